# Optimizing an MI355X kernel written in HIP

```python
import math
import jax
import jax.numpy as jnp
from jax import lax
import numpy as np

D_MODEL = 1024
BATCH = 4
SEQ = 8192
DEPTH = 2

MLA_HEADS = 8
QK_NOPE_DIM = 64
QK_ROPE_DIM = 32
V_HEAD_DIM = 64
Q_LORA_RANK = 384
KV_LORA_RANK = 256
ROPE_THETA = 10000.0
Q_BLOCK = 128
MLA_OUT = MLA_HEADS * V_HEAD_DIM
SSM_D_INNER = 1024
SSM_HEADDIM = 64
SSM_HEADS = SSM_D_INNER // SSM_HEADDIM
SSM_GROUPS = 2
SSM_D_STATE = 128
SSM_CONV = 4
SSM_CHUNK = 128
SSM_CONV_DIM = SSM_D_INNER + 2 * SSM_GROUPS * SSM_D_STATE
IN_SIZES = (Q_LORA_RANK, KV_LORA_RANK + QK_ROPE_DIM, SSM_D_INNER, SSM_CONV_DIM, SSM_HEADS, D_MODEL, D_MODEL)
IN_COLS = Q_LORA_RANK + KV_LORA_RANK + QK_ROPE_DIM + SSM_D_INNER + SSM_CONV_DIM + SSM_HEADS + 2 * D_MODEL
N_EXPERTS = 256
TOP_K = 8
N_EXPERT_GROUPS = 8
TOPK_GROUPS = 4
EXPERT_FF = 256
SHARED_FF = 256
ROUTED_SCALE = 2.5
EXPERT_BLOCK = 128
PLE_DIM = 256
DEEPNORM_ALPHA = (2 * DEPTH) ** 0.25
DEEPNORM_BETA = (8 * DEPTH) ** -0.25
LN_EPS = 1e-5
RMS_EPS = 1e-6

kernel_name = 'hybrid_mla_mamba2_moe_deepnorm'


def layer_norm(x, g, b):
    xf = x.astype(jnp.float32)
    mu = jnp.mean(xf, axis=-1, keepdims=True)
    xc = xf - mu
    var = jnp.mean(xc * xc, axis=-1, keepdims=True)
    return (xc * lax.rsqrt(var + LN_EPS) * g.astype(jnp.float32) + b.astype(jnp.float32)).astype(x.dtype)


def rms_norm(x, g):
    xf = x.astype(jnp.float32)
    y = xf * lax.rsqrt(jnp.mean(xf * xf, axis=-1, keepdims=True) + RMS_EPS)
    return (y * g.astype(jnp.float32)).astype(x.dtype)


def grouped_rms_norm(y, g, groups):
    shp = y.shape
    yg = y.astype(jnp.float32).reshape(shp[:-1] + (groups, shp[-1] // groups))
    yg = yg * lax.rsqrt(jnp.mean(yg * yg, axis=-1, keepdims=True) + RMS_EPS)
    return yg.reshape(shp) * g.astype(jnp.float32)


def split_columns(proj):
    pieces = []
    start = 0
    for size in IN_SIZES:
        pieces.append(proj[..., start:start + size])
        start += size
    return pieces


def rope_tables(positions):
    half = QK_ROPE_DIM // 2
    inv_freq = jnp.power(ROPE_THETA, -jnp.arange(half, dtype=jnp.float32) * (2.0 / QK_ROPE_DIM))
    ang = positions.astype(jnp.float32)[..., None] * inv_freq
    return jnp.cos(ang), jnp.sin(ang)


def apply_rope(x, cos, sin):
    half = QK_ROPE_DIM // 2
    xf = x.astype(jnp.float32)
    x1, x2 = xf[..., :half], xf[..., half:]
    return jnp.concatenate([x1 * cos - x2 * sin, x1 * sin + x2 * cos], axis=-1).astype(x.dtype)


def causal_mla_attention(q_nope, q_pe, k_nope, k_pe, v):
    bsz, seq = q_nope.shape[0], q_nope.shape[1]
    n_blocks = seq // Q_BLOCK
    scale = (QK_NOPE_DIM + QK_ROPE_DIM) ** -0.5
    key_pos = jnp.arange(seq)
    neg = jnp.finfo(jnp.float32).min

    def one_block(blk):
        start = blk * Q_BLOCK
        qn = lax.dynamic_slice_in_dim(q_nope, start, Q_BLOCK, axis=1)
        qp = lax.dynamic_slice_in_dim(q_pe, start, Q_BLOCK, axis=1)
        s = jnp.einsum('bqhd,bkhd->bhqk', qn, k_nope) + jnp.einsum('bqhr,bkr->bhqk', qp, k_pe)
        s = s.astype(jnp.float32) * scale
        q_pos = start + jnp.arange(Q_BLOCK)
        s = jnp.where(key_pos[None, :] <= q_pos[:, None], s, neg)
        prob = jax.nn.softmax(s, axis=-1).astype(v.dtype)
        return jnp.einsum('bhqk,bkhd->bqhd', prob, v)

    out = lax.map(one_block, jnp.arange(n_blocks))
    return jnp.moveaxis(out, 0, 1).reshape(bsz, seq, MLA_OUT)


def mla_branch(q_lat, kv_lat, q_norm, w_q_up, kv_norm, w_kv_up, cos, sin):
    bsz, seq = q_lat.shape[0], q_lat.shape[1]
    q = (rms_norm(q_lat, q_norm) @ w_q_up).reshape(bsz, seq, MLA_HEADS, QK_NOPE_DIM + QK_ROPE_DIM)
    q_nope = q[..., :QK_NOPE_DIM]
    q_pe = apply_rope(q[..., QK_NOPE_DIM:], cos[:, :, None, :], sin[:, :, None, :])
    c_kv = kv_lat[..., :KV_LORA_RANK]
    k_pe = apply_rope(kv_lat[..., KV_LORA_RANK:], cos, sin)
    kv = (rms_norm(c_kv, kv_norm) @ w_kv_up).reshape(bsz, seq, MLA_HEADS, QK_NOPE_DIM + V_HEAD_DIM)
    k_nope = kv[..., :QK_NOPE_DIM]
    v = kv[..., QK_NOPE_DIM:]
    return causal_mla_attention(q_nope, q_pe, k_nope, k_pe, v)


def causal_depthwise_conv(x, w, b):
    y = lax.conv_general_dilated(x, w[:, None, :].astype(x.dtype), window_strides=(1,),
                                 padding=[(SSM_CONV - 1, 0)], dimension_numbers=('NWC', 'WIO', 'NWC'),
                                 feature_group_count=x.shape[-1])
    return y + b.astype(x.dtype)


def ssd_chunked(xs, dt, a, bm, cm):
    bsz, seq, n_heads, hd = xs.shape
    g, n = bm.shape[2], bm.shape[3]
    r = n_heads // g
    nc, l = seq // SSM_CHUNK, SSM_CHUNK
    X = (xs.astype(jnp.float32) * dt[..., None]).reshape(bsz, nc, l, g, r, hd)
    a_dt = (dt * a).reshape(bsz, nc, l, g, r)
    a_cum = jnp.cumsum(a_dt, axis=2)
    Bc = bm.astype(jnp.float32).reshape(bsz, nc, l, g, n)
    Cc = cm.astype(jnp.float32).reshape(bsz, nc, l, g, n)
    seg = a_cum[:, :, :, None] - a_cum[:, :, None, :]
    tri = (jnp.arange(l)[:, None] >= jnp.arange(l)[None, :])[None, None, :, :, None, None]
    decay = jnp.exp(jnp.where(tri, seg, -jnp.inf))
    cb = jnp.einsum('bclgn,bcsgn->bclsg', Cc, Bc)
    y_diag = jnp.einsum('bclsg,bclsgr,bcsgrp->bclgrp', cb, decay, X)
    decay_states = jnp.exp(a_cum[:, :, -1:] - a_cum)
    states = jnp.einsum('bclgn,bclgr,bclgrp->bcgrpn', Bc, decay_states, X)
    chunk_decay = jnp.exp(a_cum[:, :, -1])

    def step(state, inp):
        chunk_state, dec = inp
        return state * dec[..., None, None] + chunk_state, state

    init = jnp.zeros((bsz, g, r, hd, n), jnp.float32)
    _, prev = lax.scan(step, init, (jnp.moveaxis(states, 1, 0), jnp.moveaxis(chunk_decay, 1, 0)))
    prev = jnp.moveaxis(prev, 0, 1)
    y_off = jnp.einsum('bclgn,bcgrpn,bclgr->bclgrp', Cc, prev, jnp.exp(a_cum))
    return (y_diag + y_off).reshape(bsz, seq, n_heads, hd)


def mamba2_branch(z, xbc, dt_raw, conv_w, conv_b, dt_bias, a_log, d_skip, norm_w):
    bsz, seq = z.shape[0], z.shape[1]
    xbc = jax.nn.silu(causal_depthwise_conv(xbc, conv_w, conv_b))
    gn = SSM_GROUPS * SSM_D_STATE
    xs = xbc[..., :SSM_D_INNER].reshape(bsz, seq, SSM_HEADS, SSM_HEADDIM)
    bm = xbc[..., SSM_D_INNER:SSM_D_INNER + gn].reshape(bsz, seq, SSM_GROUPS, SSM_D_STATE)
    cm = xbc[..., SSM_D_INNER + gn:].reshape(bsz, seq, SSM_GROUPS, SSM_D_STATE)
    dt = jax.nn.softplus(dt_raw.astype(jnp.float32) + dt_bias.astype(jnp.float32))
    a = -jnp.exp(a_log.astype(jnp.float32))
    y = ssd_chunked(xs, dt, a, bm, cm)
    y = y + xs.astype(jnp.float32) * d_skip.astype(jnp.float32)[:, None]
    y = y.reshape(bsz, seq, SSM_D_INNER) * jax.nn.silu(z.astype(jnp.float32))
    return grouped_rms_norm(y, norm_w, SSM_GROUPS).astype(z.dtype)


def sigmoid_group_router(h, w_router, router_bias):
    t = h.shape[0]
    scores = jax.nn.sigmoid((h @ w_router).astype(jnp.float32))
    sel = scores + router_bias.astype(jnp.float32)
    per_group = N_EXPERTS // N_EXPERT_GROUPS
    grp_score = jnp.sum(lax.top_k(sel.reshape(t, N_EXPERT_GROUPS, per_group), 2)[0], axis=-1)
    _, top_g = lax.top_k(grp_score, TOPK_GROUPS)
    gmask = jnp.sum(jax.nn.one_hot(top_g, N_EXPERT_GROUPS, dtype=jnp.float32), axis=1) > 0
    masked = jnp.where(jnp.repeat(gmask, per_group, axis=1), sel, -jnp.inf)
    _, idx = lax.top_k(masked, TOP_K)
    w = jnp.take_along_axis(scores, idx, axis=1)
    w = w / jnp.sum(w, axis=-1, keepdims=True) * ROUTED_SCALE
    return idx, w


def routed_experts(h, idx, wts, w_g, w_u, w_d):
    t, dm = h.shape
    n_assign = t * TOP_K
    e_flat = idx.reshape(n_assign)
    tok_flat = jnp.arange(n_assign, dtype=jnp.int32) // TOP_K
    w_flat = wts.reshape(n_assign)
    order = jnp.argsort(e_flat)
    e_sorted = e_flat[order]
    counts = jnp.bincount(e_flat, length=N_EXPERTS)
    padded = (counts + EXPERT_BLOCK - 1) // EXPERT_BLOCK * EXPERT_BLOCK
    pad_end = jnp.cumsum(padded)
    pad_start = pad_end - padded
    grp_start = jnp.cumsum(counts) - counts
    dest = pad_start[e_sorted] + jnp.arange(n_assign, dtype=jnp.int32) - grp_start[e_sorted]
    n_blocks = -(-n_assign // EXPERT_BLOCK) + N_EXPERTS
    cap = n_blocks * EXPERT_BLOCK
    slot_tok = jnp.full((cap,), t, jnp.int32).at[dest].set(tok_flat[order])
    slot_w = jnp.zeros((cap,), jnp.float32).at[dest].set(w_flat[order])
    block_expert = jnp.minimum(jnp.searchsorted(pad_end // EXPERT_BLOCK, jnp.arange(n_blocks), side='right'),
                               N_EXPERTS - 1)
    h_pad = jnp.concatenate([h, jnp.zeros((1, dm), h.dtype)], axis=0)

    def step(acc, inp):
        e, tok, wt = inp
        xb = h_pad[tok]
        hid = jax.nn.silu(xb @ w_g[e]) * (xb @ w_u[e])
        yb = (hid @ w_d[e]).astype(jnp.float32) * wt[:, None]
        return acc.at[tok].add(yb), None

    acc0 = jnp.zeros((t + 1, dm), jnp.float32)
    acc, _ = lax.scan(step, acc0, (block_expert, slot_tok.reshape(n_blocks, EXPERT_BLOCK),
                                   slot_w.reshape(n_blocks, EXPERT_BLOCK)))
    return acc[:t]


def swiglu(h, w_g, w_u, w_d):
    return (jax.nn.silu(h @ w_g) * (h @ w_u)) @ w_d


def setup_inputs(seed: int = 0) -> dict:
    key = jax.random.key(seed)
    ks = jax.random.split(key, 32)
    f32 = jnp.float32
    L = DEPTH

    def nrm(k, shape, scale):
        return jax.random.normal(k, shape, f32) * scale

    x = nrm(ks[0], (BATCH, SEQ, D_MODEL), 1.0)
    p = nrm(ks[1], (DEPTH, BATCH, SEQ, PLE_DIM), 1.0)
    offsets = jax.random.randint(ks[2], (BATCH, 1), 0, 4096, dtype=jnp.int32)
    positions = offsets + jnp.arange(SEQ, dtype=jnp.int32)[None, :]
    w_in = nrm(ks[3], (L, D_MODEL, IN_COLS), D_MODEL ** -0.5)
    q_norm = 1.0 + nrm(ks[4], (L, Q_LORA_RANK), 0.02)
    w_q_up = nrm(ks[5], (L, Q_LORA_RANK, MLA_HEADS * (QK_NOPE_DIM + QK_ROPE_DIM)), Q_LORA_RANK ** -0.5)
    kv_norm = 1.0 + nrm(ks[6], (L, KV_LORA_RANK), 0.02)
    w_kv_up = nrm(ks[7], (L, KV_LORA_RANK, MLA_HEADS * (QK_NOPE_DIM + V_HEAD_DIM)), KV_LORA_RANK ** -0.5)
    conv_w = nrm(ks[8], (L, SSM_CONV, SSM_CONV_DIM), SSM_CONV ** -0.5)
    conv_b = nrm(ks[9], (L, SSM_CONV_DIM), 0.02)
    dt0 = jnp.exp(jax.random.uniform(ks[10], (L, SSM_HEADS), f32, math.log(1e-3), math.log(1e-1)))
    dt_bias = dt0 + jnp.log(-jnp.expm1(-dt0))
    a_log = jnp.log(jax.random.uniform(ks[11], (L, SSM_HEADS), f32, 1.0, 16.0))
    d_skip = 1.0 + nrm(ks[12], (L, SSM_HEADS), 0.1)
    ssm_norm = 1.0 + nrm(ks[13], (L, SSM_D_INNER), 0.02)
    w_attn_br = nrm(ks[14], (L, MLA_OUT, D_MODEL), MLA_OUT ** -0.5 * DEEPNORM_BETA)
    w_ssm_br = nrm(ks[15], (L, SSM_D_INNER, D_MODEL), SSM_D_INNER ** -0.5 * DEEPNORM_BETA)
    w_o = nrm(ks[16], (L, D_MODEL, D_MODEL), D_MODEL ** -0.5 * DEEPNORM_BETA)
    ln1_g = 1.0 + nrm(ks[17], (L, D_MODEL), 0.02)
    ln1_b = nrm(ks[18], (L, D_MODEL), 0.02)
    w_router = nrm(ks[19], (L, D_MODEL, N_EXPERTS), D_MODEL ** -0.5)
    router_bias = nrm(ks[20], (L, N_EXPERTS), 0.01)
    w_exp_gate = nrm(ks[21], (L, N_EXPERTS, D_MODEL, EXPERT_FF), D_MODEL ** -0.5)
    w_exp_up = nrm(ks[22], (L, N_EXPERTS, D_MODEL, EXPERT_FF), D_MODEL ** -0.5)
    w_exp_down = nrm(ks[23], (L, N_EXPERTS, EXPERT_FF, D_MODEL), EXPERT_FF ** -0.5 * DEEPNORM_BETA)
    w_sh_gate = nrm(ks[24], (L, D_MODEL, SHARED_FF), D_MODEL ** -0.5)
    w_sh_up = nrm(ks[25], (L, D_MODEL, SHARED_FF), D_MODEL ** -0.5)
    w_sh_down = nrm(ks[26], (L, SHARED_FF, D_MODEL), SHARED_FF ** -0.5 * DEEPNORM_BETA)
    w_ple = nrm(ks[27], (L, PLE_DIM, D_MODEL), PLE_DIM ** -0.5 * DEEPNORM_BETA)
    w_ple_gate = nrm(ks[28], (L, D_MODEL, D_MODEL), D_MODEL ** -0.5)
    ln2_g = 1.0 + nrm(ks[29], (L, D_MODEL), 0.02)
    ln2_b = nrm(ks[30], (L, D_MODEL), 0.02)
    return {'x': x, 'p': p, 'positions': positions, 'w_in': w_in, 'q_norm': q_norm, 'w_q_up': w_q_up,
            'kv_norm': kv_norm, 'w_kv_up': w_kv_up, 'conv_w': conv_w, 'conv_b': conv_b, 'dt_bias': dt_bias,
            'a_log': a_log, 'd_skip': d_skip, 'ssm_norm': ssm_norm, 'w_attn_br': w_attn_br, 'w_ssm_br': w_ssm_br,
            'w_o': w_o, 'ln1_g': ln1_g, 'ln1_b': ln1_b, 'w_router': w_router, 'router_bias': router_bias,
            'w_exp_gate': w_exp_gate, 'w_exp_up': w_exp_up, 'w_exp_down': w_exp_down, 'w_sh_gate': w_sh_gate,
            'w_sh_up': w_sh_up, 'w_sh_down': w_sh_down, 'w_ple': w_ple, 'w_ple_gate': w_ple_gate,
            'ln2_g': ln2_g, 'ln2_b': ln2_b}


def reference(x, p, positions, w_in, q_norm, w_q_up, kv_norm, w_kv_up, conv_w, conv_b, dt_bias, a_log, d_skip,
              ssm_norm, w_attn_br, w_ssm_br, w_o, ln1_g, ln1_b, w_router, router_bias, w_exp_gate, w_exp_up,
              w_exp_down, w_sh_gate, w_sh_up, w_sh_down, w_ple, w_ple_gate, ln2_g, ln2_b):
    bsz, seq, dm = x.shape
    n_tok = bsz * seq
    cos, sin = rope_tables(positions)
    h = x
    for i in range(DEPTH):
        proj = h @ w_in[i]
        q_lat, kv_lat, z, xbc, dt_raw, gate_a, gate_b = split_columns(proj)
        ya = mla_branch(q_lat, kv_lat, q_norm[i], w_q_up[i], kv_norm[i], w_kv_up[i], cos, sin) @ w_attn_br[i]
        yb = mamba2_branch(z, xbc, dt_raw, conv_w[i], conv_b[i], dt_bias[i], a_log[i], d_skip[i],
                           ssm_norm[i]) @ w_ssm_br[i]
        mixed = (jax.nn.sigmoid(gate_a) * ya + jax.nn.sigmoid(gate_b) * yb) @ w_o[i]
        h = layer_norm(DEEPNORM_ALPHA * h + mixed, ln1_g[i], ln1_b[i])
        ht = h.reshape(n_tok, dm)
        idx, wts = sigmoid_group_router(ht, w_router[i], router_bias[i])
        routed = routed_experts(ht, idx, wts, w_exp_gate[i], w_exp_up[i], w_exp_down[i]).astype(h.dtype)
        ffn = (routed + swiglu(ht, w_sh_gate[i], w_sh_up[i], w_sh_down[i])).reshape(bsz, seq, dm)
        ple = (p[i] @ w_ple[i]) * jax.nn.sigmoid(h @ w_ple_gate[i])
        h = layer_norm(DEEPNORM_ALPHA * h + ffn + ple, ln2_g[i], ln2_b[i])
    return h
```

```cpp
#include <hip/hip_runtime.h>
#include <cstdio>
#include <cstdint>

#define LAS __attribute__((address_space(3)))
#define GAS __attribute__((address_space(1)))
typedef unsigned short bf16;
typedef short bf16x8 __attribute__((ext_vector_type(8)));
typedef short s16x4 __attribute__((ext_vector_type(4)));
typedef float f32x2 __attribute__((ext_vector_type(2)));
typedef float f32x4 __attribute__((ext_vector_type(4)));
typedef float f32x16 __attribute__((ext_vector_type(16)));
typedef unsigned u32x2 __attribute__((ext_vector_type(2)));
typedef unsigned u32x4 __attribute__((ext_vector_type(4)));
typedef GAS unsigned gu32;

constexpr int NB = 4, SEQ = 8192, T = NB * SEQ, D = 1024, DEPTH = 2;
constexpr int NCOLS = 5296, NPAD = 5376;
constexpr int CQ = 0, CKV = 384, CKPE = 640, CZ = 672, CXBC = 1696, CDT = 3232, CGA = 3248, CGB = 4272;
constexpr int NEXP = 256, TOPK = 8;
constexpr int SMAX = T * TOPK + NEXP * 255;
constexpr float ALPHA = 1.4142135623730951f;
constexpr float QSCALE = 0.10206207261596577f * 1.4426950408889634f;
constexpr int NWAVES = 8;
constexpr float YSCALE = 32.f;

constexpr size_t MiB = 1u << 20;
constexpr size_t WS_CTL = 0, CTL_ZERO_BYTES = 1 * MiB;
constexpr size_t WS_WSM = 1 * MiB, WSM_LAYER = 22 * MiB;
constexpr size_t WO_WIN = 0, WO_WQ = WO_WIN + (size_t)NPAD * 1024 * 2, WO_WKV = WO_WQ + 768 * 384 * 2, WO_WAB = WO_WKV + 1024 * 256 * 2,
                 WO_WSB = WO_WAB + 1024 * 512 * 2, WO_WO = WO_WSB + 1024 * 1024 * 2, WO_WCAT = WO_WO + 1024 * 1024 * 2,
                 WO_WSD = WO_WCAT + 1792 * 1024 * 2, WO_WPLE = WO_WSD + 1024 * 256 * 2, WO_END = WO_WPLE + 1024 * 256 * 2;
static_assert(WO_END <= WSM_LAYER, "small weights");
constexpr size_t WS_ROPE = 45 * MiB;
constexpr size_t WS_HB = 49 * MiB;
constexpr size_t WS_WGU = 113 * MiB, WGU_LAYER = 256 * MiB;
constexpr size_t WS_WD = 625 * MiB, WD_LAYER = 128 * MiB;
constexpr size_t WS_X = 881 * MiB;
constexpr size_t X_PROJ = WS_X, X_DTRAW = X_PROJ + 336 * MiB, X_QN = X_DTRAW + 2 * MiB, X_CKVN = X_QN + 24 * MiB, X_KPE = X_CKVN + 16 * MiB,
                 X_QB = X_KPE + 2 * MiB, X_KVB = X_QB + 48 * MiB, X_OB = X_KVB + 64 * MiB, X_YPART = X_OB + 32 * MiB, X_CC = X_YPART + 128 * MiB,
                 X_EACUM = X_CC + 16 * MiB, X_CDEC = X_EACUM + 2 * MiB, X_STATES = X_CDEC + 1 * MiB, X_PREV = X_STATES + 128 * MiB,
                 X_YNORM = X_PREV + 64 * MiB, X_MB = X_YNORM + 64 * MiB, X_PRE = X_MB + 64 * MiB, X_MIX_END = X_PRE + 128 * MiB;
constexpr size_t X_LOGITS = WS_X, X_RIDX = X_LOGITS + 32 * MiB, X_RW = X_RIDX + 1 * MiB, X_RRANK = X_RW + 1 * MiB, X_STOK = X_RRANK + 1 * MiB,
                 X_SW = X_STOK + 2 * MiB, X_PB = X_SW + 2 * MiB, X_SHHID = X_PB + 16 * MiB, X_SG = X_SHHID + 16 * MiB, X_BASE = X_SG + 64 * MiB,
                 X_HID = X_BASE + 128 * MiB, X_Y = X_HID + 160 * MiB, X_MOE_END = X_Y + 640 * MiB;
constexpr size_t WS_END = 2048 * MiB;
static_assert(X_MIX_END <= WS_END && X_MOE_END <= WS_END && X_PB + 16 * MiB <= X_PRE, "d_ws map");
static_assert((size_t)SMAX * 256 * 2 <= 160 * MiB && (size_t)SMAX * 1024 * 2 <= 640 * MiB && (size_t)SMAX * 4 <= 2 * MiB, "slot buffers");
constexpr int CW_TMO = 0, CW_BAR = 4096, CW_CNT = 16384, CW_SEM = 32768;
constexpr unsigned CONV_LIMIT = 96;

constexpr int RING_OFF = 0, RING_BYTES = 131072, SIDE_OFF = 131072, SIDE_BYTES = 16384, LDSCTL_OFF = SIDE_OFF + SIDE_BYTES, LDS_BYTES = LDSCTL_OFF + 512;


extern __shared__ __attribute__((aligned(16))) unsigned char lds_raw[];
__device__ __forceinline__ int lane_id() { return (int)__builtin_amdgcn_mbcnt_hi(~0u, __builtin_amdgcn_mbcnt_lo(~0u, 0u)); }
__device__ __forceinline__ unsigned hw_wave_slot() { return (unsigned)__builtin_amdgcn_s_getreg(((6 - 1) << 11) | 4) & 63u; }
__device__ __forceinline__ int wave_index() { return __builtin_amdgcn_readfirstlane(*(volatile LAS int*)((LAS unsigned char*)lds_raw + LDSCTL_OFF + 64 + 4 * hw_wave_slot())); }
__device__ __forceinline__ int cur_tid() { return wave_index() * 64 + lane_id(); }
__device__ __forceinline__ float bf2f(unsigned short b) { return __uint_as_float(((unsigned)b) << 16); }
__device__ __forceinline__ float bflo(unsigned w) { return __uint_as_float(w << 16); }
__device__ __forceinline__ float bfhi(unsigned w) { return __uint_as_float(w & 0xffff0000u); }
typedef __bf16 bf16x2_t __attribute__((ext_vector_type(2)));
__device__ __forceinline__ unsigned pk2(float lo, float hi) { const f32x2 v = {lo, hi}; const bf16x2_t b = __builtin_convertvector(v, bf16x2_t); return __builtin_bit_cast(unsigned, b); }
__device__ __forceinline__ unsigned short f2bf(float f) { return (unsigned short)(pk2(f, 0.f) & 0xffffu); }
__device__ __forceinline__ float sigmoidf_(float x) { return __builtin_amdgcn_rcpf(1.f + __expf(-x)); }
__device__ __forceinline__ float siluf_(float x) { return x * sigmoidf_(x); }
__device__ __forceinline__ float wave_sum(float v) {
#pragma unroll
    for (int o = 1; o < 64; o <<= 1) v += __shfl_xor(v, o);
    return v;
}
template <class Tp> __device__ __forceinline__ Tp* uni_ptr(Tp* p) {
    const unsigned long long v = (unsigned long long)p; unsigned lo = __builtin_amdgcn_readfirstlane((unsigned)v), hi = __builtin_amdgcn_readfirstlane((unsigned)(v >> 32));
    asm volatile("" : "+s"(lo), "+s"(hi)); return (Tp*)(GAS Tp*)(((unsigned long long)hi << 32) | lo); }
__device__ __forceinline__ int uni_int(int x) { x = __builtin_amdgcn_readfirstlane(x); asm volatile("" : "+s"(x)); return x; }
#define LDS_WAIT() asm volatile("s_waitcnt lgkmcnt(0)" ::: "memory")
#define VM_WAIT() asm volatile("s_waitcnt vmcnt(0)" ::: "memory")
#define LDS_BAR() do { asm volatile("s_waitcnt lgkmcnt(0)" ::: "memory"); __builtin_amdgcn_s_barrier(); asm volatile("" ::: "memory"); } while (0)
#define WG_BAR() do { asm volatile("s_waitcnt vmcnt(0) lgkmcnt(0)" ::: "memory"); __builtin_amdgcn_s_barrier(); asm volatile("" ::: "memory"); } while (0)

__device__ __forceinline__ unsigned off_b(unsigned row, unsigned ch) { return 256u * row + 16u * (ch ^ (((row & 3) << 2) | ((row >> 2) & 3))); }
__device__ __forceinline__ unsigned row_read_addr(unsigned rowbase, unsigned lane, unsigned s) { return off_b(rowbase + (lane & 31), 2 * s + (lane >> 5)); }
__device__ __forceinline__ unsigned tr_read_addr(unsigned lane, unsigned c, unsigned ks, unsigned t) {
    const unsigned h = lane >> 5, blk = (lane >> 4) & 1, q = (lane & 15) >> 2, p = lane & 3;
    return off_b(16 * ks + 8 * h + 4 * t + q, 4 * c + 2 * blk + (p >> 1)) + 8 * (p & 1);
}
typedef short v4i16_t __attribute__((ext_vector_type(4)));
__device__ __forceinline__ s16x4 ldstr(LAS const unsigned char* p) { return __builtin_bit_cast(s16x4, __builtin_amdgcn_ds_read_tr16_b64_v4i16((LAS v4i16_t*)p)); }
__device__ __forceinline__ bf16x8 tr_frag(LAS const unsigned char* tile, unsigned lane, unsigned c, unsigned ks) {
    const s16x4 a = ldstr(tile + tr_read_addr(lane, c, ks, 0)), b = ldstr(tile + tr_read_addr(lane, c, ks, 1));
    return (bf16x8){a[0], a[1], a[2], a[3], b[0], b[1], b[2], b[3]};
}
__device__ __forceinline__ int crow(int r, int hi) { return (r & 3) + 8 * (r >> 2) + 4 * hi; }

#define XB_TMO      128
#define XB_XCNT(j)  (256  + 64 * (j))
#define XB_XSUB(j)  (1280 + 64 * (j))
#define XB_XGEN(j)  (2304 + 64 * (j))
#define XB_TOP      3328
#define XB_TOPGEN   3392
#define XCD_BAR_WORDS 3456
#define XB_SPIN_CAP (1u << 22)
__device__ __forceinline__ unsigned xb_ld(unsigned* p)              { return __hip_atomic_load(p, __ATOMIC_RELAXED, __HIP_MEMORY_SCOPE_AGENT); }
__device__ __forceinline__ unsigned xb_add(unsigned* p, unsigned v) { return __hip_atomic_fetch_add(p, v, __ATOMIC_RELAXED, __HIP_MEMORY_SCOPE_AGENT); }
__device__ __forceinline__ unsigned xb_xcc_id() { return (unsigned)__builtin_amdgcn_s_getreg((3 << 11) | 20) & 0xFu; }
#define XB_SPIN(cond, bar) do { unsigned _sp = 0; while (cond) { __builtin_amdgcn_s_sleep(1); \
    if ((++_sp & 255u) == 0u) { if (xb_ld(&(bar)[XB_TMO])) break; if (_sp > XB_SPIN_CAP) { atomicAdd(&(bar)[XB_TMO], 1u); break; } } } } while (0)
struct XcdBarrier { unsigned* bar; unsigned x; volatile LAS unsigned* st; };
__device__ __forceinline__ XcdBarrier xcd_barrier_post(unsigned* bar, volatile LAS unsigned* st) {
    XcdBarrier b; b.bar = bar; b.x = xb_xcc_id(); b.st = st;
    if (cur_tid() == 0) (void)xb_add(&bar[XB_XCNT(b.x)], 1u);
    return b;
}
__device__ __forceinline__ void xcd_barrier_complete(unsigned* bar, unsigned x, unsigned& nloc, unsigned& nx) {
    const unsigned G = gridDim.x * gridDim.y * gridDim.z;
    unsigned sum, cnt, mine, sp = 0u;
    for (;;) {
        sum = 0u; cnt = 0u; mine = 0u;
#pragma unroll 1
        for (unsigned j = 0; j < 16; ++j) { const unsigned c = xb_ld(&bar[XB_XCNT(j)]); sum += c; cnt += (c > 0u) ? 1u : 0u; mine = (j == x) ? c : mine; }
        if (sum == G) break;
        __builtin_amdgcn_s_sleep(1);
        if ((++sp & 255u) == 0u) { if (xb_ld(&bar[XB_TMO])) break; if (sp > XB_SPIN_CAP) { atomicAdd(&bar[XB_TMO], 1u); break; } }
    }
    nloc = mine > 0u ? mine : 1u; nx = cnt > 0u ? cnt : 1u;
}
__device__ __attribute__((noinline)) void xcd_barrier(const XcdBarrier b) {
    asm volatile("s_waitcnt vmcnt(0)" ::: "memory");
    __syncthreads();
    if (cur_tid() == 0) {
        unsigned* bar = uni_ptr(b.bar);
        __builtin_amdgcn_s_waitcnt(0);
        unsigned nloc = b.st[0], nx = b.st[1];
        if (nloc == 0u) { xcd_barrier_complete(bar, b.x, nloc, nx); b.st[0] = nloc; b.st[1] = nx; }
        const unsigned old = xb_add(&bar[XB_XSUB(b.x)], 1u);
        const unsigned gen = old / nloc;
        if (old + 1u == (gen + 1u) * nloc) {
            __builtin_amdgcn_fence(__ATOMIC_RELEASE, "agent");
            asm volatile("s_waitcnt vmcnt(0)" ::: "memory");
            const unsigned og = xb_add(&bar[XB_TOP], 1u);
            const unsigned tg = og / nx;
            if (og + 1u == (tg + 1u) * nx) xb_add(&bar[XB_TOPGEN], 1u);
            else XB_SPIN(xb_ld(&bar[XB_TOPGEN]) == tg, bar);
            __builtin_amdgcn_fence(__ATOMIC_ACQUIRE, "agent");
            xb_add(&bar[XB_XGEN(b.x)], 1u);
            asm volatile("s_waitcnt vmcnt(0)" ::: "memory");
        } else {
            XB_SPIN(xb_ld(&bar[XB_XGEN(b.x)]) == gen, bar);
            __builtin_amdgcn_fence(__ATOMIC_ACQUIRE, "agent");
            asm volatile("s_waitcnt vmcnt(0)" ::: "memory");
        }
    }
    __syncthreads();
}

namespace ge {
constexpr int BM = 256, BK = 64, HALF = 128, HTB = HALF * BK * 2, STAGE_BYTES = 8 * HTB, NXCD = 8, WGM = 8;
__device__ __forceinline__ int lds_byte(int r, int c) { const int st = (r >> 4) * 2 + (c >> 5), rr = r & 15, cc = c & 31, ob = rr * 64 + cc * 2; return st * 1024 + (ob ^ (((ob >> 9) & 1) << 5)); }
__device__ __forceinline__ void stage_rc(int b, int& R, int& C) { const int st = b / 1024, sb = b % 1024, swz = sb ^ (((sb >> 9) & 1) << 5); R = (st >> 1) * 16 + swz / 64; C = (st & 1) * 32 + (swz % 64) / 2; }
__device__ __forceinline__ int perm32(int rho) { const int n = rho >> 4, i = rho & 15; return 8 * (i >> 2) + 4 * n + (i & 3); }
struct GU { const char* A; const char* B; int pm, pn, x0; };
typedef f32x4 Acc[2][2][4][2];
struct StaticOrder {
    int nM, nN, nwg, G, c;
    __device__ __forceinline__ void init(int M, int N, int G_, int c_) { nM = M / BM; nN = N / BM; nwg = nM * nN; G = G_; c = c_; }
    __device__ __forceinline__ bool next(int i, int& pm, int& pn) const {
        const long L = (long)i * G + c; if (L >= nwg) return false;
        int wgid = (int)L; { const int q = nwg / NXCD, r = nwg % NXCD, xcd = wgid % NXCD, off = wgid / NXCD; wgid = (xcd < r ? xcd * (q + 1) : r * (q + 1) + (xcd - r) * q) + off; }
        const int nig = WGM * nN, gid = wgid / nig, fm = gid * WGM, gsz = (nM - fm) < WGM ? (nM - fm) : WGM;
        pm = fm + ((wgid % nig) % gsz); pn = (wgid % nig) / gsz; return true;
    }
};

template <class P>
__device__ __forceinline__ void gemm_phase(LAS unsigned char* lds, const P& p) {
    int tid_ = cur_tid(); asm volatile("" : "+v"(tid_));
    const int tid = tid_, wid = __builtin_amdgcn_readfirstlane(tid >> 6), lane = tid & 63, wr = wid >> 2, wc = wid & 3, fr = lane & 15, fq = lane >> 4;
    const int K = p.K, nt = K / BK;
    int Rp[2], Cp[2]; unsigned voffB[2];
#pragma unroll
    for (int i = 0; i < 2; ++i) { int R, C; stage_rc(tid * 16 + i * 8192, R, C); Rp[i] = R; Cp[i] = C; const int Rb = (R & ~31) + perm32(R & 31); voffB[i] = (unsigned)(Rb * K + C) * 2u; }
    const size_t kstep = (size_t)(BK * 2);
    const size_t hstepB = (size_t)HALF * K * 2;
    const unsigned ldsw = (unsigned)wid * 1024u;
    const int aoff = lds_byte(wr * 64 + fr, fq * 8), boff = lds_byte(wc * 32 + fr, fq * 8);
#define PG8_SA(b, h) (((b) * 2 + (h)) * HTB)
#define PG8_SB(b, h) ((4 + (b) * 2 + (h)) * HTB)
#define PG8_STAGE(bufoff, gbase, voff) do { _Pragma("unroll") for (int _i = 0; _i < 2; ++_i) \
        __builtin_amdgcn_global_load_lds((const unsigned*)((const char*)(gbase) + (voff)[_i]), (LAS unsigned*)(lds + (bufoff) + ldsw + _i * 8192), 16, 0, 0); } while (0)
#define PG8_LDA(dst, b, h) do { _Pragma("unroll") for (int m = 0; m < 4; ++m) _Pragma("unroll") for (int k = 0; k < 2; ++k) dst[m][k] = *(const LAS bf16x8*)(lds + PG8_SA(b, h) + aoff + m * 2048 + k * 1024); } while (0)
#define PG8_LDB(dst, b, h) do { _Pragma("unroll") for (int n = 0; n < 2; ++n) _Pragma("unroll") for (int k = 0; k < 2; ++k) dst[n][k] = *(const LAS bf16x8*)(lds + PG8_SB(b, h) + boff + n * 2048 + k * 1024); } while (0)
#define PG8_MMA(ai, bj, At, Bt) do { __builtin_amdgcn_s_setprio(1); _Pragma("unroll") for (int m = 0; m < 4; ++m) _Pragma("unroll") for (int n = 0; n < 2; ++n) _Pragma("unroll") for (int k = 0; k < 2; ++k) \
        acc[ai][bj][m][n] = __builtin_amdgcn_mfma_f32_16x16x32_bf16(Bt[n][k], At[m][k], acc[ai][bj][m][n], 0, 0, 0); __builtin_amdgcn_s_setprio(0); } while (0)
#define PG8_WAIT_V(n) asm volatile("s_waitcnt vmcnt(" #n ")" ::: "memory")
#define PG8_WAIT_L(n) asm volatile("s_waitcnt lgkmcnt(" #n ")" ::: "memory")
#define PG8_BAR __builtin_amdgcn_s_barrier()
#define PG8_SCHED __builtin_amdgcn_sched_barrier(0)
    GU cur, nxt; int ui = 0;
    if (!p.next(0, cur)) return;
    Acc acc;
#pragma unroll
    for (int a = 0; a < 2; ++a)
#pragma unroll
        for (int b = 0; b < 2; ++b)
#pragma unroll
            for (int m = 0; m < 4; ++m)
#pragma unroll
                for (int n = 0; n < 2; ++n) acc[a][b][m][n] = (f32x4){0.f, 0.f, 0.f, 0.f};
    bf16x8 At[4][2], B0[2][2], B1[2][2];
    unsigned vA[2][2], vN[2][2];
    p.rowoff(cur, Rp, Cp, vA);
    const char* cA = cur.A; const char* cB = cur.B;
    PG8_STAGE(PG8_SB(0, 0), cB, voffB); PG8_STAGE(PG8_SB(0, 1), cB + hstepB, voffB); PG8_STAGE(PG8_SA(0, 0), cA, vA[0]); PG8_STAGE(PG8_SA(0, 1), cA, vA[1]);
    if (wr == 1) PG8_BAR;
    PG8_WAIT_V(2); PG8_BAR;
    PG8_STAGE(PG8_SB(1, 0), cB + kstep, voffB); PG8_STAGE(PG8_SA(1, 0), cA + kstep, vA[0]); PG8_STAGE(PG8_SB(1, 1), cB + hstepB + kstep, voffB);
    PG8_WAIT_V(6); PG8_BAR;
    for (;;) {
        const bool has_next = p.next(ui + 1, nxt);
        if (has_next) p.rowoff(nxt, Rp, Cp, vN);
        else {
#pragma unroll
            for (int h = 0; h < 2; ++h)
#pragma unroll
                for (int i = 0; i < 2; ++i) vN[h][i] = vA[h][i]; }
        const char* nA = has_next ? nxt.A : cA; const char* nB = has_next ? nxt.B : cB;
        for (int t = 0; t < nt; t += 2) {
            const bool last = (t == nt - 2);
            const char* a1 = cA + (size_t)(t + 1) * kstep;
            const char* a2 = last ? nA : cA + (size_t)(t + 2) * kstep; const char* b2 = last ? nB : cB + (size_t)(t + 2) * kstep;
            const char* a3 = a2 + kstep; const char* b3 = b2 + kstep;
            unsigned v2[2][2];
#pragma unroll
            for (int h = 0; h < 2; ++h)
#pragma unroll
                for (int i = 0; i < 2; ++i) v2[h][i] = last ? vN[h][i] : vA[h][i];
            PG8_LDB(B0, 0, 0); PG8_LDB(B1, 0, 1); PG8_SCHED; PG8_LDA(At, 0, 0); PG8_STAGE(PG8_SA(1, 1), a1, vA[1]);
            PG8_WAIT_V(8); PG8_WAIT_L(0); PG8_BAR; PG8_MMA(0, 0, At, B0); PG8_MMA(0, 1, At, B1); PG8_BAR; PG8_SCHED;
            PG8_LDA(At, 0, 1); PG8_STAGE(PG8_SB(0, 0), b2, voffB); PG8_STAGE(PG8_SB(0, 1), b2 + hstepB, voffB); PG8_STAGE(PG8_SA(0, 0), a2, v2[0]);
            PG8_WAIT_V(8); PG8_WAIT_L(0); PG8_BAR; PG8_MMA(1, 0, At, B0); PG8_MMA(1, 1, At, B1); PG8_BAR; PG8_SCHED;
            PG8_LDB(B0, 1, 0); PG8_LDB(B1, 1, 1); PG8_SCHED; PG8_LDA(At, 1, 0); PG8_STAGE(PG8_SA(0, 1), a2, v2[1]);
            PG8_WAIT_V(8); PG8_WAIT_L(0); PG8_BAR; PG8_MMA(0, 0, At, B0); PG8_MMA(0, 1, At, B1); PG8_BAR; PG8_SCHED;
            PG8_LDA(At, 1, 1); PG8_STAGE(PG8_SB(1, 0), b3, voffB); PG8_STAGE(PG8_SB(1, 1), b3 + hstepB, voffB); PG8_STAGE(PG8_SA(1, 0), a3, v2[0]);
            PG8_WAIT_V(8); PG8_WAIT_L(0); PG8_BAR; PG8_MMA(1, 0, At, B0); PG8_MMA(1, 1, At, B1); PG8_BAR; PG8_SCHED;
        }
        if (wr == 0) PG8_BAR;
        p.epi(acc, cur, wr, wc, fr, fq);
        if (!has_next) break;
#pragma unroll
        for (int a = 0; a < 2; ++a)
#pragma unroll
            for (int b = 0; b < 2; ++b)
#pragma unroll
                for (int m = 0; m < 4; ++m)
#pragma unroll
                    for (int n = 0; n < 2; ++n) acc[a][b][m][n] = (f32x4){0.f, 0.f, 0.f, 0.f};
        cur = nxt; cA = nA; cB = nB; ++ui;
#pragma unroll
        for (int h = 0; h < 2; ++h)
#pragma unroll
            for (int i = 0; i < 2; ++i) vA[h][i] = vN[h][i];
        if (wr == 1) PG8_BAR;
    }
    PG8_WAIT_V(0);
    PG8_BAR;
#undef PG8_SA
#undef PG8_SB
#undef PG8_STAGE
#undef PG8_LDA
#undef PG8_LDB
#undef PG8_MMA
#undef PG8_WAIT_V
#undef PG8_WAIT_L
#undef PG8_BAR
#undef PG8_SCHED
}

template <class Epi> struct Dense {
    const bf16* A; const bf16* Bt; int lda, K; StaticOrder S; Epi E;
    __device__ __forceinline__ bool next(int i, GU& u) const {
        int pm, pn; if (!S.next(i, pm, pn)) return false;
        u.pm = pm; u.pn = pn; u.x0 = 0; u.A = (const char*)A + (size_t)pm * BM * lda * 2; u.B = (const char*)Bt + (size_t)pn * BM * K * 2; return true;
    }
    __device__ __forceinline__ void rowoff(const GU&, const int (&R)[2], const int (&C)[2], unsigned (&v)[2][2]) const {
#pragma unroll
        for (int h = 0; h < 2; ++h)
#pragma unroll
            for (int i = 0; i < 2; ++i) v[h][i] = (unsigned)((h * HALF + R[i]) * lda + C[i]) * 2u;
    }
    __device__ __forceinline__ void epi(const Acc& acc, const GU& u, int wr, int wc, int fr, int fq) const {
        const int row0 = u.pm * BM + wr * 64 + fr, col0 = u.pn * BM + wc * 32 + 8 * fq;
        E.unit(acc, u, row0, col0);
    }
};
}

struct Frame {
    LAS unsigned char* lds;
    gu32* ctl;
    int tid, lane, wave, G, vcu;
    unsigned char* ws;
    float* out;
    const void* const* in;
};

__device__ __forceinline__ void frame_refresh(Frame& F) {
    int t = cur_tid(); asm volatile("" : "+v"(t)); F.tid = t; F.lane = t & 63; F.wave = __builtin_amdgcn_readfirstlane(t >> 6);
    F.ws = uni_ptr(F.ws); F.ctl = (gu32*)(F.ws + WS_CTL); F.G = uni_int(F.G); F.vcu = uni_int(F.vcu); F.out = uni_ptr(F.out);
}
template <class F> __device__ __forceinline__ void epi_rows(const ge::Acc& acc, int row0, int col0, F f) {
#pragma unroll
    for (int ai = 0; ai < 2; ++ai)
#pragma unroll
        for (int m = 0; m < 4; ++m)
        {
#pragma unroll
            for (int bj = 0; bj < 2; ++bj) f(row0 + ai * 128 + m * 16, col0 + bj * 128, acc[ai][bj][m][0], acc[ai][bj][m][1]);
            asm volatile("" ::: "memory"); }
}
template <class LD, class US> __device__ __forceinline__ void epi_rows_pf(const ge::Acc& acc, int row0, int col0, LD ld, US us) {
#pragma unroll
    for (int ai = 0; ai < 2; ++ai) {
        decltype(ld(0, 0)) pre[4][2];
#pragma unroll
        for (int m = 0; m < 4; ++m)
#pragma unroll
            for (int bj = 0; bj < 2; ++bj) pre[m][bj] = ld(row0 + ai * 128 + m * 16, col0 + bj * 128);
#pragma unroll
        for (int m = 0; m < 4; ++m)
#pragma unroll
            for (int bj = 0; bj < 2; ++bj) us(row0 + ai * 128 + m * 16, col0 + bj * 128, acc[ai][bj][m][0], acc[ai][bj][m][1], pre[m][bj]);
        asm volatile("" ::: "memory"); }
}
struct Pre2 { u32x4 a, b; };
__device__ __forceinline__ u32x4 pack8(f32x4 a, f32x4 b) { u32x4 w; w.x = pk2(a[0], a[1]); w.y = pk2(a[2], a[3]); w.z = pk2(b[0], b[1]); w.w = pk2(b[2], b[3]); return w; }
__device__ __forceinline__ void unpack8(u32x4 w, f32x4& a, f32x4& b) { a = (f32x4){bflo(w.x), bfhi(w.x), bflo(w.y), bfhi(w.y)}; b = (f32x4){bflo(w.z), bfhi(w.z), bflo(w.w), bfhi(w.w)}; }

struct EpiProj {
    bf16* proj; float* dtraw;
    __device__ __forceinline__ void unit(const ge::Acc& acc, const ge::GU& u, int row0, int col0) const {
        epi_rows(acc, row0, col0, [&](int row, int col, f32x4 a, f32x4 b) {
            *(u32x4*)(proj + (size_t)row * NPAD + col) = pack8(a, b);
            if (col >= CDT && col < CDT + 16) { float* d = dtraw + (size_t)row * 16 + (col - CDT); *(f32x4*)d = a; *(f32x4*)(d + 4) = b; }
        });
    }
};
struct EpiQ {
    bf16* Q; const float* rc; const float* rs;
    __device__ __forceinline__ void unit(const ge::Acc& acc, const ge::GU& u, int row0, int col0) const {
        const int fq = lane_id() >> 4;
        epi_rows(acc, row0, col0, [&](int row, int col, f32x4 a, f32x4 b) {
            const int cg = col & ~31;
            if ((cg % 96) == 64) {
                const int i0 = 8 * (fq & 1);
#pragma unroll
                for (int hf = 0; hf < 2; ++hf) {
                    f32x4& x = hf ? b : a;
                    const f32x4 c = *(const f32x4*)(rc + (size_t)row * 16 + i0 + 4 * hf), sn = *(const f32x4*)(rs + (size_t)row * 16 + i0 + 4 * hf);
                    f32x4 y;
#pragma unroll
                    for (int e = 0; e < 4; ++e) y[e] = __shfl_xor(x[e], 32);
                    x = (fq < 2) ? (x * c - y * sn) : (y * sn + x * c);
                }
            }
            *(u32x4*)(Q + (size_t)row * 768 + col) = pack8(a * QSCALE, b * QSCALE);
        });
    }
};
struct EpiStoreBf16 {
    bf16* O; int ld;
    __device__ __forceinline__ void unit(const ge::Acc& acc, const ge::GU& u, int row0, int col0) const {
        epi_rows(acc, row0, col0, [&](int row, int col, f32x4 a, f32x4 b) { *(u32x4*)(O + (size_t)row * ld + col) = pack8(a, b); });
    }
};
struct EpiGate {
    bf16* mb; const bf16* proj; int gcol0; int add;
    __device__ __forceinline__ void unit(const ge::Acc& acc, const ge::GU& u, int row0, int col0) const {
        epi_rows_pf(acc, row0, col0,
            [&](int row, int col) { Pre2 r; r.a = *(const u32x4*)(proj + (size_t)row * NPAD + gcol0 + col); r.b = r.a; if (add) r.b = *(const u32x4*)(mb + (size_t)row * D + col); return r; },
            [&](int row, int col, f32x4 a, f32x4 b, const Pre2& pr) {
            f32x4 g0, g1; unpack8(pr.a, g0, g1);
#pragma unroll
            for (int e = 0; e < 4; ++e) { a[e] *= sigmoidf_(g0[e]); b[e] *= sigmoidf_(g1[e]); }
            bf16* o = mb + (size_t)row * D + col;
            if (add) { f32x4 p0, p1; unpack8(pr.b, p0, p1); a += p0; b += p1; }
            *(u32x4*)o = pack8(a, b);
        });
    }
};
struct EpiWo {
    bf16* pre; const bf16* h;
    __device__ __forceinline__ void unit(const ge::Acc& acc, const ge::GU& u, int row0, int col0) const {
        epi_rows_pf(acc, row0, col0, [&](int row, int col) { return *(const u32x4*)(h + (size_t)row * D + col); },
            [&](int row, int col, f32x4 a, f32x4 b, const u32x4& hw) {
            f32x4 h0, h1; unpack8(hw, h0, h1);
            *(u32x4*)(pre + (size_t)row * D + col) = pack8(h0 * ALPHA + a, h1 * ALPHA + b);
        });
    }
};
struct EpiCat {
    float* logits; bf16* shhid; bf16* sg;
    __device__ __forceinline__ void unit(const ge::Acc& acc, const ge::GU& u, int row0, int col0) const {
        if (u.pn == 0) {
            epi_rows(acc, row0, col0, [&](int row, int col, f32x4 a, f32x4 b) { float* o = logits + (size_t)row * 256 + col; *(f32x4*)o = a; *(f32x4*)(o + 4) = b; });
        } else if (u.pn <= 2) {
            const int hc = (u.pn - 1) * 128 + (col0 & 127);
#pragma unroll
            for (int ai = 0; ai < 2; ++ai)
#pragma unroll
                for (int m = 0; m < 4; ++m) {
                    f32x4 g0 = acc[ai][0][m][0], g1 = acc[ai][0][m][1], u0 = acc[ai][1][m][0], u1 = acc[ai][1][m][1];
#pragma unroll
                    for (int e = 0; e < 4; ++e) { g0[e] = siluf_(g0[e]) * u0[e]; g1[e] = siluf_(g1[e]) * u1[e]; }
                    *(u32x4*)(shhid + (size_t)(row0 + ai * 128 + m * 16) * 256 + hc) = pack8(g0, g1);
                }
        } else {
            epi_rows(acc, row0, col0, [&](int row, int col, f32x4 a, f32x4 b) {
#pragma unroll
                for (int e = 0; e < 4; ++e) { a[e] = sigmoidf_(a[e]); b[e] = sigmoidf_(b[e]); }
                *(u32x4*)(sg + (size_t)row * D + (col - 768)) = pack8(a, b);
            });
        }
    }
};
struct EpiPle {
    bf16* base; const bf16* h; const bf16* sg;
    __device__ __forceinline__ void unit(const ge::Acc& acc, const ge::GU& u, int row0, int col0) const {
        epi_rows_pf(acc, row0, col0, [&](int row, int col) { Pre2 r; r.a = *(const u32x4*)(sg + (size_t)row * D + col); r.b = *(const u32x4*)(h + (size_t)row * D + col); return r; },
            [&](int row, int col, f32x4 a, f32x4 b, const Pre2& pr) {
            f32x4 g0, g1; unpack8(pr.a, g0, g1);
            f32x4 h0, h1; unpack8(pr.b, h0, h1);
            *(u32x4*)(base + (size_t)row * D + col) = pack8(h0 * ALPHA + a * g0, h1 * ALPHA + b * g1);
        });
    }
};
struct EpiAddF32 {
    bf16* base;
    __device__ __forceinline__ void unit(const ge::Acc& acc, const ge::GU& u, int row0, int col0) const {
        epi_rows_pf(acc, row0, col0, [&](int row, int col) { return *(const u32x4*)(base + (size_t)row * D + col); },
            [&](int row, int col, f32x4 a, f32x4 b, const u32x4& pw) {
            bf16* o = base + (size_t)row * D + col; f32x4 p0, p1; unpack8(pw, p0, p1);
            *(u32x4*)o = pack8(p0 + a, p1 + b);
        });
    }
};

__device__ __forceinline__ int find_expert(const LAS int* toff, int j) {
    int lo = 0, hi = NEXP;
    while (hi - lo > 1) { const int mid = (lo + hi) >> 1; if (toff[mid] <= j) lo = mid; else hi = mid; }
    return lo;
}
struct MoeGU {
    const bf16* hb; const bf16* wgu; const int* stok; bf16* hid; const LAS int* toff; int G, c, K;
    __device__ __forceinline__ bool next(int i, ge::GU& u) const {
        const int L = i * G + c, ntile = toff[NEXP]; if (L >= ntile * 2) return false;
        const int j = L >> 1, pn = L & 1, e = find_expert(toff, j);
        u.pm = j; u.pn = pn; u.x0 = e; u.A = (const char*)hb; u.B = (const char*)wgu + ((size_t)e * 512 + pn * 256) * 1024 * 2; return true;
    }
    __device__ __forceinline__ void rowoff(const ge::GU& u, const int (&R)[2], const int (&C)[2], unsigned (&v)[2][2]) const {
#pragma unroll
        for (int h = 0; h < 2; ++h)
#pragma unroll
            for (int i = 0; i < 2; ++i) v[h][i] = (unsigned)(stok[u.pm * 256 + h * 128 + R[i]] * D + C[i]) * 2u;
    }
    __device__ __forceinline__ void epi(const ge::Acc& acc, const ge::GU& u, int wr, int wc, int fr, int fq) const {
        const int slot0 = u.pm * 256 + wr * 64 + fr, hc = u.pn * 128 + wc * 32 + 8 * fq;
#pragma unroll
        for (int ai = 0; ai < 2; ++ai)
#pragma unroll
            for (int m = 0; m < 4; ++m) {
                f32x4 g0 = acc[ai][0][m][0], g1 = acc[ai][0][m][1], u0 = acc[ai][1][m][0], u1 = acc[ai][1][m][1];
#pragma unroll
                for (int e = 0; e < 4; ++e) { g0[e] = siluf_(g0[e]) * u0[e]; g1[e] = siluf_(g1[e]) * u1[e]; }
                *(u32x4*)(hid + (size_t)(slot0 + ai * 128 + m * 16) * 256 + hc) = pack8(g0, g1);
            }
    }
};
struct MoeDown {
    const bf16* hid; const bf16* wd; const float* sw; unsigned char* Y; const LAS int* toff; int G, c, K;
    __device__ __forceinline__ bool next(int i, ge::GU& u) const {
        const int L = i * G + c, ntile = toff[NEXP]; if (L >= ntile * 4) return false;
        const int j = L >> 2, pn = L & 3, e = find_expert(toff, j);
        u.pm = j; u.pn = pn; u.x0 = e; u.A = (const char*)hid + (size_t)j * 256 * 256 * 2; u.B = (const char*)wd + ((size_t)e * 1024 + pn * 256) * 256 * 2; return true;
    }
    __device__ __forceinline__ void rowoff(const ge::GU&, const int (&R)[2], const int (&C)[2], unsigned (&v)[2][2]) const {
#pragma unroll
        for (int h = 0; h < 2; ++h)
#pragma unroll
            for (int i = 0; i < 2; ++i) v[h][i] = (unsigned)((h * 128 + R[i]) * 256 + C[i]) * 2u;
    }
    __device__ __forceinline__ void epi(const ge::Acc& acc, const ge::GU& u, int wr, int wc, int fr, int fq) const {
        const int slot0 = u.pm * 256 + wr * 64 + fr, col0 = u.pn * 256 + wc * 32 + 8 * fq;
#pragma unroll
        for (int ai = 0; ai < 2; ++ai)
#pragma unroll
            for (int m = 0; m < 4; ++m) { const int slot = slot0 + ai * 128 + m * 16;
#pragma unroll
                for (int bj = 0; bj < 2; ++bj) { const f32x4 a = acc[ai][bj][m][0] * YSCALE, bq = acc[ai][bj][m][1] * YSCALE;
                    int w0 = __builtin_amdgcn_cvt_pk_fp8_f32(a[0], a[1], 0, false); w0 = __builtin_amdgcn_cvt_pk_fp8_f32(a[2], a[3], w0, true);
                    int w1 = __builtin_amdgcn_cvt_pk_fp8_f32(bq[0], bq[1], 0, false); w1 = __builtin_amdgcn_cvt_pk_fp8_f32(bq[2], bq[3], w1, true);
                    *(u32x2*)(Y + (size_t)slot * D + col0 + bj * 128) = (u32x2){(unsigned)w0, (unsigned)w1}; } }
    }
};

__device__ __forceinline__ void transpose_item(const float* W, int ld, int K, int nvalid, int col0, bf16* WT, int dst_row, int kb, LAS float* scr, int lane) {
    const int k0 = 64 * kb, n4 = lane & 7, kq = lane >> 3, cc = col0 + 4 * n4; const bool ok = cc < nvalid;
    const float* src = W + (size_t)(k0 + kq) * ld + cc;
    f32x4 v[8];
#pragma unroll
    for (int i = 0; i < 8; ++i) v[i] = ok ? *(const f32x4*)(src + (size_t)(8 * i) * ld) : (f32x4){0.f, 0.f, 0.f, 0.f};
#pragma unroll
    for (int i = 0; i < 8; ++i) { LAS float* d = scr + (8 * i + kq) * 33 + 4 * n4; d[0] = v[i][0]; d[1] = v[i][1]; d[2] = v[i][2]; d[3] = v[i][3]; }
    LDS_WAIT(); asm volatile("" ::: "memory");
    const int c = lane & 7;
#pragma unroll
    for (int j = 0; j < 4; ++j) { const int n = (lane >> 3) + 8 * j; const LAS float* s_ = scr + (8 * c) * 33 + n;
        u32x4 o; o.x = pk2(s_[0 * 33], s_[1 * 33]); o.y = pk2(s_[2 * 33], s_[3 * 33]); o.z = pk2(s_[4 * 33], s_[5 * 33]); o.w = pk2(s_[6 * 33], s_[7 * 33]);
        *(u32x4*)(WT + (size_t)(dst_row + n) * K + k0 + 8 * c) = o; }
    LDS_WAIT(); asm volatile("" ::: "memory");
}
#define TJOB(src_, ld_, K_, nvalid_, nrows_, dst_) { const int ni_ = ((K_) / 64) * ((nrows_) / 32); if (r < ni_) { const int nbk_ = (nrows_) / 32; \
        transpose_item((src_), (ld_), (K_), (nvalid_), 32 * (r % nbk_), (dst_), 32 * (r % nbk_), r / nbk_, scr, F.lane); continue; } r -= ni_; }
constexpr int ITEMS_SMALL = 16 * 168 + 6 * 24 + 4 * 32 + 8 * 32 + 16 * 32 + 16 * 32 + 16 * (8 + 4 * 4 + 32) + 4 * 32 + 4 * 32;
constexpr int ITEMS_EXP = NEXP * 384;
__device__ __forceinline__ void p0_small_weights(Frame& F) {
    LAS float* scr = (LAS float*)(F.lds + RING_OFF + F.wave * 16384);
    const int gw = F.vcu * NWAVES + F.wave, NGW = F.G * NWAVES;
    for (int it = gw; it < DEPTH * ITEMS_SMALL; it += NGW) {
        const int L = it / ITEMS_SMALL; int r = it % ITEMS_SMALL;
        unsigned char* wl = F.ws + WS_WSM + (size_t)L * WSM_LAYER;
        const float* w_in = (const float*)F.in[3] + (size_t)L * 1024 * NCOLS;
        TJOB(w_in, NCOLS, 1024, NCOLS, NPAD, (bf16*)(wl + WO_WIN));
        TJOB((const float*)F.in[5] + (size_t)L * 384 * 768, 768, 384, 768, 768, (bf16*)(wl + WO_WQ));
        TJOB((const float*)F.in[7] + (size_t)L * 256 * 1024, 1024, 256, 1024, 1024, (bf16*)(wl + WO_WKV));
        TJOB((const float*)F.in[14] + (size_t)L * 512 * 1024, 1024, 512, 1024, 1024, (bf16*)(wl + WO_WAB));
        TJOB((const float*)F.in[15] + (size_t)L * 1024 * 1024, 1024, 1024, 1024, 1024, (bf16*)(wl + WO_WSB));
        TJOB((const float*)F.in[16] + (size_t)L * 1024 * 1024, 1024, 1024, 1024, 1024, (bf16*)(wl + WO_WO));
        bf16* wcat = (bf16*)(wl + WO_WCAT);
        const float* shg = (const float*)F.in[24] + (size_t)L * 1024 * 256; const float* shu = (const float*)F.in[25] + (size_t)L * 1024 * 256;
        TJOB((const float*)F.in[19] + (size_t)L * 1024 * 256, 256, 1024, 256, 256, wcat);
        TJOB(shg, 256, 1024, 128, 128, wcat + (size_t)256 * 1024);
        TJOB(shu, 256, 1024, 128, 128, wcat + (size_t)384 * 1024);
        TJOB(shg + 128, 256, 1024, 128, 128, wcat + (size_t)512 * 1024);
        TJOB(shu + 128, 256, 1024, 128, 128, wcat + (size_t)640 * 1024);
        TJOB((const float*)F.in[28] + (size_t)L * 1024 * 1024, 1024, 1024, 1024, 1024, wcat + (size_t)768 * 1024);
        TJOB((const float*)F.in[26] + (size_t)L * 256 * 1024, 1024, 256, 1024, 1024, (bf16*)(wl + WO_WSD));
        TJOB((const float*)F.in[27] + (size_t)L * 256 * 1024, 1024, 256, 1024, 1024, (bf16*)(wl + WO_WPLE));
    }
}
__device__ __forceinline__ void p0_expert_weights(Frame& F, int L) {
    LAS float* scr = (LAS float*)(F.lds + RING_OFF + F.wave * 16384);
    int lane_ = F.lane; asm volatile("" : "+v"(lane_));
    const int gw = F.vcu * NWAVES + F.wave, NGW = F.G * NWAVES, lane = lane_, n4 = lane & 7, kq = lane >> 3;
    const float* wg = (const float*)F.in[21] + (size_t)L * NEXP * 1024 * 256; const float* wu = (const float*)F.in[22] + (size_t)L * NEXP * 1024 * 256;
    const float* wd = (const float*)F.in[23] + (size_t)L * NEXP * 256 * 1024;
    bf16* wgu_t = (bf16*)(F.ws + WS_WGU + (size_t)L * WGU_LAYER); bf16* wd_t = (bf16*)(F.ws + WS_WD + (size_t)L * WD_LAYER);
#define TP_DECODE(it_, SRC, LD, DST, KK) do { const int e_ = (it_) / 384, r_ = (it_) % 384, which_ = r_ >> 7, rr_ = r_ & 127; \
        if (which_ < 2) { const int kb_ = rr_ >> 3, nb_ = rr_ & 7; LD = 256; KK = 1024; \
            SRC = (which_ ? wu : wg) + (size_t)e_ * 1024 * 256 + (size_t)(64 * kb_ + kq) * 256 + 32 * nb_ + 4 * n4; \
            DST = wgu_t + (size_t)e_ * 512 * 1024 + (size_t)((nb_ >> 2) * 256 + which_ * 128 + 32 * (nb_ & 3)) * 1024 + 64 * kb_; } \
        else { const int kb_ = rr_ >> 5, nb_ = rr_ & 31; LD = 1024; KK = 256; \
            SRC = wd + (size_t)e_ * 256 * 1024 + (size_t)(64 * kb_ + kq) * 1024 + 32 * nb_ + 4 * n4; \
            DST = wd_t + (size_t)e_ * 1024 * 256 + (size_t)(32 * nb_) * 256 + 64 * kb_; } } while (0)
#define TP_LOAD(BUF, DSTV, KV, item) do { const float* s__; int ld__; TP_DECODE((item), s__, ld__, DSTV, KV); \
        _Pragma("unroll") for (int i = 0; i < 8; ++i) asm volatile("global_load_dwordx4 %0, %1, off nt" : "=v"(BUF[i]) : "v"(s__ + (size_t)(8 * i) * ld__) : "memory"); } while (0)
#define TP_WAIT7(BUF) asm volatile("s_waitcnt vmcnt(7)" ::: "memory")
#define TP_PROC(BUF, DSTV, KV) do { \
        _Pragma("unroll") for (int i = 0; i < 8; ++i) { LAS float* d = scr + (8 * i + kq) * 33 + 4 * n4; d[0] = BUF[i][0]; d[1] = BUF[i][1]; d[2] = BUF[i][2]; d[3] = BUF[i][3]; } \
        LDS_WAIT(); asm volatile("" ::: "memory"); \
        _Pragma("unroll") for (int j = 0; j < 4; ++j) { const int n = (lane >> 3) + 8 * j; const LAS float* s_ = scr + (8 * (lane & 7)) * 33 + n; \
            u32x4 o; o.x = pk2(s_[0 * 33], s_[1 * 33]); o.y = pk2(s_[2 * 33], s_[3 * 33]); o.z = pk2(s_[4 * 33], s_[5 * 33]); o.w = pk2(s_[6 * 33], s_[7 * 33]); \
            __builtin_nontemporal_store(o, (u32x4*)(DSTV + (size_t)n * KV + 8 * (lane & 7))); } \
        LDS_WAIT(); asm volatile("" ::: "memory"); } while (0)
#define TP_WAIT0(BUF) asm volatile("s_waitcnt vmcnt(0)" ::: "memory")
    for (int it = gw; it < ITEMS_EXP; it += 2 * NGW) {
        f32x4 b0[8], b1[8]; bf16 *d0, *d1 = wgu_t; int K0, K1 = 0;
        const bool two = it + NGW < ITEMS_EXP;
        TP_LOAD(b0, d0, K0, it);
        if (two) { TP_LOAD(b1, d1, K1, it + NGW); TP_WAIT7(b0); } else TP_WAIT0(b0);
        TP_PROC(b0, d0, K0);
        if (two) { TP_WAIT0(b1); TP_PROC(b1, d1, K1); }
    }
#undef TP_WAIT0
#undef TP_WAIT7
#undef TP_PROC
#undef TP_LOAD
#undef TP_DECODE
}
__device__ __forceinline__ bool conv_acquire(Frame& F, int L, bool block) {
    volatile LAS int* flag = (volatile LAS int*)(F.lds + LDSCTL_OFF + 384);
    unsigned* sem = (unsigned*)(F.ctl + CW_SEM + 64 * L);
    if (cur_tid() == 0) {
        int ok = 0;
        for (;;) {
            const unsigned old = __hip_atomic_fetch_add(sem, 1u, __ATOMIC_RELAXED, __HIP_MEMORY_SCOPE_AGENT);
            if (old < CONV_LIMIT) { ok = 1; break; }
            __hip_atomic_fetch_sub(sem, 1u, __ATOMIC_RELAXED, __HIP_MEMORY_SCOPE_AGENT);
            if (!block) break;
            __builtin_amdgcn_s_sleep(64);
        }
        *flag = ok;
    }
    WG_BAR();
    const int ok = __builtin_amdgcn_readfirstlane(*flag);
    WG_BAR();
    return ok != 0;
}
__device__ __forceinline__ void conv_release(Frame& F, int L) {
    if (cur_tid() == 0) __hip_atomic_fetch_sub((unsigned*)(F.ctl + CW_SEM + 64 * L), 1u, __ATOMIC_RELAXED, __HIP_MEMORY_SCOPE_AGENT);
}
__device__ __forceinline__ void p0_misc(Frame& F) {
    const int gw = F.vcu * NWAVES + F.wave, NGW = F.G * NWAVES;
    const float* x = (const float*)F.in[0]; bf16* hb = (bf16*)(F.ws + WS_HB);
    for (int m0 = gw; m0 < T; m0 += 2 * NGW) {
        const bool two = m0 + NGW < T; const int m1 = two ? m0 + NGW : m0;
        f32x4 v[2][4];
#pragma unroll
        for (int r = 0; r < 2; ++r) { const f32x4* xr = (const f32x4*)(x + (size_t)(r ? m1 : m0) * D) + F.lane;
#pragma unroll
            for (int j = 0; j < 4; ++j) v[r][j] = xr[64 * j]; }
#pragma unroll
        for (int r = 0; r < 2; ++r) { if (r == 1 && !two) break; u32x2* hr = (u32x2*)(hb + (size_t)(r ? m1 : m0) * D) + F.lane;
#pragma unroll
            for (int j = 0; j < 4; ++j) hr[64 * j] = (u32x2){pk2(v[r][j][0], v[r][j][1]), pk2(v[r][j][2], v[r][j][3])}; }
    }
    const int* pos = (const int*)F.in[2]; float* rc = (float*)(F.ws + WS_ROPE); float* rs = rc + (size_t)T * 16;
    const double cfr[16] = {0.15915494309189535, 0.08949940160889101, 0.050329212104487035, 0.0283021958306234, 0.015915494309189534, 0.008949940160889102, 0.005032921210448704, 0.00283021958306234,
                            0.0015915494309189536, 0.0008949940160889102, 0.0005032921210448703, 0.00028302195830623395, 0.00015915494309189535, 8.949940160889102e-05, 5.0329212104487035e-05, 2.8302195830623396e-05};
    for (int idx = (F.vcu * NWAVES * 64) + F.tid; idx < T * 16; idx += F.G * NWAVES * 64) {
        const int t = idx >> 4, i = idx & 15; double rev = (double)pos[t] * cfr[i]; rev -= __builtin_floor(rev);
        rc[idx] = __builtin_amdgcn_cosf((float)rev); rs[idx] = __builtin_amdgcn_sinf((float)rev);
    }
}

__device__ __forceinline__ void prep_rows(Frame& F, int L) {
    const int gw = F.vcu * NWAVES + F.wave, NGW = F.G * NWAVES, lane = F.lane;
    const bf16* proj = (const bf16*)(F.ws + X_PROJ); bf16* qn = (bf16*)(F.ws + X_QN); bf16* ckvn = (bf16*)(F.ws + X_CKVN); bf16* kpe = (bf16*)(F.ws + X_KPE);
    const float* qg = (const float*)F.in[4] + L * 384; const float* kg = (const float*)F.in[6] + L * 256;
    const float* rc = (const float*)(F.ws + WS_ROPE); const float* rs = rc + (size_t)T * 16;
    float gq[6], gk[4];
#pragma unroll
    for (int j = 0; j < 6; ++j) gq[j] = qg[lane * 2 + (j & 1) + 128 * (j >> 1)];
#pragma unroll
    for (int j = 0; j < 4; ++j) gk[j] = kg[lane * 4 + j];
    for (int t0 = gw; t0 < T; t0 += 2 * NGW) {
        const bool two = t0 + NGW < T; const int t1 = two ? t0 + NGW : t0;
        unsigned qw[2][3]; u32x2 kw[2]; float xv[2], cc[2], ss[2];
#pragma unroll
        for (int r = 0; r < 2; ++r) { const int t = r ? t1 : t0; const bf16* pr = proj + (size_t)t * NPAD;
#pragma unroll
            for (int j = 0; j < 3; ++j) qw[r][j] = *(const unsigned*)(pr + CQ + 128 * j + 2 * lane);
            kw[r] = *(const u32x2*)(pr + CKV + 4 * lane);
            xv[r] = bf2f(pr[CKPE + (lane & 31)]); cc[r] = rc[(size_t)t * 16 + (lane & 15)]; ss[r] = rs[(size_t)t * 16 + (lane & 15)]; }
#pragma unroll
        for (int r = 0; r < 2; ++r) { if (r == 1 && !two) break; const int t = r ? t1 : t0;
            float q[6], k[4];
#pragma unroll
            for (int j = 0; j < 3; ++j) { q[2 * j] = bflo(qw[r][j]); q[2 * j + 1] = bfhi(qw[r][j]); }
            k[0] = bflo(kw[r].x); k[1] = bfhi(kw[r].x); k[2] = bflo(kw[r].y); k[3] = bfhi(kw[r].y);
            float sq = 0.f, sk = 0.f;
#pragma unroll
            for (int j = 0; j < 6; ++j) sq += q[j] * q[j];
#pragma unroll
            for (int j = 0; j < 4; ++j) sk += k[j] * k[j];
            sq = wave_sum(sq); sk = wave_sum(sk);
            const float rq = __builtin_amdgcn_rsqf(sq * (1.f / 384.f) + 1e-6f), rk = __builtin_amdgcn_rsqf(sk * (1.f / 256.f) + 1e-6f);
#pragma unroll
            for (int j = 0; j < 3; ++j) *(unsigned*)(qn + (size_t)t * 384 + 128 * j + 2 * lane) = pk2(q[2 * j] * rq * gq[2 * j], q[2 * j + 1] * rq * gq[2 * j + 1]);
            *(u32x2*)(ckvn + (size_t)t * 256 + 4 * lane) = (u32x2){pk2(k[0] * rk * gk[0], k[1] * rk * gk[1]), pk2(k[2] * rk * gk[2], k[3] * rk * gk[3])};
            const float yv = __shfl_xor(xv[r], 16);
            const float o = (lane & 16) ? (yv * ss[r] + xv[r] * cc[r]) : (xv[r] * cc[r] - yv * ss[r]);
            if (lane < 32) kpe[(size_t)t * 32 + lane] = f2bf(o); }
    }
}
template <bool COMBINE, bool OUT32> __device__ __forceinline__ void ln_rows(Frame& F, const bf16* src, const float* g, const float* b, const int* rpos, const unsigned char* Y8, const float* rwt) {
    const int gw = F.vcu * NWAVES + F.wave, NGW = F.G * NWAVES, lane = F.lane;
    bf16* hb = (bf16*)(F.ws + WS_HB);
    f32x4 gv[4], bv[4];
#pragma unroll
    for (int j = 0; j < 4; ++j) { gv[j] = *((const f32x4*)g + 4 * lane + j); bv[j] = *((const f32x4*)b + 4 * lane + j); }
    for (int t = gw; t < T; t += NGW) {
        f32x4 v[4];
#pragma unroll
        for (int i = 0; i < 2; ++i) { const u32x4 w = *((const u32x4*)(src + (size_t)t * D) + 2 * lane + i); unpack8(w, v[2 * i], v[2 * i + 1]); }
        if (COMBINE) {
            const int slot = rpos[t * TOPK + (lane & 7)]; const float wgt = rwt[t * TOPK + (lane & 7)] * (1.f / YSCALE);
            f32x4 ra[4] = {{0.f, 0.f, 0.f, 0.f}, {0.f, 0.f, 0.f, 0.f}, {0.f, 0.f, 0.f, 0.f}, {0.f, 0.f, 0.f, 0.f}};
#pragma unroll
            for (int k = 0; k < TOPK; ++k) { const int sl = __builtin_amdgcn_readlane(slot, k); const u32x4 w = *((const u32x4*)(Y8 + (size_t)sl * D) + lane);
                const unsigned ww[4] = {w.x, w.y, w.z, w.w};
                const float wk = __uint_as_float(__builtin_amdgcn_readlane(__float_as_uint(wgt), k));
#pragma unroll
                for (int j = 0; j < 4; ++j) { const f32x2 lo = __builtin_amdgcn_cvt_pk_f32_fp8((int)ww[j], false), hi = __builtin_amdgcn_cvt_pk_f32_fp8((int)ww[j], true); ra[j] += (f32x4){lo[0], lo[1], hi[0], hi[1]} * wk; } }
#pragma unroll
            for (int j = 0; j < 4; ++j) v[j] += ra[j];
        }
        float s = 0.f;
#pragma unroll
        for (int j = 0; j < 4; ++j) s += (v[j][0] + v[j][1]) + (v[j][2] + v[j][3]);
        const float mean = wave_sum(s) * (1.f / D); float s2 = 0.f;
#pragma unroll
        for (int j = 0; j < 4; ++j) { v[j] = v[j] - mean; s2 += (v[j][0] * v[j][0] + v[j][1] * v[j][1]) + (v[j][2] * v[j][2] + v[j][3] * v[j][3]); }
        const float rstd = __builtin_amdgcn_rsqf(wave_sum(s2) * (1.f / D) + 1e-5f);
        f32x4 o[4];
#pragma unroll
        for (int j = 0; j < 4; ++j) { o[j] = v[j] * rstd * gv[j] + bv[j]; if (OUT32) *((f32x4*)(F.out + (size_t)t * D) + 4 * lane + j) = o[j]; }
        if (!OUT32) {
#pragma unroll
        for (int i = 0; i < 2; ++i) *((u32x4*)(hb + (size_t)t * D) + 2 * lane + i) = pack8(o[2 * i], o[2 * i + 1]); }
    }
}
__device__ __forceinline__ void conv_p(Frame& F, int L) {
    const float* p = (const float*)F.in[1] + (size_t)L * T * 256; bf16* pb = (bf16*)(F.ws + X_PB);
    const size_t n = (size_t)T * 256 / 4, st = (size_t)F.G * NWAVES * 64;
    for (size_t i = (size_t)(F.vcu * NWAVES * 64 + F.tid); i < n; i += 4 * st) {
        f32x4 v[4];
#pragma unroll
        for (int k = 0; k < 4; ++k) if (i + k * st < n) v[k] = ((const f32x4*)p)[i + k * st];
#pragma unroll
        for (int k = 0; k < 4; ++k) if (i + k * st < n) ((u32x2*)pb)[i + k * st] = (u32x2){pk2(v[k][0], v[k][1]), pk2(v[k][2], v[k][3])}; }
}

template <int CTRL> __device__ __forceinline__ float dppf(float v) { return __int_as_float(__builtin_amdgcn_update_dpp(0, __float_as_int(v), CTRL, 0xF, 0xF, false)); }
__device__ __forceinline__ float rdlane(float v, int l) { return __uint_as_float(__builtin_amdgcn_readlane(__float_as_uint(v), l)); }
__device__ __forceinline__ float wave_max_uniform(float v) {
    v = fmaxf(v, dppf<0xB1>(v)); v = fmaxf(v, dppf<0x4E>(v)); v = fmaxf(v, dppf<0x141>(v)); v = fmaxf(v, dppf<0x140>(v));
    return fmaxf(fmaxf(rdlane(v, 0), rdlane(v, 16)), fmaxf(rdlane(v, 32), rdlane(v, 48)));
}
__device__ __forceinline__ void topk_rows(Frame& F, int L) {
    const int gw = F.vcu * NWAVES + F.wave, NGW = F.G * NWAVES, lane = F.lane;
    const float* logits = (const float*)(F.ws + X_LOGITS); int* ridx = (int*)(F.ws + X_RIDX); float* rw = (float*)(F.ws + X_RW); int* rrank = (int*)(F.ws + X_RRANK);
    unsigned* cnt = (unsigned*)(F.ctl + CW_CNT + L * NEXP);
    const f32x4 bias = *((const f32x4*)((const float*)F.in[20] + L * NEXP) + lane);
    const int g = lane >> 3;
    auto route = [&](const f32x4& lg, int& myidx, float& mysc, float& ssum) {
        float sc[4], sel[4];
#pragma unroll
        for (int j = 0; j < 4; ++j) { sc[j] = __builtin_amdgcn_rcpf(1.f + __expf(-lg[j])); sel[j] = sc[j] + bias[j]; }
        float m1 = fmaxf(sel[0], sel[1]), m2 = fminf(sel[0], sel[1]);
        { const float a = fmaxf(sel[2], sel[3]), bb = fminf(sel[2], sel[3]); const float n1 = fmaxf(m1, a), n2 = fmaxf(fminf(m1, a), fmaxf(m2, bb)); m1 = n1; m2 = n2; }
#define TK_MERGE(CTRL) do { const float a1 = dppf<CTRL>(m1), a2 = dppf<CTRL>(m2); const float n1 = fmaxf(m1, a1), n2 = fmaxf(fminf(m1, a1), fmaxf(m2, a2)); m1 = n1; m2 = n2; } while (0)
        TK_MERGE(0xB1); TK_MERGE(0x4E); TK_MERGE(0x141);
#undef TK_MERGE
        const float gs = m1 + m2; int rank = 0;
#pragma unroll
        for (int j = 0; j < 8; ++j) { const float o = rdlane(gs, 8 * j); rank += (o > gs || (o == gs && j < g)) ? 1 : 0; }
        if (rank >= 4) {
#pragma unroll
            for (int j = 0; j < 4; ++j) sel[j] = -INFINITY; }
        myidx = 0; mysc = 0.f; ssum = 0.f;
#pragma unroll
        for (int k = 0; k < TOPK; ++k) {
            float bv = sel[0]; int bi = 0;
#pragma unroll
            for (int j = 1; j < 4; ++j) if (sel[j] > bv) { bv = sel[j]; bi = j; }
            const float wmax = wave_max_uniform(bv);
            const unsigned long long mask = __ballot(bv == wmax);
            const int wl = (int)__builtin_ctzll(mask);
            const int wj = __builtin_amdgcn_readlane(bi, wl);
            const float cand = (wj == 0) ? sc[0] : (wj == 1) ? sc[1] : (wj == 2) ? sc[2] : sc[3];
            const float wsc = rdlane(cand, wl);
            if (lane == wl) {
#pragma unroll
                for (int j = 0; j < 4; ++j) if (wj == j) sel[j] = -INFINITY; }
            ssum += wsc;
            if (lane == k) { myidx = 4 * wl + wj; mysc = wsc; }
        }
    };
    for (int t0 = gw; t0 < T; t0 += 2 * NGW) {
        const bool two = t0 + NGW < T; const int t1 = two ? t0 + NGW : t0;
        const f32x4 lg0 = *((const f32x4*)(logits + (size_t)t0 * NEXP) + lane), lg1 = *((const f32x4*)(logits + (size_t)t1 * NEXP) + lane);
        int i0, i1; float s0, s1, q0, q1;
        route(lg0, i0, s0, q0); route(lg1, i1, s1, q1);
        if (lane < TOPK) {
            const float w0 = s0 * __builtin_amdgcn_rcpf(q0) * 2.5f, w1 = s1 * __builtin_amdgcn_rcpf(q1) * 2.5f;
            const unsigned r0 = __hip_atomic_fetch_add(cnt + i0, 1u, __ATOMIC_RELAXED, __HIP_MEMORY_SCOPE_AGENT);
            unsigned r1 = 0; if (two) r1 = __hip_atomic_fetch_add(cnt + i1, 1u, __ATOMIC_RELAXED, __HIP_MEMORY_SCOPE_AGENT);
            ridx[t0 * TOPK + lane] = i0; rw[t0 * TOPK + lane] = w0; rrank[t0 * TOPK + lane] = (int)r0;
            if (two) { ridx[t1 * TOPK + lane] = i1; rw[t1 * TOPK + lane] = w1; rrank[t1 * TOPK + lane] = (int)r1; }
        }
    }
}
__device__ __forceinline__ void build_toff(Frame& F, int L, LAS int* toff) {
    const unsigned* cnt = (const unsigned*)(F.ctl + CW_CNT + L * NEXP);
    if (F.wave == 0) {
        int run = 0;
#pragma unroll
        for (int j = 0; j < 4; ++j) {
            const int e = 64 * j + F.lane; const int nt = ((int)__hip_atomic_load(cnt + e, __ATOMIC_RELAXED, __HIP_MEMORY_SCOPE_AGENT) + 255) >> 8;
            int inc = nt;
#pragma unroll
            for (int o = 1; o < 64; o <<= 1) { const int v = __shfl_up(inc, o); if (F.lane >= o) inc += v; }
            toff[e] = run + inc - nt; run += __shfl(inc, 63);
        }
        if (F.lane == 0) toff[NEXP] = run;
    }
    WG_BAR();
}
__device__ __forceinline__ void scatter_slots(Frame& F, int L, const LAS int* toff) {
    const int* ridx = (const int*)(F.ws + X_RIDX); const float* rw = (const float*)(F.ws + X_RW); int* rrank = (int*)(F.ws + X_RRANK);
    int* stok = (int*)(F.ws + X_STOK); float* sw = (float*)(F.ws + X_SW);
    const unsigned* cnt = (const unsigned*)(F.ctl + CW_CNT + L * NEXP);
    for (int i = F.vcu * NWAVES * 64 + F.tid; i < T * TOPK; i += F.G * NWAVES * 64) {
        const int e = ridx[i], slot = 256 * toff[e] + rrank[i];
        stok[slot] = i >> 3; sw[slot] = rw[i]; rrank[i] = slot;
    }
    for (int e = F.vcu; e < NEXP; e += F.G) {
        const int n = (int)__hip_atomic_load(cnt + e, __ATOMIC_RELAXED, __HIP_MEMORY_SCOPE_AGENT), s0 = 256 * toff[e] + n, s1 = 256 * toff[e + 1];
        for (int s = s0 + F.tid; s < s1; s += NWAVES * 64) { stok[s] = 0; sw[s] = 0.f; }
    }
}

namespace at {
constexpr int KSLOT = 12288, VSLOT = 8192, LDS_K = 0, LDS_V = 4 * KSLOT, LDS_WS = LDS_V + 3 * VSLOT, LDS_END = LDS_WS + 8 * 256;
__device__ __forceinline__ void glds16(const void* gsrc, unsigned lds_dst) { unsigned keep;
    asm volatile("s_mov_b32 %0, m0\n\ts_mov_b32 m0, %2\n\ts_nop 0\n\tglobal_load_lds_dwordx4 %1, off\n\ts_mov_b32 m0, %0" : "=&s"(keep) : "v"(gsrc), "s"(lds_dst) : "memory"); }
#define AT_SBAR() __builtin_amdgcn_sched_barrier(0)
#define AT_PIN(x) asm volatile("" : "+v"(x))
#define AT_MF(a, b, c) __builtin_amdgcn_mfma_f32_32x32x16_bf16(a, b, c, 0, 0, 0)
#define AT_MX3(a, b, c) __builtin_fmaxf(__builtin_fmaxf((a), (b)), (c))
__device__ __forceinline__ float rowmax(const f32x16& p0, const f32x16& p1) {
    float a = AT_MX3(p0[0], p0[1], p1[0]), b = AT_MX3(p0[2], p0[3], p1[1]); a = AT_MX3(a, p1[2], p1[3]);
#pragma unroll
    for (int r = 4; r < 16; r += 4) { a = AT_MX3(a, p0[r], p0[r + 1]); b = AT_MX3(b, p0[r + 2], p0[r + 3]); a = AT_MX3(a, p1[r], p1[r + 1]); b = AT_MX3(b, p1[r + 2], p1[r + 3]); }
    const float m = __builtin_fmaxf(a, b); auto rr = __builtin_amdgcn_permlane32_swap(__float_as_uint(m), __float_as_uint(m), false, false);
    return __builtin_fmaxf(__uint_as_float(rr[0]), __uint_as_float(rr[1])); }
__device__ __forceinline__ void cmask(f32x16& p0, f32x16& p1, int jb, int qrel, int hi) {
    const int kb = 64 * jb + 4 * hi;
#pragma unroll
    for (int r = 0; r < 16; ++r) { const int kv = kb + (r & 3) + 8 * (r >> 2); if (kv > qrel) p0[r] = -INFINITY; if (kv + 32 > qrel) p1[r] = -INFINITY; } }
__device__ __forceinline__ void attn_unit(int b, int h, int qb, const bf16* Q, const bf16* KV, const bf16* KPE, bf16* O, LAS unsigned char* shm) {
    int tid_ = cur_tid(); asm volatile("" : "+v"(tid_));
    const int tid = tid_, lane = tid & 63, r32 = lane & 31, hi = lane >> 5; const int wid = __builtin_amdgcn_readfirstlane(tid >> 6);
    const size_t tb = (size_t)b * SEQ; const int q0 = qb * 256;
    const unsigned lds0 = (unsigned)(size_t)shm;
    LAS float* wsf = (LAS float*)(shm + LDS_WS) + wid * 64;
    const int NT = (q0 + 256) / 64;
    bf16x8 qr[6];
    { const bf16* qp = Q + (tb + q0 + wid * 32 + r32) * 768 + h * 96 + hi * 8;
#pragma unroll
      for (int d0 = 0; d0 < 6; ++d0) qr[d0] = *(const bf16x8*)(qp + d0 * 16); }
    asm volatile("s_waitcnt vmcnt(0)" ::: "memory");
    const bf16* ksrc0 = KV + (tb + lane) * 1024 + h * 128 + wid * 8;
    const bf16* ksrc1 = KPE + (tb + lane) * 32 + (wid & 3) * 8;
    const bf16* vsrc = KV + (tb + 16 * (wid & 3) + (lane >> 2)) * 1024 + h * 128 + 64 + (wid >> 2) * 32 + (lane & 3) * 8;
#define AT_DMAK(t, s) do { glds16(ksrc0 + (size_t)(t) * 64 * 1024, (unsigned)__builtin_amdgcn_readfirstlane(lds0 + LDS_K + (s) * KSLOT + wid * 1024)); \
        if (wid < 4) glds16(ksrc1 + (size_t)(t) * 64 * 32, (unsigned)__builtin_amdgcn_readfirstlane(lds0 + LDS_K + (s) * KSLOT + (8 + wid) * 1024)); } while (0)
#define AT_DMAV(t, s) glds16(vsrc + (size_t)(t) * 64 * 1024, (unsigned)__builtin_amdgcn_readfirstlane(lds0 + LDS_V + (s) * VSLOT + wid * 1024))
#define AT_WAITC() do { if (wid < 4) asm volatile("s_waitcnt vmcnt(3) lgkmcnt(0)\n\ts_barrier" ::: "memory"); else asm volatile("s_waitcnt vmcnt(2) lgkmcnt(0)\n\ts_barrier" ::: "memory"); } while (0)
#define AT_WAIT0() asm volatile("s_waitcnt vmcnt(0) lgkmcnt(0)\n\ts_barrier" ::: "memory")
    AT_DMAK(0, 0); AT_DMAV(0, 0); AT_DMAK(1, 1); AT_DMAK(2, 2);
    constexpr float THR = 8.f;
    float mhat = 0.f, l_reg = 0.f; f32x2 mh2 = {0.f, 0.f}; f32x16 o0 = {}, o1 = {}; const f32x16 zero16 = {};
    const int qrel = wid * 32 + r32;
    bool resc = false;
    f32x16 pA0, pA1, pB0, pB1; bf16x8 kf[12]; s16x4 vlo[8], vhi[8]; u32x4 pw0, pw1, pw2, pw3;
    LAS const unsigned char* const kp0 = shm + LDS_K + hi * 1024 + r32 * 16;
    LAS const unsigned char* const vp0 = shm + LDS_V + ((lane >> 4) & 1) * 32 + (lane & 3) * 8 + (4 * hi + ((lane & 15) >> 2)) * 64;
    int sl_prev = 0, sl_cur = 0, sl_next = 1;
#define AT_ROT() do { sl_prev = sl_cur; sl_cur = sl_next; sl_next = (sl_next == 2) ? 0 : sl_next + 1; } while (0)
#define AT_KRDP(kp_, d0) do { kf[2 * (d0)] = *(LAS const bf16x8*)((kp_) + (d0) * 2048); kf[2 * (d0) + 1] = *(LAS const bf16x8*)((kp_) + (d0) * 2048 + 512); } while (0)
#define AT_KRD(d0) AT_KRDP(kp_, d0)
#define AT_VRD(i) do { vlo[i] = ldstr(vp_ + (((i) >> 2) * 4096 + ((i) & 3) * 1024)); vhi[i] = ldstr(vp_ + (((i) >> 2) * 4096 + ((i) & 3) * 1024 + 512)); } while (0)
#define AT_VFR(i) (bf16x8){vlo[i][0], vlo[i][1], vlo[i][2], vlo[i][3], vhi[i][0], vhi[i][1], vhi[i][2], vhi[i][3]}
#define AT_PAF(k) __builtin_bit_cast(bf16x8, pw##k)
#define AT_PK(P, i) pk2(P[i], P[i + 1])
#define AT_EX(X, i) X[i] = __builtin_amdgcn_exp2f(X[i])
#define AT_RESC() do { if (resc) { _Pragma("unroll") for (int r = 0; r < 16; ++r) { const float f = wsf[crow(r, hi)]; o0[r] *= f; o1[r] *= f; } } } while (0)
    if (wid < 4) asm volatile("s_waitcnt vmcnt(2) lgkmcnt(0)\n\ts_barrier" ::: "memory"); else asm volatile("s_waitcnt vmcnt(1) lgkmcnt(0)\n\ts_barrier" ::: "memory");
    AT_DMAK(3, 3); AT_DMAV(1, 1);
    { LAS const unsigned char* kp_ = kp0;
      _Pragma("unroll") for (int d0 = 0; d0 < 6; ++d0) AT_KRD(d0);
      pA0 = AT_MF(kf[0], qr[0], zero16); pA1 = AT_MF(kf[1], qr[0], zero16);
      _Pragma("unroll") for (int d0 = 1; d0 < 6; ++d0) { pA0 = AT_MF(kf[2 * d0], qr[d0], pA0); pA1 = AT_MF(kf[2 * d0 + 1], qr[d0], pA1); } }
    if (NT == 4) cmask(pA0, pA1, 0, qrel, hi);
    { mhat = rowmax(pA0, pA1); mh2 = (f32x2){-mhat, -mhat}; AT_PIN(mh2);
#pragma unroll
      for (int r = 0; r < 16; ++r) pA0[r] = __builtin_amdgcn_exp2f(pA0[r] - mhat); }
    AT_KRDP(kp0 + KSLOT, 0); AT_KRDP(kp0 + KSLOT, 1);
    sl_prev = 0; sl_cur = 1; sl_next = 2;
#define AT_GA(MFS, FILL) do { MFS; FILL; AT_SBAR(); } while (0)
#define AT_EX2(X, i) do { f32x2 x_ = {X[i], X[(i) + 1]}; x_ += mh2; X[i] = __builtin_amdgcn_exp2f(x_[0]); X[(i) + 1] = __builtin_amdgcn_exp2f(x_[1]); } while (0)
#define AT_SUM2(X, i) s2 += (f32x2){X[i], X[(i) + 1]}
#define AT_STEP(C0, C1, P0, P1, t, MASK, GK, GV, GL, CNT) do { \
    if (CNT) AT_WAITC(); else AT_WAIT0(); \
    if (GK) AT_DMAK((t) + 3, ((t) + 3) & 3); if (GV) AT_DMAV((t) + 1, sl_next); \
    LAS const unsigned char* const kp_ = kp0 + ((t) & 3) * KSLOT; LAS const unsigned char* const kpn_ = kp0 + (((t) + 1) & 3) * KSLOT; LAS const unsigned char* const vp_ = vp0 + sl_prev * VSLOT; \
    f32x2 s2 = {0.f, 0.f}; \
    AT_KRD(2); AT_SBAR(); \
    AT_GA(C0 = AT_MF(kf[0], qr[0], zero16), AT_EX2(P1, 0); pw0[0] = AT_PK(P0, 0); AT_SUM2(P0, 0); AT_PIN(P1); AT_PIN(pw0); AT_PIN(s2)); \
    AT_GA(C1 = AT_MF(kf[1], qr[0], zero16), AT_KRD(3); AT_EX2(P1, 2); pw0[1] = AT_PK(P0, 2); AT_SUM2(P0, 2); pw2[0] = AT_PK(P1, 0); AT_SUM2(P1, 0); AT_PIN(P1); AT_PIN(pw0); AT_PIN(pw2); AT_PIN(s2)); \
    AT_GA(C0 = AT_MF(kf[2], qr[1], C0), pw0[2] = AT_PK(P0, 4); AT_SUM2(P0, 4); pw2[1] = AT_PK(P1, 2); AT_SUM2(P1, 2); AT_PIN(pw0); AT_PIN(pw2); AT_PIN(s2)); \
    AT_GA(C1 = AT_MF(kf[3], qr[1], C1), AT_KRD(4); AT_EX2(P1, 4); pw0[3] = AT_PK(P0, 6); AT_SUM2(P0, 6); AT_PIN(P1); AT_PIN(pw0); AT_PIN(s2)); \
    AT_GA(C0 = AT_MF(kf[4], qr[2], C0), AT_EX2(P1, 6); pw1[0] = AT_PK(P0, 8); AT_SUM2(P0, 8); pw2[2] = AT_PK(P1, 4); AT_SUM2(P1, 4); AT_PIN(P1); AT_PIN(pw1); AT_PIN(pw2); AT_PIN(s2)); \
    AT_GA(C1 = AT_MF(kf[5], qr[2], C1), AT_KRD(5); pw1[1] = AT_PK(P0, 10); AT_SUM2(P0, 10); pw2[3] = AT_PK(P1, 6); AT_SUM2(P1, 6); AT_PIN(pw1); AT_PIN(pw2); AT_PIN(s2)); \
    AT_GA(C0 = AT_MF(kf[6], qr[3], C0), AT_EX2(P1, 8); pw1[2] = AT_PK(P0, 12); AT_SUM2(P0, 12); AT_PIN(P1); AT_PIN(pw1); AT_PIN(s2)); \
    AT_GA(C1 = AT_MF(kf[7], qr[3], C1), AT_EX2(P1, 10); pw1[3] = AT_PK(P0, 14); AT_SUM2(P0, 14); pw3[0] = AT_PK(P1, 8); AT_SUM2(P1, 8); AT_PIN(P1); AT_PIN(pw1); AT_PIN(pw3); AT_PIN(s2)); \
    AT_GA(C0 = AT_MF(kf[8], qr[4], C0), pw3[1] = AT_PK(P1, 10); AT_SUM2(P1, 10); AT_PIN(pw3); AT_PIN(s2)); \
    AT_GA(C1 = AT_MF(kf[9], qr[4], C1), AT_EX2(P1, 12); AT_PIN(P1)); \
    AT_GA(C0 = AT_MF(kf[10], qr[5], C0), AT_VRD(0); AT_EX2(P1, 14); pw3[2] = AT_PK(P1, 12); AT_SUM2(P1, 12); AT_PIN(P1); AT_PIN(pw3); AT_PIN(s2)); \
    AT_GA(C1 = AT_MF(kf[11], qr[5], C1), AT_VRD(4); pw3[3] = AT_PK(P1, 14); AT_SUM2(P1, 14); AT_PIN(pw3); AT_PIN(s2)); \
    l_reg += s2[0] + s2[1]; \
    if (MASK) cmask(C0, C1, (t) - (NT - 4), qrel, hi); \
    { const float rm = rowmax(C0, C1) - mhat; resc = false;                                                       \
      if (__builtin_expect(__any(rm > THR), 0)) { const float dl = __builtin_fmaxf(rm, 0.f); mhat += dl; mh2 = (f32x2){-mhat, -mhat}; AT_PIN(mh2);     \
          const float f = __builtin_amdgcn_exp2f(-dl); l_reg *= f; if (hi == 0) wsf[r32] = f; resc = true; } } \
    AT_PIN(l_reg); AT_SBAR(); \
    AT_GA(o0 = AT_MF(AT_PAF(0), AT_VFR(0), o0), AT_VRD(1); AT_EX2(C0, 0); AT_PIN(C0)); \
    AT_GA(o1 = AT_MF(AT_PAF(0), AT_VFR(4), o1), AT_VRD(5); AT_EX2(C0, 2); AT_PIN(C0)); \
    AT_GA(o0 = AT_MF(AT_PAF(1), AT_VFR(1), o0), AT_VRD(2); AT_EX2(C0, 4); AT_PIN(C0)); \
    AT_GA(o1 = AT_MF(AT_PAF(1), AT_VFR(5), o1), AT_VRD(6); AT_EX2(C0, 6); AT_PIN(C0)); \
    AT_GA(o0 = AT_MF(AT_PAF(2), AT_VFR(2), o0), AT_VRD(3); AT_EX2(C0, 8); AT_PIN(C0)); \
    AT_GA(o1 = AT_MF(AT_PAF(2), AT_VFR(6), o1), AT_VRD(7); AT_EX2(C0, 10); AT_PIN(C0)); \
    AT_GA(o0 = AT_MF(AT_PAF(3), AT_VFR(3), o0), if (GL) AT_KRDP(kpn_, 0); AT_EX2(C0, 12); AT_PIN(C0)); \
    AT_GA(o1 = AT_MF(AT_PAF(3), AT_VFR(7), o1), if (GL) AT_KRDP(kpn_, 1); AT_EX2(C0, 14); AT_PIN(C0)); \
    AT_RESC(); AT_ROT(); \
    } while (0)
    int t = 1;
    for (; t + 5 < NT; t += 2) {
        AT_STEP(pB0, pB1, pA0, pA1, t, false, true, true, true, true);
        AT_STEP(pA0, pA1, pB0, pB1, t + 1, false, true, true, true, true);
    }
    for (; t + 1 < NT; t += 2) {
        AT_STEP(pB0, pB1, pA0, pA1, t, true, (t + 3 < NT), (t + 1 < NT), (t + 1 < NT), false);
        AT_STEP(pA0, pA1, pB0, pB1, t + 1, true, (t + 4 < NT), (t + 2 < NT), (t + 2 < NT), false);
    }
    AT_STEP(pB0, pB1, pA0, pA1, NT - 1, true, false, false, false, false);
    { LAS const unsigned char* const vp_ = vp0 + sl_prev * VSLOT;
#pragma unroll
      for (int i = 0; i < 8; ++i) AT_VRD(i);
#pragma unroll
      for (int r = 0; r < 16; ++r) pB1[r] = __builtin_amdgcn_exp2f(pB1[r] - mhat);
      pw0 = (u32x4){AT_PK(pB0, 0), AT_PK(pB0, 2), AT_PK(pB0, 4), AT_PK(pB0, 6)}; pw1 = (u32x4){AT_PK(pB0, 8), AT_PK(pB0, 10), AT_PK(pB0, 12), AT_PK(pB0, 14)};
      pw2 = (u32x4){AT_PK(pB1, 0), AT_PK(pB1, 2), AT_PK(pB1, 4), AT_PK(pB1, 6)}; pw3 = (u32x4){AT_PK(pB1, 8), AT_PK(pB1, 10), AT_PK(pB1, 12), AT_PK(pB1, 14)};
      { float sa = 0.f;
#pragma unroll
        for (int r = 0; r < 16; ++r) sa += pB0[r] + pB1[r];
        l_reg += sa; }
      o0 = AT_MF(AT_PAF(0), AT_VFR(0), o0); o1 = AT_MF(AT_PAF(0), AT_VFR(4), o1);
      o0 = AT_MF(AT_PAF(1), AT_VFR(1), o0); o1 = AT_MF(AT_PAF(1), AT_VFR(5), o1);
      o0 = AT_MF(AT_PAF(2), AT_VFR(2), o0); o1 = AT_MF(AT_PAF(2), AT_VFR(6), o1);
      o0 = AT_MF(AT_PAF(3), AT_VFR(3), o0); o1 = AT_MF(AT_PAF(3), AT_VFR(7), o1); }
#undef AT_STEP
#undef AT_GA
#undef AT_EX2
#undef AT_SUM2
#undef AT_RESC
#undef AT_EX
#undef AT_PK
#undef AT_PAF
#undef AT_VFR
#undef AT_VRD
#undef AT_KRD
#undef AT_KRDP
#undef AT_ROT
#undef AT_WAIT0
#undef AT_WAITC
#undef AT_DMAV
#undef AT_DMAK
    { auto rr = __builtin_amdgcn_permlane32_swap(__float_as_uint(l_reg), __float_as_uint(l_reg), false, false); l_reg = __uint_as_float(rr[0]) + __uint_as_float(rr[1]); }
    if (hi == 0) wsf[32 + r32] = l_reg;
    bf16* Ow = O + (tb + q0 + wid * 32) * 512 + h * 64 + r32;
#pragma unroll
    for (int r = 0; r < 16; ++r) { const int q = crow(r, hi); const float f = __builtin_amdgcn_rcpf(wsf[32 + q]); Ow[(size_t)q * 512] = f2bf(o0[r] * f); Ow[(size_t)q * 512 + 32] = f2bf(o1[r] * f); }
    asm volatile("s_waitcnt lgkmcnt(0)\n\ts_barrier" ::: "memory");
}
}

namespace ssd {
constexpr int L_BM = 0, L_CG = 32768, L_X = 65536;
constexpr int S_ACUM = 0, S_DT = 2048;
template <class F> __device__ __forceinline__ void conv8(const bf16* proj, const float* cw, const float* cb, int ccol, size_t t0, int tr0, bool seq_start, F sink) {
    float w[4][8], bia[8];
#pragma unroll
    for (int k = 0; k < 4; ++k) { const f32x4 a = *(const f32x4*)(cw + k * 1536 + ccol), b = *(const f32x4*)(cw + k * 1536 + ccol + 4);
        w[k][0] = a[0]; w[k][1] = a[1]; w[k][2] = a[2]; w[k][3] = a[3]; w[k][4] = b[0]; w[k][5] = b[1]; w[k][6] = b[2]; w[k][7] = b[3]; }
    { const f32x4 a = *(const f32x4*)(cb + ccol), b = *(const f32x4*)(cb + ccol + 4); bia[0] = a[0]; bia[1] = a[1]; bia[2] = a[2]; bia[3] = a[3]; bia[4] = b[0]; bia[5] = b[1]; bia[6] = b[2]; bia[7] = b[3]; }
    float x0[8], x1[8], x2[8];
    auto ld = [&](int tr, float (&x)[8]) {
        if (seq_start && tr < 0) {
#pragma unroll
            for (int e = 0; e < 8; ++e) x[e] = 0.f;
        } else {
            const u32x4 v = *(const u32x4*)(proj + (t0 + tr) * NPAD + CXBC + ccol);
            x[0] = bflo(v.x); x[1] = bfhi(v.x); x[2] = bflo(v.y); x[3] = bfhi(v.y); x[4] = bflo(v.z); x[5] = bfhi(v.z); x[6] = bflo(v.w); x[7] = bfhi(v.w);
        } };
    ld(tr0 - 3, x0); ld(tr0 - 2, x1); ld(tr0 - 1, x2);
#pragma unroll
    for (int i = 0; i < 8; ++i) {
        float x3[8], y[8]; ld(tr0 + i, x3);
#pragma unroll
        for (int e = 0; e < 8; ++e) { const float v = bia[e] + w[0][e] * x0[e] + w[1][e] * x1[e] + w[2][e] * x2[e] + w[3][e] * x3[e]; y[e] = siluf_(v); x0[e] = x1[e]; x1[e] = x2[e]; x2[e] = x3[e]; }
        sink(tr0 + i, y);
    }
}
__device__ __forceinline__ void s1_unit(Frame& F, int L, int b, int c, int g) {
    LAS unsigned char* lds = F.lds; LAS float* side = (LAS float*)(F.lds + SIDE_OFF);
    int tid_ = cur_tid(); asm volatile("" : "+v"(tid_));
    const int tid = tid_, lane = tid & 63, wid = __builtin_amdgcn_readfirstlane(tid >> 6), r32 = lane & 31, hi = lane >> 5;
    const size_t t0 = (size_t)b * SEQ + (size_t)c * 128; const bool seq_start = (c == 0);
    const bf16* proj = (const bf16*)(F.ws + X_PROJ); const float* dtraw = (const float*)(F.ws + X_DTRAW);
    const float* cw = (const float*)F.in[8] + (size_t)L * 4 * 1536; const float* cb = (const float*)F.in[9] + L * 1536;
    const float* dtb = (const float*)F.in[10] + L * 16; const float* alog = (const float*)F.in[11] + L * 16; const float* dsk = (const float*)F.in[12] + L * 16;
    bf16* Cc = (bf16*)(F.ws + X_CC); float* eacum = (float*)(F.ws + X_EACUM); float* cdec = (float*)(F.ws + X_CDEC);
    bf16* ypart = (bf16*)(F.ws + X_YPART); bf16* states = (bf16*)(F.ws + X_STATES);
    { const int ch = tid & 31, tg = tid >> 5; const bool isC = ch >= 16; const int ccol = 1024 + (isC ? 256 : 0) + g * 128 + 8 * (ch & 15);
      conv8(proj, cw, cb, ccol, t0, 8 * tg, seq_start, [&](int tr, const float (&y)[8]) {
          const u32x4 w = {pk2(y[0], y[1]), pk2(y[2], y[3]), pk2(y[4], y[5]), pk2(y[6], y[7])};
          *(LAS u32x4*)(lds + (isC ? L_CG : L_BM) + off_b(tr, ch & 15)) = w;
          if (isC) *(u32x4*)(Cc + (t0 + tr) * 256 + g * 128 + 8 * (ch & 15)) = w; }); }
    LDS_BAR();
    { const int lb = wid >> 1; f32x16 gacc[2];
#pragma unroll
      for (int i = 0; i < 2; ++i) { const int sb = 2 * (wid & 1) + i; gacc[i] = (f32x16){};
          if (sb <= lb) {
#pragma unroll
              for (int ks = 0; ks < 8; ++ks) { const bf16x8 a = *(LAS const bf16x8*)(lds + L_CG + row_read_addr(32 * lb, lane, ks)), bb = *(LAS const bf16x8*)(lds + L_BM + row_read_addr(32 * sb, lane, ks));
                  gacc[i] = __builtin_amdgcn_mfma_f32_32x32x16_bf16(a, bb, gacc[i], 0, 0, 0); } } }
      LDS_BAR();
#pragma unroll
      for (int i = 0; i < 2; ++i) { const int sb = 2 * (wid & 1) + i;
          if (sb <= lb) {
#pragma unroll
              for (int r = 0; r < 16; ++r) { const int row = 32 * lb + crow(r, hi), col = 32 * sb + r32; *(LAS unsigned short*)(lds + L_CG + off_b(row, col >> 3) + (col & 7) * 2) = f2bf(gacc[i][r]); } } } }
#pragma unroll 1
    for (int rd = 0; rd < 2; ++rd) {
        if (wid < 4) {
            const int h = 8 * g + 4 * rd + wid; const float bia = dtb[h], a = -__expf(alog[h]);
            float d0 = dtraw[(t0 + lane) * 16 + h] + bia, d1 = dtraw[(t0 + 64 + lane) * 16 + h] + bia;
            d0 = fmaxf(d0, 0.f) + __logf(1.f + __expf(-fabsf(d0))); d1 = fmaxf(d1, 0.f) + __logf(1.f + __expf(-fabsf(d1)));
            d0 = fmaxf(d0, 1e-20f); d1 = fmaxf(d1, 1e-20f);
            float c0 = d0 * a, c1 = d1 * a;
#pragma unroll
            for (int o = 1; o < 64; o <<= 1) { const float v0 = __shfl_up(c0, o), v1 = __shfl_up(c1, o); if (lane >= o) { c0 += v0; c1 += v1; } }
            c1 += __shfl(c0, 63);
            side[S_ACUM / 4 + wid * 128 + lane] = c0; side[S_ACUM / 4 + wid * 128 + 64 + lane] = c1;
            side[S_DT / 4 + wid * 128 + lane] = d0; side[S_DT / 4 + wid * 128 + 64 + lane] = d1;
            eacum[(t0 + lane) * 16 + h] = __expf(c0); eacum[(t0 + 64 + lane) * 16 + h] = __expf(c1);
            if (lane == 63) cdec[((size_t)b * 64 + c) * 16 + h] = __expf(c1);
        }
        LDS_BAR();
        {
          const int ch = tid & 31, tg = tid >> 5, hd = ch >> 3, pch = ch & 7; const int ccol = (8 * g + 4 * rd + hd) * 64 + 8 * pch;
          conv8(proj, cw, cb, ccol, t0, 8 * tg, seq_start, [&](int tr, const float (&y)[8]) {
              const float d = side[S_DT / 4 + hd * 128 + tr];
              *(LAS u32x4*)(lds + L_X + (hd >> 1) * 32768 + off_b(tr, (hd & 1) * 8 + pch)) = (u32x4){pk2(y[0] * d, y[1] * d), pk2(y[2] * d, y[3] * d), pk2(y[4] * d, y[5] * d), pk2(y[6] * d, y[7] * d)}; }); }
        LDS_BAR();
        {
          const int hd = wid >> 1, sub = wid & 1, h = 8 * g + 4 * rd + hd;
          LAS const unsigned char* Xt = lds + L_X + (hd >> 1) * 32768; const int cb0 = (hd & 1) * 2;
          LAS const float* ac = side + S_ACUM / 4 + hd * 128; LAS const float* dts = side + S_DT / 4 + hd * 128;
          const float dskip = dsk[h];
#pragma unroll 1
          for (int rbi = 0; rbi < 2; ++rbi) {
              const int rb = sub ? (1 + rbi) : (3 * rbi); const int l = 32 * rb + r32; const float al = ac[l], dl = dskip * __builtin_amdgcn_rcpf(dts[l]);
              f32x16 y0 = {}, y1 = {};
              for (int ks = 0; ks <= 2 * rb + 1; ++ks) {
                  const u32x4 gw = *(LAS const u32x4*)(lds + L_CG + row_read_addr(32 * rb, lane, ks));
                  const f32x4 as0 = *(LAS const f32x4*)(ac + 16 * ks + 8 * hi), as1 = *(LAS const f32x4*)(ac + 16 * ks + 8 * hi + 4);
                  const float gv[8] = {bflo(gw.x), bfhi(gw.x), bflo(gw.y), bfhi(gw.y), bflo(gw.z), bfhi(gw.z), bflo(gw.w), bfhi(gw.w)};
                  const float asv[8] = {as0[0], as0[1], as0[2], as0[3], as1[0], as1[1], as1[2], as1[3]};
                  float mv[8];
#pragma unroll
                  for (int j = 0; j < 8; ++j) { const int s = 16 * ks + 8 * hi + j; float m = (s <= l) ? gv[j] * __expf(al - asv[j]) : 0.f; if (s == l) m += dl; mv[j] = m; }
                  const bf16x8 af = __builtin_bit_cast(bf16x8, (u32x4){pk2(mv[0], mv[1]), pk2(mv[2], mv[3]), pk2(mv[4], mv[5]), pk2(mv[6], mv[7])});
                  y0 = __builtin_amdgcn_mfma_f32_32x32x16_bf16(af, tr_frag(Xt, lane, cb0, ks), y0, 0, 0, 0);
                  y1 = __builtin_amdgcn_mfma_f32_32x32x16_bf16(af, tr_frag(Xt, lane, cb0 + 1, ks), y1, 0, 0, 0);
              }
#pragma unroll
              for (int i = 0; i < 2; ++i) { bf16* yp = ypart + (((size_t)b * 64 + c) * 16 + h) * 8192 + (size_t)(rb * 2) * 1024 + lane * 16 + 8 * i;
                  *(u32x4*)yp = (u32x4){pk2(y0[8 * i], y0[8 * i + 1]), pk2(y0[8 * i + 2], y0[8 * i + 3]), pk2(y0[8 * i + 4], y0[8 * i + 5]), pk2(y0[8 * i + 6], y0[8 * i + 7])};
                  *(u32x4*)(yp + 1024) = (u32x4){pk2(y1[8 * i], y1[8 * i + 1]), pk2(y1[8 * i + 2], y1[8 * i + 3]), pk2(y1[8 * i + 4], y1[8 * i + 5]), pk2(y1[8 * i + 6], y1[8 * i + 7])}; }
          }
          { f32x16 st[4] = {{}, {}, {}, {}}; const float aend = ac[127];
            for (int ks = 0; ks < 8; ++ks) {
                const bf16x8 xf = tr_frag(Xt, lane, cb0 + sub, ks); const u32x4 xw = __builtin_bit_cast(u32x4, xf);
                const f32x4 as0 = *(LAS const f32x4*)(ac + 16 * ks + 8 * hi), as1 = *(LAS const f32x4*)(ac + 16 * ks + 8 * hi + 4);
                const bf16x8 af = __builtin_bit_cast(bf16x8, (u32x4){pk2(bflo(xw.x) * __expf(aend - as0[0]), bfhi(xw.x) * __expf(aend - as0[1])), pk2(bflo(xw.y) * __expf(aend - as0[2]), bfhi(xw.y) * __expf(aend - as0[3])),
                                                                       pk2(bflo(xw.z) * __expf(aend - as1[0]), bfhi(xw.z) * __expf(aend - as1[1])), pk2(bflo(xw.w) * __expf(aend - as1[2]), bfhi(xw.w) * __expf(aend - as1[3]))});
#pragma unroll
                for (int nb = 0; nb < 4; ++nb) st[nb] = __builtin_amdgcn_mfma_f32_32x32x16_bf16(af, tr_frag(lds + L_BM, lane, nb, ks), st[nb], 0, 0, 0);
            }
            bf16* sp = states + (((size_t)b * 64 + c) * 16 + h) * 8192;
#pragma unroll
            for (int nb = 0; nb < 4; ++nb)
#pragma unroll
                for (int r = 0; r < 16; ++r) sp[(32 * sub + crow(r, hi)) * 128 + 32 * nb + r32] = f2bf(st[nb][r]); }
        }
        LDS_BAR();
    }
}
__device__ __forceinline__ void scan_phase(Frame& F) {
    const bf16* states = (const bf16*)(F.ws + X_STATES); const float* cdec = (const float*)(F.ws + X_CDEC); bf16* prev = (bf16*)(F.ws + X_PREV);
    for (int idx = F.vcu * NWAVES * 64 + F.tid; idx < NB * 16 * 64 * 32; idx += F.G * NWAVES * 64) {
        const int n4 = idx & 31, p = (idx >> 5) & 63, h = (idx >> 11) & 15, b = idx >> 15;
        f32x4 st = {0.f, 0.f, 0.f, 0.f};
#pragma unroll 1
        for (int c0 = 0; c0 < 64; c0 += 16) {
            const size_t o0 = ((((size_t)b * 64 + c0) * 16 + h) * 64 + p) * 128 + 4 * n4;
            u32x2 cw[16]; float d[16];
#pragma unroll
            for (int k = 0; k < 16; ++k) { cw[k] = *(const u32x2*)(states + o0 + (size_t)k * (16 * 64 * 128)); d[k] = cdec[((size_t)b * 64 + c0 + k) * 16 + h]; }
#pragma unroll
            for (int k = 0; k < 16; ++k) {
                *(u32x2*)(prev + o0 + (size_t)k * (16 * 64 * 128)) = (u32x2){pk2(st[0], st[1]), pk2(st[2], st[3])};
                const f32x4 cs = {bflo(cw[k].x), bfhi(cw[k].x), bflo(cw[k].y), bfhi(cw[k].y)};
                st = st * d[k] + cs; }
        }
    }
}
__device__ __forceinline__ void s3_unit(Frame& F, int L, int b, int c, int g) {
    LAS unsigned char* lds = F.lds; LAS float* side = (LAS float*)(F.lds + SIDE_OFF);
    int tid_ = cur_tid(); asm volatile("" : "+v"(tid_));
    const int tid = tid_, lane = tid & 63, wid = __builtin_amdgcn_readfirstlane(tid >> 6), r32 = lane & 31, hi = lane >> 5, h = 8 * g + wid;
    const size_t t0 = (size_t)b * SEQ + (size_t)c * 128;
    const bf16* proj = (const bf16*)(F.ws + X_PROJ); const bf16* Cc = (const bf16*)(F.ws + X_CC); const float* eacum = (const float*)(F.ws + X_EACUM);
    const bf16* ypf = (const bf16*)(F.ws + X_YPART) + (((size_t)b * 64 + c) * 16 + h) * 8192 + lane * 16; const bf16* prev = (const bf16*)(F.ws + X_PREV) + (((size_t)b * 64 + c) * 16 + h) * 8192;
    const float* nw = (const float*)F.in[13] + L * 1024; bf16* ynorm = (bf16*)(F.ws + X_YNORM);
    LAS unsigned char* zst = lds + 32768 + wid * 8192;
    LAS float* eac = side + 1280 + wid * 128;
#pragma unroll
    for (int i = 0; i < 4; ++i) { const int q = tid + 512 * i, row = q >> 4, ch = q & 15; *(LAS u32x4*)(lds + off_b(row, ch)) = *(const u32x4*)(Cc + (t0 + row) * 256 + g * 128 + 8 * ch); }
    eac[lane] = eacum[(t0 + lane) * 16 + h]; eac[64 + lane] = eacum[(t0 + 64 + lane) * 16 + h];
    bf16x8 pf[8][2];
#pragma unroll
    for (int ks = 0; ks < 8; ++ks)
#pragma unroll
        for (int pb = 0; pb < 2; ++pb) pf[ks][pb] = *(const bf16x8*)(prev + (32 * pb + r32) * 128 + 16 * ks + 8 * hi);
    LDS_BAR();
    const int srow = lane >> 1, shalf = lane & 1;
#define S3_LOAD(rb, Z, Y0, Y1) do { \
        _Pragma("unroll") for (int i = 0; i < 4; ++i) { const int q = lane + 64 * i, row = q >> 3, ch = q & 7; Z[i] = *(const u32x4*)(proj + (t0 + 32 * (rb) + row) * NPAD + CZ + h * 64 + 8 * ch); } \
        _Pragma("unroll") for (int i = 0; i < 2; ++i) { Y0[i] = *(const u32x4*)(ypf + ((rb) * 2 + 0) * 1024 + 8 * i); Y1[i] = *(const u32x4*)(ypf + ((rb) * 2 + 1) * 1024 + 8 * i); } } while (0)
    auto s3_body = [&](const int rb, const u32x4 (&zq)[4], const u32x4 (&yq0)[2], const u32x4 (&yq1)[2]) {
#pragma unroll
        for (int i = 0; i < 4; ++i) { const int q = lane + 64 * i, row = q >> 3, ch = q & 7; *(LAS u32x4*)(zst + row * 128 + ch * 16) = zq[i]; }
        f32x16 a0 = {}, a1 = {};
#pragma unroll
        for (int ks = 0; ks < 8; ++ks) { const bf16x8 cf = *(LAS const bf16x8*)(lds + row_read_addr(32 * rb, lane, ks));
            a0 = __builtin_amdgcn_mfma_f32_32x32x16_bf16(cf, pf[ks][0], a0, 0, 0, 0); a1 = __builtin_amdgcn_mfma_f32_32x32x16_bf16(cf, pf[ks][1], a1, 0, 0, 0); }
#pragma unroll
        for (int r = 0; r < 16; ++r) { const int lr = crow(r, hi); const float ea = eac[32 * rb + lr];
            const float z0 = bf2f(*(LAS const unsigned short*)(zst + lr * 128 + r32 * 2)), z1 = bf2f(*(LAS const unsigned short*)(zst + lr * 128 + 64 + r32 * 2));
            const unsigned w0_ = yq0[r >> 3][(r >> 1) & 3], w1_ = yq1[r >> 3][(r >> 1) & 3];
            const float y0 = (((r & 1) ? bfhi(w0_) : bflo(w0_)) + ea * a0[r]) * siluf_(z0), y1 = (((r & 1) ? bfhi(w1_) : bflo(w1_)) + ea * a1[r]) * siluf_(z1);
            *(LAS unsigned short*)(zst + 4096 + lr * 128 + r32 * 2) = f2bf(y0); *(LAS unsigned short*)(zst + 4096 + lr * 128 + 64 + r32 * 2) = f2bf(y1); }
        { float ss = 0.f; u32x4 w[4];
#pragma unroll
          for (int i = 0; i < 4; ++i) { w[i] = *(LAS const u32x4*)(zst + 4096 + srow * 128 + shalf * 64 + i * 16);
              const float e[8] = {bflo(w[i].x), bfhi(w[i].x), bflo(w[i].y), bfhi(w[i].y), bflo(w[i].z), bfhi(w[i].z), bflo(w[i].w), bfhi(w[i].w)};
#pragma unroll
              for (int k = 0; k < 8; ++k) ss += e[k] * e[k]; }
          ss += __shfl_xor(ss, 1);
          if (shalf == 0) side[wid * 128 + 32 * rb + srow] = ss;
          bf16* yo = ynorm + (t0 + 32 * rb + srow) * 1024 + h * 64 + shalf * 32;
#pragma unroll
          for (int i = 0; i < 4; ++i) *(u32x4*)(yo + 8 * i) = w[i]; }
    };
    { u32x4 zA[4], yA0[2], yA1[2], zB[4], yB0[2], yB1[2];
      S3_LOAD(0, zA, yA0, yA1);
      S3_LOAD(1, zB, yB0, yB1); s3_body(0, zA, yA0, yA1);
      S3_LOAD(2, zA, yA0, yA1); s3_body(1, zB, yB0, yB1);
      S3_LOAD(3, zB, yB0, yB1); s3_body(2, zA, yA0, yA1);
      s3_body(3, zB, yB0, yB1); }
#undef S3_LOAD
    WG_BAR();
    if (tid < 128) { float s = 0.f;
#pragma unroll
        for (int w = 0; w < 8; ++w) s += side[w * 128 + tid];
        side[1024 + tid] = __builtin_amdgcn_rsqf(s * (1.f / 512.f) + 1e-6f); }
    LDS_BAR();
    float wv[32];
#pragma unroll
    for (int i = 0; i < 8; ++i) { const f32x4 t4 = *(const f32x4*)(nw + h * 64 + shalf * 32 + 4 * i); wv[4 * i] = t4[0]; wv[4 * i + 1] = t4[1]; wv[4 * i + 2] = t4[2]; wv[4 * i + 3] = t4[3]; }
    u32x4 yw[4][4];
#pragma unroll
    for (int rb = 0; rb < 4; ++rb) { const bf16* yo = ynorm + (t0 + 32 * rb + srow) * 1024 + h * 64 + shalf * 32;
#pragma unroll
        for (int i = 0; i < 4; ++i) yw[rb][i] = *(const u32x4*)(yo + 8 * i); }
#pragma unroll
    for (int rb = 0; rb < 4; ++rb) { const float rs = side[1024 + 32 * rb + srow]; bf16* yo = ynorm + (t0 + 32 * rb + srow) * 1024 + h * 64 + shalf * 32;
#pragma unroll
        for (int i = 0; i < 4; ++i) { const u32x4 w = yw[rb][i]; u32x4 o;
            o.x = pk2(bflo(w.x) * rs * wv[8 * i], bfhi(w.x) * rs * wv[8 * i + 1]); o.y = pk2(bflo(w.y) * rs * wv[8 * i + 2], bfhi(w.y) * rs * wv[8 * i + 3]);
            o.z = pk2(bflo(w.z) * rs * wv[8 * i + 4], bfhi(w.z) * rs * wv[8 * i + 5]); o.w = pk2(bflo(w.w) * rs * wv[8 * i + 6], bfhi(w.w) * rs * wv[8 * i + 7]);
            *(u32x4*)(yo + 8 * i) = o; } }
    LDS_BAR();
}
}

#ifndef PHM
#define PHM 0x3fff
#endif
template <int L> __device__ __forceinline__ void layer_body(Frame& F, const XcdBarrier bar, LAS unsigned char* ring, LAS int* toff, bf16* hb, const int bx) {
        unsigned char* wl = F.ws + WS_WSM + (size_t)L * WSM_LAYER; (void)wl;
#if (PHM >> 1) & 1
        frame_refresh(F);
        { ge::Dense<EpiProj> P{hb, (const bf16*)(wl + WO_WIN), 1024, 1024, {}, {(bf16*)(F.ws + X_PROJ), (float*)(F.ws + X_DTRAW)}}; P.S.init(T, NPAD, F.G, bx);
          ge::gemm_phase(ring, P); }
        xcd_barrier(bar);
#endif
#if (PHM >> 2) & 1
        frame_refresh(F);
#ifndef NO_PREP
        prep_rows(F, L);
#endif
#ifndef NO_S1
        { const int nk_ = (NB * 64 * 2 + F.G - 1) / F.G, kmax_ = nk_ < 2 ? 2 : nk_;
#pragma unroll 1
          for (int k_ = 0; k_ < kmax_; ++k_) { const int u = F.vcu + k_ * F.G;
              if (u < NB * 64 * 2) ssd::s1_unit(F, L, u >> 7, (u >> 1) & 63, u & 1); } }
#endif
        xcd_barrier(bar);
#endif
#if (PHM >> 3) & 1
        frame_refresh(F);
        { ge::Dense<EpiQ> P{(const bf16*)(F.ws + X_QN), (const bf16*)(wl + WO_WQ), 384, 384, {}, {(bf16*)(F.ws + X_QB), (const float*)(F.ws + WS_ROPE), (const float*)(F.ws + WS_ROPE) + (size_t)T * 16}}; P.S.init(T, 768, F.G, bx);
          ge::gemm_phase(ring, P); }
        { ge::Dense<EpiStoreBf16> P{(const bf16*)(F.ws + X_CKVN), (const bf16*)(wl + WO_WKV), 256, 256, {}, {(bf16*)(F.ws + X_KVB), 1024}}; P.S.init(T, 1024, F.G, bx);
          ge::gemm_phase(ring, P); }
        ssd::scan_phase(F);
        xcd_barrier(bar);
#endif
#if (PHM >> 4) & 1
        frame_refresh(F);
#ifndef NO_ATTN
        { const int s = F.vcu & 7, bh = F.vcu >> 3; const bool bal = F.G == 256;
          const int nk_ = bal ? 4 : (1024 + F.G - 1) / F.G, kmax_ = nk_ < 4 ? 4 : nk_;
          bool conv_done = false;
#pragma unroll 1
          for (int i = 0; i < kmax_; ++i) {
              if (!conv_done && conv_acquire(F, L, false)) { p0_expert_weights(F, L); WG_BAR(); conv_release(F, L); conv_done = true; }
              const int qb = (i == 0) ? s : (i == 1) ? 15 - s : (i == 2) ? 16 + s : 31 - s; const int u = F.vcu + i * F.G;
              if (bal || u < 1024)
                  at::attn_unit(bal ? (bh >> 3) : (u >> 8), bal ? (bh & 7) : ((u >> 5) & 7), bal ? qb : (u & 31), (const bf16*)(F.ws + X_QB), (const bf16*)(F.ws + X_KVB), (const bf16*)(F.ws + X_KPE), (bf16*)(F.ws + X_OB), ring); }
          if (!conv_done) { conv_acquire(F, L, true); p0_expert_weights(F, L); WG_BAR(); conv_release(F, L); } }
#endif
#ifndef NO_S3
        for (int u = F.vcu; u < NB * 64 * 2; u += F.G) ssd::s3_unit(F, L, u >> 7, (u >> 1) & 63, u & 1);
#endif
        xcd_barrier(bar);
#endif
#if (PHM >> 5) & 1
        frame_refresh(F);
        { ge::Dense<EpiGate> P{(const bf16*)(F.ws + X_OB), (const bf16*)(wl + WO_WAB), 512, 512, {}, {(bf16*)(F.ws + X_MB), (const bf16*)(F.ws + X_PROJ), CGA, 0}}; P.S.init(T, 1024, F.G, bx);
          ge::gemm_phase(ring, P); }
        { ge::Dense<EpiGate> P{(const bf16*)(F.ws + X_YNORM), (const bf16*)(wl + WO_WSB), 1024, 1024, {}, {(bf16*)(F.ws + X_MB), (const bf16*)(F.ws + X_PROJ), CGB, 1}}; P.S.init(T, 1024, F.G, bx);
          ge::gemm_phase(ring, P); }
        xcd_barrier(bar);
#endif
#if (PHM >> 6) & 1
        frame_refresh(F);
        { ge::Dense<EpiWo> P{(const bf16*)(F.ws + X_MB), (const bf16*)(wl + WO_WO), 1024, 1024, {}, {(bf16*)(F.ws + X_PRE), (const bf16*)hb}}; P.S.init(T, 1024, F.G, bx);
          ge::gemm_phase(ring, P); }
        xcd_barrier(bar);
#endif
#if (PHM >> 7) & 1
        frame_refresh(F);
        ln_rows<false, false>(F, (const bf16*)(F.ws + X_PRE), (const float*)F.in[17] + L * D, (const float*)F.in[18] + L * D, nullptr, nullptr, nullptr);
        conv_p(F, L);
        xcd_barrier(bar);
#endif
#if (PHM >> 8) & 1
        frame_refresh(F);
        { ge::Dense<EpiCat> P{hb, (const bf16*)(wl + WO_WCAT), 1024, 1024, {}, {(float*)(F.ws + X_LOGITS), (bf16*)(F.ws + X_SHHID), (bf16*)(F.ws + X_SG)}}; P.S.init(T, 1792, F.G, bx);
          ge::gemm_phase(ring, P); }
        xcd_barrier(bar);
#endif
#if (PHM >> 9) & 1
        frame_refresh(F);
        topk_rows(F, L);
        { ge::Dense<EpiPle> P{(const bf16*)(F.ws + X_PB), (const bf16*)(wl + WO_WPLE), 256, 256, {}, {(bf16*)(F.ws + X_BASE), (const bf16*)hb, (const bf16*)(F.ws + X_SG)}}; P.S.init(T, 1024, F.G, bx);
          ge::gemm_phase(ring, P); }
        { ge::Dense<EpiAddF32> P{(const bf16*)(F.ws + X_SHHID), (const bf16*)(wl + WO_WSD), 256, 256, {}, {(bf16*)(F.ws + X_BASE)}}; P.S.init(T, 1024, F.G, bx);
          ge::gemm_phase(ring, P); }
        xcd_barrier(bar);
#endif
#if (PHM >> 10) & 1
        frame_refresh(F);
        build_toff(F, L, toff);
        scatter_slots(F, L, toff);
        xcd_barrier(bar);
#endif
#if (PHM >> 11) & 1
        frame_refresh(F);
        { MoeGU P{hb, (const bf16*)(F.ws + WS_WGU + (size_t)L * WGU_LAYER), (const int*)(F.ws + X_STOK), (bf16*)(F.ws + X_HID), toff, F.G, F.vcu, 1024};
          ge::gemm_phase(ring, P); }
        xcd_barrier(bar);
#endif
#if (PHM >> 12) & 1
        frame_refresh(F);
        { MoeDown P{(const bf16*)(F.ws + X_HID), (const bf16*)(F.ws + WS_WD + (size_t)L * WD_LAYER), (const float*)(F.ws + X_SW), (unsigned char*)(F.ws + X_Y), toff, F.G, F.vcu, 256};
          ge::gemm_phase(ring, P); }
        xcd_barrier(bar);
#endif
#if (PHM >> 13) & 1
        frame_refresh(F);
        ln_rows<true, L == DEPTH - 1>(F, (const bf16*)(F.ws + X_BASE), (const float*)F.in[29] + L * D, (const float*)F.in[30] + L * D, (const int*)(F.ws + X_RRANK), (const unsigned char*)(F.ws + X_Y), (const float*)(F.ws + X_RW));
        xcd_barrier(bar);
#endif
}
struct Args { const void* in[31]; float* out; unsigned char* ws; };
__global__ void __launch_bounds__(NWAVES * 64, 2) fwd(Args args) {
    Frame F;
    F.lds = (LAS unsigned char*)lds_raw;
    F.tid = threadIdx.x; F.lane = F.tid & 63; F.wave = __builtin_amdgcn_readfirstlane(F.tid >> 6);
    F.G = gridDim.x; { const int bx = blockIdx.x; F.vcu = (F.G % 8 == 0) ? (bx % 8) * (F.G / 8) + bx / 8 : bx; }
    F.ws = args.ws; F.out = args.out; F.in = args.in; F.ctl = (gu32*)(args.ws + WS_CTL);
    for (int u = F.tid; u < (LDS_BYTES - LDSCTL_OFF) / 4; u += NWAVES * 64) ((LAS unsigned*)(F.lds + LDSCTL_OFF))[u] = 0u;
    __syncthreads();
    if (F.lane == 0) *(volatile LAS int*)(F.lds + LDSCTL_OFF + 64 + 4 * hw_wave_slot()) = F.wave;
    __syncthreads();
    frame_refresh(F);
    XcdBarrier bar = xcd_barrier_post((unsigned*)(F.ctl + CW_BAR), (volatile LAS unsigned*)(F.lds + LDSCTL_OFF));
    LAS unsigned char* ring = F.lds + RING_OFF;
    LAS int* toff = (LAS int*)(F.lds + SIDE_OFF + 8192);
    bf16* hb = (bf16*)(F.ws + WS_HB);
    const int bx = (int)blockIdx.x;

#if (PHM >> 0) & 1
        frame_refresh(F);
    p0_small_weights(F); p0_misc(F);
    xcd_barrier(bar);

#endif
    layer_body<0>(F, bar, ring, toff, hb, bx);
    layer_body<1>(F, bar, ring, toff, hb, bx);
}

extern "C" void kernel_launch(void* const* d_in, const int* in_sizes, int n_in, void* d_out, int out_size, void* d_ws, size_t ws_size, hipStream_t stream) {
    static int grid = 0;
    if (grid == 0) {
        if (n_in != 31 || out_size != T * D || ws_size < WS_END) { fprintf(stderr, "kernel_launch: unexpected shapes (n_in %d out %d ws %zu)\n", n_in, out_size, ws_size); grid = -1; return; }
        int dev = 0, cus = 0, per_cu = 0;
        if (hipGetDevice(&dev) != hipSuccess || hipDeviceGetAttribute(&cus, hipDeviceAttributeMultiprocessorCount, dev) != hipSuccess) { grid = -1; return; }
        if (hipFuncSetAttribute((const void*)fwd, hipFuncAttributeMaxDynamicSharedMemorySize, LDS_BYTES) != hipSuccess) { fprintf(stderr, "kernel_launch: hipFuncSetAttribute failed\n"); grid = -1; return; }
        if (hipOccupancyMaxActiveBlocksPerMultiprocessor(&per_cu, (const void*)fwd, NWAVES * 64, LDS_BYTES) != hipSuccess || per_cu < 1) { fprintf(stderr, "kernel_launch: occupancy query says %d\n", per_cu); }
        (void)hipGetLastError();
        grid = cus;
    }
    if (grid < 0) return;
    (void)hipMemsetAsync((char*)d_ws + WS_CTL, 0, CTL_ZERO_BYTES, stream);
    Args a{};
    for (int i = 0; i < 31; ++i) a.in[i] = d_in[i];
    a.out = (float*)d_out; a.ws = (unsigned char*)d_ws;
    hipLaunchKernelGGL(fwd, dim3(grid), dim3(NWAVES * 64), LDS_BYTES, stream, a);
}
```

```cpp
#include <hip/hip_runtime.h>
#include <cstdio>
#include <cstdint>

#define LAS __attribute__((address_space(3)))
#define GAS __attribute__((address_space(1)))
typedef unsigned short bf16;
typedef short bf16x8 __attribute__((ext_vector_type(8)));
typedef short s16x4 __attribute__((ext_vector_type(4)));
typedef float f32x2 __attribute__((ext_vector_type(2)));
typedef float f32x4 __attribute__((ext_vector_type(4)));
typedef float f32x16 __attribute__((ext_vector_type(16)));
typedef unsigned u32x2 __attribute__((ext_vector_type(2)));
typedef unsigned u32x4 __attribute__((ext_vector_type(4)));
typedef GAS unsigned gu32;

constexpr int NB = 4, SEQ = 8192, T = NB * SEQ, D = 1024, DEPTH = 2;
constexpr int NCOLS = 5296, NPAD = 5376;
constexpr int CQ = 0, CKV = 384, CKPE = 640, CZ = 672, CXBC = 1696, CDT = 3232, CGA = 3248, CGB = 4272;
constexpr int NEXP = 256, TOPK = 8;
constexpr int SMAX = T * TOPK + NEXP * 255;
constexpr float ALPHA = 1.4142135623730951f;
constexpr float QSCALE = 0.10206207261596577f * 1.4426950408889634f;
constexpr int NWAVES = 8;
constexpr float YSCALE = 32.f;

constexpr size_t MiB = 1u << 20;
constexpr size_t WS_CTL = 0, CTL_ZERO_BYTES = 1 * MiB;
constexpr size_t WS_WSM = 1 * MiB, WSM_LAYER = 22 * MiB;
constexpr size_t WO_WIN = 0, WO_WQ = WO_WIN + (size_t)NPAD * 1024 * 2, WO_WKV = WO_WQ + 768 * 384 * 2, WO_WAB = WO_WKV + 1024 * 256 * 2,
                 WO_WSB = WO_WAB + 1024 * 512 * 2, WO_WO = WO_WSB + 1024 * 1024 * 2, WO_WCAT = WO_WO + 1024 * 1024 * 2,
                 WO_WSD = WO_WCAT + 1792 * 1024 * 2, WO_WPLE = WO_WSD + 1024 * 256 * 2, WO_END = WO_WPLE + 1024 * 256 * 2;
static_assert(WO_END <= WSM_LAYER, "small weights");
constexpr size_t WS_ROPE = 45 * MiB;
constexpr size_t WS_HB = 49 * MiB;
constexpr size_t WS_WGU = 113 * MiB, WGU_LAYER = 256 * MiB;
constexpr size_t WS_WD = 625 * MiB, WD_LAYER = 128 * MiB;
constexpr size_t WS_X = 881 * MiB;
constexpr size_t X_PROJ = WS_X, X_DTRAW = X_PROJ + 336 * MiB, X_QN = X_DTRAW + 2 * MiB, X_CKVN = X_QN + 24 * MiB, X_KPE = X_CKVN + 16 * MiB,
                 X_QB = X_KPE + 2 * MiB, X_KVB = X_QB + 48 * MiB, X_OB = X_KVB + 64 * MiB, X_YPART = X_OB + 32 * MiB, X_CC = X_YPART + 128 * MiB,
                 X_EACUM = X_CC + 16 * MiB, X_CDEC = X_EACUM + 2 * MiB, X_STATES = X_CDEC + 1 * MiB, X_PREV = X_STATES + 128 * MiB,
                 X_YNORM = X_PREV + 64 * MiB, X_MB = X_YNORM + 64 * MiB, X_PRE = X_MB + 64 * MiB, X_MIX_END = X_PRE + 128 * MiB;
constexpr size_t X_LOGITS = WS_X, X_RIDX = X_LOGITS + 32 * MiB, X_RW = X_RIDX + 1 * MiB, X_RRANK = X_RW + 1 * MiB, X_STOK = X_RRANK + 1 * MiB,
                 X_SW = X_STOK + 2 * MiB, X_PB = X_SW + 2 * MiB, X_SHHID = X_PB + 16 * MiB, X_SG = X_SHHID + 16 * MiB, X_BASE = X_SG + 64 * MiB,
                 X_HID = X_BASE + 128 * MiB, X_Y = X_HID + 160 * MiB, X_MOE_END = X_Y + 640 * MiB;
constexpr size_t WS_END = 2048 * MiB;
static_assert(X_MIX_END <= WS_END && X_MOE_END <= WS_END && X_PB + 16 * MiB <= X_PRE, "d_ws map");
static_assert((size_t)SMAX * 256 * 2 <= 160 * MiB && (size_t)SMAX * 1024 * 2 <= 640 * MiB && (size_t)SMAX * 4 <= 2 * MiB, "slot buffers");
constexpr int CW_TMO = 0, CW_BAR = 4096, CW_CNT = 16384, CW_SEM = 32768;
constexpr unsigned CONV_LIMIT = 96;

constexpr int RING_OFF = 0, RING_BYTES = 131072, SIDE_OFF = 131072, SIDE_BYTES = 16384, LDSCTL_OFF = SIDE_OFF + SIDE_BYTES, LDS_BYTES = LDSCTL_OFF + 512;


extern __shared__ __attribute__((aligned(16))) unsigned char lds_raw[];
__device__ __forceinline__ int lane_id() { return (int)__builtin_amdgcn_mbcnt_hi(~0u, __builtin_amdgcn_mbcnt_lo(~0u, 0u)); }
__device__ __forceinline__ unsigned hw_wave_slot() { return (unsigned)__builtin_amdgcn_s_getreg(((6 - 1) << 11) | 4) & 63u; }
__device__ __forceinline__ int wave_index() { return __builtin_amdgcn_readfirstlane(*(volatile LAS int*)((LAS unsigned char*)lds_raw + LDSCTL_OFF + 64 + 4 * hw_wave_slot())); }
__device__ __forceinline__ int cur_tid() { return wave_index() * 64 + lane_id(); }
__device__ __forceinline__ float bf2f(unsigned short b) { return __uint_as_float(((unsigned)b) << 16); }
__device__ __forceinline__ float bflo(unsigned w) { return __uint_as_float(w << 16); }
__device__ __forceinline__ float bfhi(unsigned w) { return __uint_as_float(w & 0xffff0000u); }
typedef __bf16 bf16x2_t __attribute__((ext_vector_type(2)));
__device__ __forceinline__ unsigned pk2(float lo, float hi) { const f32x2 v = {lo, hi}; const bf16x2_t b = __builtin_convertvector(v, bf16x2_t); return __builtin_bit_cast(unsigned, b); }
__device__ __forceinline__ unsigned short f2bf(float f) { return (unsigned short)(pk2(f, 0.f) & 0xffffu); }
__device__ __forceinline__ float sigmoidf_(float x) { return __builtin_amdgcn_rcpf(1.f + __expf(-x)); }
__device__ __forceinline__ float siluf_(float x) { return x * sigmoidf_(x); }
__device__ __forceinline__ float wave_sum(float v) {
#pragma unroll
    for (int o = 1; o < 64; o <<= 1) v += __shfl_xor(v, o);
    return v;
}
template <class Tp> __device__ __forceinline__ Tp* uni_ptr(Tp* p) {
    const unsigned long long v = (unsigned long long)p; unsigned lo = __builtin_amdgcn_readfirstlane((unsigned)v), hi = __builtin_amdgcn_readfirstlane((unsigned)(v >> 32));
    asm volatile("" : "+s"(lo), "+s"(hi)); return (Tp*)(GAS Tp*)(((unsigned long long)hi << 32) | lo); }
__device__ __forceinline__ int uni_int(int x) { x = __builtin_amdgcn_readfirstlane(x); asm volatile("" : "+s"(x)); return x; }
#define LDS_WAIT() asm volatile("s_waitcnt lgkmcnt(0)" ::: "memory")
#define VM_WAIT() asm volatile("s_waitcnt vmcnt(0)" ::: "memory")
#define LDS_BAR() do { asm volatile("s_waitcnt lgkmcnt(0)" ::: "memory"); __builtin_amdgcn_s_barrier(); asm volatile("" ::: "memory"); } while (0)
#define WG_BAR() do { asm volatile("s_waitcnt vmcnt(0) lgkmcnt(0)" ::: "memory"); __builtin_amdgcn_s_barrier(); asm volatile("" ::: "memory"); } while (0)

__device__ __forceinline__ unsigned off_b(unsigned row, unsigned ch) { return 256u * row + 16u * (ch ^ (((row & 3) << 2) | ((row >> 2) & 3))); }
__device__ __forceinline__ unsigned row_read_addr(unsigned rowbase, unsigned lane, unsigned s) { return off_b(rowbase + (lane & 31), 2 * s + (lane >> 5)); }
__device__ __forceinline__ unsigned tr_read_addr(unsigned lane, unsigned c, unsigned ks, unsigned t) {
    const unsigned h = lane >> 5, blk = (lane >> 4) & 1, q = (lane & 15) >> 2, p = lane & 3;
    return off_b(16 * ks + 8 * h + 4 * t + q, 4 * c + 2 * blk + (p >> 1)) + 8 * (p & 1);
}
typedef short v4i16_t __attribute__((ext_vector_type(4)));
__device__ __forceinline__ s16x4 ldstr(LAS const unsigned char* p) { return __builtin_bit_cast(s16x4, __builtin_amdgcn_ds_read_tr16_b64_v4i16((LAS v4i16_t*)p)); }
__device__ __forceinline__ bf16x8 tr_frag(LAS const unsigned char* tile, unsigned lane, unsigned c, unsigned ks) {
    const s16x4 a = ldstr(tile + tr_read_addr(lane, c, ks, 0)), b = ldstr(tile + tr_read_addr(lane, c, ks, 1));
    return (bf16x8){a[0], a[1], a[2], a[3], b[0], b[1], b[2], b[3]};
}
__device__ __forceinline__ int crow(int r, int hi) { return (r & 3) + 8 * (r >> 2) + 4 * hi; }

#define XB_TMO      128
#define XB_XCNT(j)  (256  + 64 * (j))
#define XB_XSUB(j)  (1280 + 64 * (j))
#define XB_XGEN(j)  (2304 + 64 * (j))
#define XB_TOP      3328
#define XB_TOPGEN   3392
#define XCD_BAR_WORDS 3456
#define XB_SPIN_CAP (1u << 22)
__device__ __forceinline__ unsigned xb_ld(unsigned* p)              { return __hip_atomic_load(p, __ATOMIC_RELAXED, __HIP_MEMORY_SCOPE_AGENT); }
__device__ __forceinline__ unsigned xb_add(unsigned* p, unsigned v) { return __hip_atomic_fetch_add(p, v, __ATOMIC_RELAXED, __HIP_MEMORY_SCOPE_AGENT); }
__device__ __forceinline__ unsigned xb_xcc_id() { return (unsigned)__builtin_amdgcn_s_getreg((3 << 11) | 20) & 0xFu; }
#define XB_SPIN(cond, bar) do { unsigned _sp = 0; while (cond) { __builtin_amdgcn_s_sleep(1); \
    if ((++_sp & 255u) == 0u) { if (xb_ld(&(bar)[XB_TMO])) break; if (_sp > XB_SPIN_CAP) { atomicAdd(&(bar)[XB_TMO], 1u); break; } } } } while (0)
struct XcdBarrier { unsigned* bar; unsigned x; volatile LAS unsigned* st; };
__device__ __forceinline__ XcdBarrier xcd_barrier_post(unsigned* bar, volatile LAS unsigned* st) {
    XcdBarrier b; b.bar = bar; b.x = xb_xcc_id(); b.st = st;
    if (cur_tid() == 0) (void)xb_add(&bar[XB_XCNT(b.x)], 1u);
    return b;
}
__device__ __forceinline__ void xcd_barrier_complete(unsigned* bar, unsigned x, unsigned& nloc, unsigned& nx) {
    const unsigned G = gridDim.x * gridDim.y * gridDim.z;
    unsigned sum, cnt, mine, sp = 0u;
    for (;;) {
        sum = 0u; cnt = 0u; mine = 0u;
#pragma unroll 1
        for (unsigned j = 0; j < 16; ++j) { const unsigned c = xb_ld(&bar[XB_XCNT(j)]); sum += c; cnt += (c > 0u) ? 1u : 0u; mine = (j == x) ? c : mine; }
        if (sum == G) break;
        __builtin_amdgcn_s_sleep(1);
        if ((++sp & 255u) == 0u) { if (xb_ld(&bar[XB_TMO])) break; if (sp > XB_SPIN_CAP) { atomicAdd(&bar[XB_TMO], 1u); break; } }
    }
    nloc = mine > 0u ? mine : 1u; nx = cnt > 0u ? cnt : 1u;
}
__device__ __attribute__((noinline)) void xcd_barrier(const XcdBarrier b) {
    asm volatile("s_waitcnt vmcnt(0)" ::: "memory");
    __syncthreads();
    if (cur_tid() == 0) {
        unsigned* bar = uni_ptr(b.bar);
        __builtin_amdgcn_s_waitcnt(0);
        unsigned nloc = b.st[0], nx = b.st[1];
        if (nloc == 0u) { xcd_barrier_complete(bar, b.x, nloc, nx); b.st[0] = nloc; b.st[1] = nx; }
        const unsigned old = xb_add(&bar[XB_XSUB(b.x)], 1u);
        const unsigned gen = old / nloc;
        if (old + 1u == (gen + 1u) * nloc) {
            __builtin_amdgcn_fence(__ATOMIC_RELEASE, "agent");
            asm volatile("s_waitcnt vmcnt(0)" ::: "memory");
            const unsigned og = xb_add(&bar[XB_TOP], 1u);
            const unsigned tg = og / nx;
            if (og + 1u == (tg + 1u) * nx) xb_add(&bar[XB_TOPGEN], 1u);
            else XB_SPIN(xb_ld(&bar[XB_TOPGEN]) == tg, bar);
            __builtin_amdgcn_fence(__ATOMIC_ACQUIRE, "agent");
            xb_add(&bar[XB_XGEN(b.x)], 1u);
            asm volatile("s_waitcnt vmcnt(0)" ::: "memory");
        } else {
            XB_SPIN(xb_ld(&bar[XB_XGEN(b.x)]) == gen, bar);
            __builtin_amdgcn_fence(__ATOMIC_ACQUIRE, "agent");
            asm volatile("s_waitcnt vmcnt(0)" ::: "memory");
        }
    }
    __syncthreads();
}

namespace ge {
constexpr int BM = 256, BK = 64, HALF = 128, HTB = HALF * BK * 2, STAGE_BYTES = 8 * HTB, NXCD = 8, WGM = 8;
__device__ __forceinline__ int lds_byte(int r, int c) { const int st = (r >> 4) * 2 + (c >> 5), rr = r & 15, cc = c & 31, ob = rr * 64 + cc * 2; return st * 1024 + (ob ^ (((ob >> 9) & 1) << 5)); }
__device__ __forceinline__ void stage_rc(int b, int& R, int& C) { const int st = b / 1024, sb = b % 1024, swz = sb ^ (((sb >> 9) & 1) << 5); R = (st >> 1) * 16 + swz / 64; C = (st & 1) * 32 + (swz % 64) / 2; }
__device__ __forceinline__ int perm32(int rho) { const int n = rho >> 4, i = rho & 15; return 8 * (i >> 2) + 4 * n + (i & 3); }
struct GU { const char* A; const char* B; int pm, pn, x0; };
typedef f32x4 Acc[2][2][4][2];
struct StaticOrder {
    int nM, nN, nwg, G, c;
    __device__ __forceinline__ void init(int M, int N, int G_, int c_) { nM = M / BM; nN = N / BM; nwg = nM * nN; G = G_; c = c_; }
    __device__ __forceinline__ bool next(int i, int& pm, int& pn) const {
        const long L = (long)i * G + c; if (L >= nwg) return false;
        int wgid = (int)L; { const int q = nwg / NXCD, r = nwg % NXCD, xcd = wgid % NXCD, off = wgid / NXCD; wgid = (xcd < r ? xcd * (q + 1) : r * (q + 1) + (xcd - r) * q) + off; }
        const int nig = WGM * nN, gid = wgid / nig, fm = gid * WGM, gsz = (nM - fm) < WGM ? (nM - fm) : WGM;
        pm = fm + ((wgid % nig) % gsz); pn = (wgid % nig) / gsz; return true;
    }
};

template <class P>
__device__ __forceinline__ void gemm_phase(LAS unsigned char* lds, const P& p) {
    int tid_ = cur_tid(); asm volatile("" : "+v"(tid_));
    const int tid = tid_, wid = __builtin_amdgcn_readfirstlane(tid >> 6), lane = tid & 63, wr = wid >> 2, wc = wid & 3, fr = lane & 15, fq = lane >> 4;
    const int K = p.K, nt = K / BK;
    int Rp[2], Cp[2]; unsigned voffB[2];
#pragma unroll
    for (int i = 0; i < 2; ++i) { int R, C; stage_rc(tid * 16 + i * 8192, R, C); Rp[i] = R; Cp[i] = C; const int Rb = (R & ~31) + perm32(R & 31); voffB[i] = (unsigned)(Rb * K + C) * 2u; }
    const size_t kstep = (size_t)(BK * 2);
    const size_t hstepB = (size_t)HALF * K * 2;
    const unsigned ldsw = (unsigned)wid * 1024u;
    const int aoff = lds_byte(wr * 64 + fr, fq * 8), boff = lds_byte(wc * 32 + fr, fq * 8);
#define PG8_SA(b, h) (((b) * 2 + (h)) * HTB)
#define PG8_SB(b, h) ((4 + (b) * 2 + (h)) * HTB)
#define PG8_STAGE(bufoff, gbase, voff) do { _Pragma("unroll") for (int _i = 0; _i < 2; ++_i) \
        __builtin_amdgcn_global_load_lds((const unsigned*)((const char*)(gbase) + (voff)[_i]), (LAS unsigned*)(lds + (bufoff) + ldsw + _i * 8192), 16, 0, 0); } while (0)
#define PG8_LDA(dst, b, h) do { _Pragma("unroll") for (int m = 0; m < 4; ++m) _Pragma("unroll") for (int k = 0; k < 2; ++k) dst[m][k] = *(const LAS bf16x8*)(lds + PG8_SA(b, h) + aoff + m * 2048 + k * 1024); } while (0)
#define PG8_LDB(dst, b, h) do { _Pragma("unroll") for (int n = 0; n < 2; ++n) _Pragma("unroll") for (int k = 0; k < 2; ++k) dst[n][k] = *(const LAS bf16x8*)(lds + PG8_SB(b, h) + boff + n * 2048 + k * 1024); } while (0)
#define PG8_MMA(ai, bj, At, Bt) do { __builtin_amdgcn_s_setprio(1); _Pragma("unroll") for (int m = 0; m < 4; ++m) _Pragma("unroll") for (int n = 0; n < 2; ++n) _Pragma("unroll") for (int k = 0; k < 2; ++k) \
        acc[ai][bj][m][n] = __builtin_amdgcn_mfma_f32_16x16x32_bf16(Bt[n][k], At[m][k], acc[ai][bj][m][n], 0, 0, 0); __builtin_amdgcn_s_setprio(0); } while (0)
#define PG8_WAIT_V(n) asm volatile("s_waitcnt vmcnt(" #n ")" ::: "memory")
#define PG8_WAIT_L(n) asm volatile("s_waitcnt lgkmcnt(" #n ")" ::: "memory")
#define PG8_BAR __builtin_amdgcn_s_barrier()
#define PG8_SCHED __builtin_amdgcn_sched_barrier(0)
    GU cur, nxt; int ui = 0;
    if (!p.next(0, cur)) return;
    Acc acc;
#pragma unroll
    for (int a = 0; a < 2; ++a)
#pragma unroll
        for (int b = 0; b < 2; ++b)
#pragma unroll
            for (int m = 0; m < 4; ++m)
#pragma unroll
                for (int n = 0; n < 2; ++n) acc[a][b][m][n] = (f32x4){0.f, 0.f, 0.f, 0.f};
    bf16x8 At[4][2], B0[2][2], B1[2][2];
    unsigned vA[2][2], vN[2][2];
    p.rowoff(cur, Rp, Cp, vA);
    const char* cA = cur.A; const char* cB = cur.B;
    PG8_STAGE(PG8_SB(0, 0), cB, voffB); PG8_STAGE(PG8_SB(0, 1), cB + hstepB, voffB); PG8_STAGE(PG8_SA(0, 0), cA, vA[0]); PG8_STAGE(PG8_SA(0, 1), cA, vA[1]);
    if (wr == 1) PG8_BAR;
    PG8_WAIT_V(2); PG8_BAR;
    PG8_STAGE(PG8_SB(1, 0), cB + kstep, voffB); PG8_STAGE(PG8_SA(1, 0), cA + kstep, vA[0]); PG8_STAGE(PG8_SB(1, 1), cB + hstepB + kstep, voffB);
    PG8_WAIT_V(6); PG8_BAR;
    for (;;) {
        const bool has_next = p.next(ui + 1, nxt);
        if (has_next) p.rowoff(nxt, Rp, Cp, vN);
        else {
#pragma unroll
            for (int h = 0; h < 2; ++h)
#pragma unroll
                for (int i = 0; i < 2; ++i) vN[h][i] = vA[h][i]; }
        const char* nA = has_next ? nxt.A : cA; const char* nB = has_next ? nxt.B : cB;
        for (int t = 0; t < nt; t += 2) {
            const bool last = (t == nt - 2);
            const char* a1 = cA + (size_t)(t + 1) * kstep;
            const char* a2 = last ? nA : cA + (size_t)(t + 2) * kstep; const char* b2 = last ? nB : cB + (size_t)(t + 2) * kstep;
            const char* a3 = a2 + kstep; const char* b3 = b2 + kstep;
            unsigned v2[2][2];
#pragma unroll
            for (int h = 0; h < 2; ++h)
#pragma unroll
                for (int i = 0; i < 2; ++i) v2[h][i] = last ? vN[h][i] : vA[h][i];
            PG8_LDB(B0, 0, 0); PG8_LDB(B1, 0, 1); PG8_SCHED; PG8_LDA(At, 0, 0); PG8_STAGE(PG8_SA(1, 1), a1, vA[1]);
            PG8_WAIT_V(8); PG8_WAIT_L(0); PG8_BAR; PG8_MMA(0, 0, At, B0); PG8_MMA(0, 1, At, B1); PG8_BAR; PG8_SCHED;
            PG8_LDA(At, 0, 1); PG8_STAGE(PG8_SB(0, 0), b2, voffB); PG8_STAGE(PG8_SB(0, 1), b2 + hstepB, voffB); PG8_STAGE(PG8_SA(0, 0), a2, v2[0]);
            PG8_WAIT_V(8); PG8_WAIT_L(0); PG8_BAR; PG8_MMA(1, 0, At, B0); PG8_MMA(1, 1, At, B1); PG8_BAR; PG8_SCHED;
            PG8_LDB(B0, 1, 0); PG8_LDB(B1, 1, 1); PG8_SCHED; PG8_LDA(At, 1, 0); PG8_STAGE(PG8_SA(0, 1), a2, v2[1]);
            PG8_WAIT_V(8); PG8_WAIT_L(0); PG8_BAR; PG8_MMA(0, 0, At, B0); PG8_MMA(0, 1, At, B1); PG8_BAR; PG8_SCHED;
            PG8_LDA(At, 1, 1); PG8_STAGE(PG8_SB(1, 0), b3, voffB); PG8_STAGE(PG8_SB(1, 1), b3 + hstepB, voffB); PG8_STAGE(PG8_SA(1, 0), a3, v2[0]);
            PG8_WAIT_V(8); PG8_WAIT_L(0); PG8_BAR; PG8_MMA(1, 0, At, B0); PG8_MMA(1, 1, At, B1); PG8_BAR; PG8_SCHED;
        }
        if (wr == 0) PG8_BAR;
        p.epi(acc, cur, wr, wc, fr, fq);
        if (!has_next) break;
#pragma unroll
        for (int a = 0; a < 2; ++a)
#pragma unroll
            for (int b = 0; b < 2; ++b)
#pragma unroll
                for (int m = 0; m < 4; ++m)
#pragma unroll
                    for (int n = 0; n < 2; ++n) acc[a][b][m][n] = (f32x4){0.f, 0.f, 0.f, 0.f};
        cur = nxt; cA = nA; cB = nB; ++ui;
#pragma unroll
        for (int h = 0; h < 2; ++h)
#pragma unroll
            for (int i = 0; i < 2; ++i) vA[h][i] = vN[h][i];
        if (wr == 1) PG8_BAR;
    }
    PG8_WAIT_V(0);
    PG8_BAR;
#undef PG8_SA
#undef PG8_SB
#undef PG8_STAGE
#undef PG8_LDA
#undef PG8_LDB
#undef PG8_MMA
#undef PG8_WAIT_V
#undef PG8_WAIT_L
#undef PG8_BAR
#undef PG8_SCHED
}

template <class Epi> struct Dense {
    const bf16* A; const bf16* Bt; int lda, K; StaticOrder S; Epi E;
    __device__ __forceinline__ bool next(int i, GU& u) const {
        int pm, pn; if (!S.next(i, pm, pn)) return false;
        u.pm = pm; u.pn = pn; u.x0 = 0; u.A = (const char*)A + (size_t)pm * BM * lda * 2; u.B = (const char*)Bt + (size_t)pn * BM * K * 2; return true;
    }
    __device__ __forceinline__ void rowoff(const GU&, const int (&R)[2], const int (&C)[2], unsigned (&v)[2][2]) const {
#pragma unroll
        for (int h = 0; h < 2; ++h)
#pragma unroll
            for (int i = 0; i < 2; ++i) v[h][i] = (unsigned)((h * HALF + R[i]) * lda + C[i]) * 2u;
    }
    __device__ __forceinline__ void epi(const Acc& acc, const GU& u, int wr, int wc, int fr, int fq) const {
        const int row0 = u.pm * BM + wr * 64 + fr, col0 = u.pn * BM + wc * 32 + 8 * fq;
        E.unit(acc, u, row0, col0);
    }
};
}

struct Frame {
    LAS unsigned char* lds;
    gu32* ctl;
    int tid, lane, wave, G, vcu;
    unsigned char* ws;
    float* out;
    const void* const* in;
};

__device__ __forceinline__ void frame_refresh(Frame& F) {
    int t = cur_tid(); asm volatile("" : "+v"(t)); F.tid = t; F.lane = t & 63; F.wave = __builtin_amdgcn_readfirstlane(t >> 6);
    F.ws = uni_ptr(F.ws); F.ctl = (gu32*)(F.ws + WS_CTL); F.G = uni_int(F.G); F.vcu = uni_int(F.vcu); F.out = uni_ptr(F.out);
}
template <class F> __device__ __forceinline__ void epi_rows(const ge::Acc& acc, int row0, int col0, F f) {
#pragma unroll
    for (int ai = 0; ai < 2; ++ai)
#pragma unroll
        for (int m = 0; m < 4; ++m)
        {
#pragma unroll
            for (int bj = 0; bj < 2; ++bj) f(row0 + ai * 128 + m * 16, col0 + bj * 128, acc[ai][bj][m][0], acc[ai][bj][m][1]);
            asm volatile("" ::: "memory"); }
}
template <class LD, class US> __device__ __forceinline__ void epi_rows_pf(const ge::Acc& acc, int row0, int col0, LD ld, US us) {
#pragma unroll
    for (int ai = 0; ai < 2; ++ai) {
        decltype(ld(0, 0)) pre[4][2];
#pragma unroll
        for (int m = 0; m < 4; ++m)
#pragma unroll
            for (int bj = 0; bj < 2; ++bj) pre[m][bj] = ld(row0 + ai * 128 + m * 16, col0 + bj * 128);
#pragma unroll
        for (int m = 0; m < 4; ++m)
#pragma unroll
            for (int bj = 0; bj < 2; ++bj) us(row0 + ai * 128 + m * 16, col0 + bj * 128, acc[ai][bj][m][0], acc[ai][bj][m][1], pre[m][bj]);
        asm volatile("" ::: "memory"); }
}
struct Pre2 { u32x4 a, b; };
__device__ __forceinline__ u32x4 pack8(f32x4 a, f32x4 b) { u32x4 w; w.x = pk2(a[0], a[1]); w.y = pk2(a[2], a[3]); w.z = pk2(b[0], b[1]); w.w = pk2(b[2], b[3]); return w; }
__device__ __forceinline__ void unpack8(u32x4 w, f32x4& a, f32x4& b) { a = (f32x4){bflo(w.x), bfhi(w.x), bflo(w.y), bfhi(w.y)}; b = (f32x4){bflo(w.z), bfhi(w.z), bflo(w.w), bfhi(w.w)}; }

struct EpiProj {
    bf16* proj; float* dtraw;
    __device__ __forceinline__ void unit(const ge::Acc& acc, const ge::GU& u, int row0, int col0) const {
        epi_rows(acc, row0, col0, [&](int row, int col, f32x4 a, f32x4 b) {
            *(u32x4*)(proj + (size_t)row * NPAD + col) = pack8(a, b);
            if (col >= CDT && col < CDT + 16) { float* d = dtraw + (size_t)row * 16 + (col - CDT); *(f32x4*)d = a; *(f32x4*)(d + 4) = b; }
        });
    }
};
struct EpiQ {
    bf16* Q; const float* rc; const float* rs;
    __device__ __forceinline__ void unit(const ge::Acc& acc, const ge::GU& u, int row0, int col0) const {
        const int fq = lane_id() >> 4;
        epi_rows(acc, row0, col0, [&](int row, int col, f32x4 a, f32x4 b) {
            const int cg = col & ~31;
            if ((cg % 96) == 64) {
                const int i0 = 8 * (fq & 1);
#pragma unroll
                for (int hf = 0; hf < 2; ++hf) {
                    f32x4& x = hf ? b : a;
                    const f32x4 c = *(const f32x4*)(rc + (size_t)row * 16 + i0 + 4 * hf), sn = *(const f32x4*)(rs + (size_t)row * 16 + i0 + 4 * hf);
                    f32x4 y;
#pragma unroll
                    for (int e = 0; e < 4; ++e) y[e] = __shfl_xor(x[e], 32);
                    x = (fq < 2) ? (x * c - y * sn) : (y * sn + x * c);
                }
            }
            *(u32x4*)(Q + (size_t)row * 768 + col) = pack8(a * QSCALE, b * QSCALE);
        });
    }
};
struct EpiStoreBf16 {
    bf16* O; int ld;
    __device__ __forceinline__ void unit(const ge::Acc& acc, const ge::GU& u, int row0, int col0) const {
        epi_rows(acc, row0, col0, [&](int row, int col, f32x4 a, f32x4 b) { *(u32x4*)(O + (size_t)row * ld + col) = pack8(a, b); });
    }
};
struct EpiGate {
    bf16* mb; const bf16* proj; int gcol0; int add;
    __device__ __forceinline__ void unit(const ge::Acc& acc, const ge::GU& u, int row0, int col0) const {
        epi_rows_pf(acc, row0, col0,
            [&](int row, int col) { Pre2 r; r.a = *(const u32x4*)(proj + (size_t)row * NPAD + gcol0 + col); r.b = r.a; if (add) r.b = *(const u32x4*)(mb + (size_t)row * D + col); return r; },
            [&](int row, int col, f32x4 a, f32x4 b, const Pre2& pr) {
            f32x4 g0, g1; unpack8(pr.a, g0, g1);
#pragma unroll
            for (int e = 0; e < 4; ++e) { a[e] *= sigmoidf_(g0[e]); b[e] *= sigmoidf_(g1[e]); }
            bf16* o = mb + (size_t)row * D + col;
            if (add) { f32x4 p0, p1; unpack8(pr.b, p0, p1); a += p0; b += p1; }
            *(u32x4*)o = pack8(a, b);
        });
    }
};
struct EpiWo {
    bf16* pre; const bf16* h;
    __device__ __forceinline__ void unit(const ge::Acc& acc, const ge::GU& u, int row0, int col0) const {
        epi_rows_pf(acc, row0, col0, [&](int row, int col) { return *(const u32x4*)(h + (size_t)row * D + col); },
            [&](int row, int col, f32x4 a, f32x4 b, const u32x4& hw) {
            f32x4 h0, h1; unpack8(hw, h0, h1);
            *(u32x4*)(pre + (size_t)row * D + col) = pack8(h0 * ALPHA + a, h1 * ALPHA + b);
        });
    }
};
struct EpiCat {
    float* logits; bf16* shhid; bf16* sg;
    __device__ __forceinline__ void unit(const ge::Acc& acc, const ge::GU& u, int row0, int col0) const {
        if (u.pn == 0) {
            epi_rows(acc, row0, col0, [&](int row, int col, f32x4 a, f32x4 b) { float* o = logits + (size_t)row * 256 + col; *(f32x4*)o = a; *(f32x4*)(o + 4) = b; });
        } else if (u.pn <= 2) {
            const int hc = (u.pn - 1) * 128 + (col0 & 127);
#pragma unroll
            for (int ai = 0; ai < 2; ++ai)
#pragma unroll
                for (int m = 0; m < 4; ++m) {
                    f32x4 g0 = acc[ai][0][m][0], g1 = acc[ai][0][m][1], u0 = acc[ai][1][m][0], u1 = acc[ai][1][m][1];
#pragma unroll
                    for (int e = 0; e < 4; ++e) { g0[e] = siluf_(g0[e]) * u0[e]; g1[e] = siluf_(g1[e]) * u1[e]; }
                    *(u32x4*)(shhid + (size_t)(row0 + ai * 128 + m * 16) * 256 + hc) = pack8(g0, g1);
                }
        } else {
            epi_rows(acc, row0, col0, [&](int row, int col, f32x4 a, f32x4 b) {
#pragma unroll
                for (int e = 0; e < 4; ++e) { a[e] = sigmoidf_(a[e]); b[e] = sigmoidf_(b[e]); }
                *(u32x4*)(sg + (size_t)row * D + (col - 768)) = pack8(a, b);
            });
        }
    }
};
struct EpiPle {
    bf16* base; const bf16* h; const bf16* sg;
    __device__ __forceinline__ void unit(const ge::Acc& acc, const ge::GU& u, int row0, int col0) const {
        epi_rows_pf(acc, row0, col0, [&](int row, int col) { Pre2 r; r.a = *(const u32x4*)(sg + (size_t)row * D + col); r.b = *(const u32x4*)(h + (size_t)row * D + col); return r; },
            [&](int row, int col, f32x4 a, f32x4 b, const Pre2& pr) {
            f32x4 g0, g1; unpack8(pr.a, g0, g1);
            f32x4 h0, h1; unpack8(pr.b, h0, h1);
            *(u32x4*)(base + (size_t)row * D + col) = pack8(h0 * ALPHA + a * g0, h1 * ALPHA + b * g1);
        });
    }
};
struct EpiAddF32 {
    bf16* base;
    __device__ __forceinline__ void unit(const ge::Acc& acc, const ge::GU& u, int row0, int col0) const {
        epi_rows_pf(acc, row0, col0, [&](int row, int col) { return *(const u32x4*)(base + (size_t)row * D + col); },
            [&](int row, int col, f32x4 a, f32x4 b, const u32x4& pw) {
            bf16* o = base + (size_t)row * D + col; f32x4 p0, p1; unpack8(pw, p0, p1);
            *(u32x4*)o = pack8(p0 + a, p1 + b);
        });
    }
};

__device__ __forceinline__ int find_expert(const LAS int* toff, int j) {
    int lo = 0, hi = NEXP;
    while (hi - lo > 1) { const int mid = (lo + hi) >> 1; if (toff[mid] <= j) lo = mid; else hi = mid; }
    return lo;
}
struct MoeGU {
    const bf16* hb; const bf16* wgu; const int* stok; bf16* hid; const LAS int* toff; int G, c, K;
    __device__ __forceinline__ bool next(int i, ge::GU& u) const {
        const int L = i * G + c, ntile = toff[NEXP]; if (L >= ntile * 2) return false;
        const int j = L >> 1, pn = L & 1, e = find_expert(toff, j);
        u.pm = j; u.pn = pn; u.x0 = e; u.A = (const char*)hb; u.B = (const char*)wgu + ((size_t)e * 512 + pn * 256) * 1024 * 2; return true;
    }
    __device__ __forceinline__ void rowoff(const ge::GU& u, const int (&R)[2], const int (&C)[2], unsigned (&v)[2][2]) const {
#pragma unroll
        for (int h = 0; h < 2; ++h)
#pragma unroll
            for (int i = 0; i < 2; ++i) v[h][i] = (unsigned)(stok[u.pm * 256 + h * 128 + R[i]] * D + C[i]) * 2u;
    }
    __device__ __forceinline__ void epi(const ge::Acc& acc, const ge::GU& u, int wr, int wc, int fr, int fq) const {
        const int slot0 = u.pm * 256 + wr * 64 + fr, hc = u.pn * 128 + wc * 32 + 8 * fq;
#pragma unroll
        for (int ai = 0; ai < 2; ++ai)
#pragma unroll
            for (int m = 0; m < 4; ++m) {
                f32x4 g0 = acc[ai][0][m][0], g1 = acc[ai][0][m][1], u0 = acc[ai][1][m][0], u1 = acc[ai][1][m][1];
#pragma unroll
                for (int e = 0; e < 4; ++e) { g0[e] = siluf_(g0[e]) * u0[e]; g1[e] = siluf_(g1[e]) * u1[e]; }
                *(u32x4*)(hid + (size_t)(slot0 + ai * 128 + m * 16) * 256 + hc) = pack8(g0, g1);
            }
    }
};
struct MoeDown {
    const bf16* hid; const bf16* wd; const float* sw; unsigned char* Y; const LAS int* toff; int G, c, K;
    __device__ __forceinline__ bool next(int i, ge::GU& u) const {
        const int L = i * G + c, ntile = toff[NEXP]; if (L >= ntile * 4) return false;
        const int j = L >> 2, pn = L & 3, e = find_expert(toff, j);
        u.pm = j; u.pn = pn; u.x0 = e; u.A = (const char*)hid + (size_t)j * 256 * 256 * 2; u.B = (const char*)wd + ((size_t)e * 1024 + pn * 256) * 256 * 2; return true;
    }
    __device__ __forceinline__ void rowoff(const ge::GU&, const int (&R)[2], const int (&C)[2], unsigned (&v)[2][2]) const {
#pragma unroll
        for (int h = 0; h < 2; ++h)
#pragma unroll
            for (int i = 0; i < 2; ++i) v[h][i] = (unsigned)((h * 128 + R[i]) * 256 + C[i]) * 2u;
    }
    __device__ __forceinline__ void epi(const ge::Acc& acc, const ge::GU& u, int wr, int wc, int fr, int fq) const {
        const int slot0 = u.pm * 256 + wr * 64 + fr, col0 = u.pn * 256 + wc * 32 + 8 * fq;
#pragma unroll
        for (int ai = 0; ai < 2; ++ai)
#pragma unroll
            for (int m = 0; m < 4; ++m) { const int slot = slot0 + ai * 128 + m * 16;
#pragma unroll
                for (int bj = 0; bj < 2; ++bj) { const f32x4 a = acc[ai][bj][m][0] * YSCALE, bq = acc[ai][bj][m][1] * YSCALE;
                    int w0 = __builtin_amdgcn_cvt_pk_fp8_f32(a[0], a[1], 0, false); w0 = __builtin_amdgcn_cvt_pk_fp8_f32(a[2], a[3], w0, true);
                    int w1 = __builtin_amdgcn_cvt_pk_fp8_f32(bq[0], bq[1], 0, false); w1 = __builtin_amdgcn_cvt_pk_fp8_f32(bq[2], bq[3], w1, true);
                    *(u32x2*)(Y + (size_t)slot * D + col0 + bj * 128) = (u32x2){(unsigned)w0, (unsigned)w1}; } }
    }
};

__device__ __forceinline__ void transpose_item(const float* W, int ld, int K, int nvalid, int col0, bf16* WT, int dst_row, int kb, LAS float* scr, int lane) {
    const int k0 = 64 * kb, n4 = lane & 7, kq = lane >> 3, cc = col0 + 4 * n4; const bool ok = cc < nvalid;
    const float* src = W + (size_t)(k0 + kq) * ld + cc;
    f32x4 v[8];
#pragma unroll
    for (int i = 0; i < 8; ++i) v[i] = ok ? *(const f32x4*)(src + (size_t)(8 * i) * ld) : (f32x4){0.f, 0.f, 0.f, 0.f};
#pragma unroll
    for (int i = 0; i < 8; ++i) { LAS float* d = scr + (8 * i + kq) * 33 + 4 * n4; d[0] = v[i][0]; d[1] = v[i][1]; d[2] = v[i][2]; d[3] = v[i][3]; }
    LDS_WAIT(); asm volatile("" ::: "memory");
    const int c = lane & 7;
#pragma unroll
    for (int j = 0; j < 4; ++j) { const int n = (lane >> 3) + 8 * j; const LAS float* s_ = scr + (8 * c) * 33 + n;
        u32x4 o; o.x = pk2(s_[0 * 33], s_[1 * 33]); o.y = pk2(s_[2 * 33], s_[3 * 33]); o.z = pk2(s_[4 * 33], s_[5 * 33]); o.w = pk2(s_[6 * 33], s_[7 * 33]);
        *(u32x4*)(WT + (size_t)(dst_row + n) * K + k0 + 8 * c) = o; }
    LDS_WAIT(); asm volatile("" ::: "memory");
}
#define TJOB(src_, ld_, K_, nvalid_, nrows_, dst_) { const int ni_ = ((K_) / 64) * ((nrows_) / 32); if (r < ni_) { const int nbk_ = (nrows_) / 32; \
        transpose_item((src_), (ld_), (K_), (nvalid_), 32 * (r % nbk_), (dst_), 32 * (r % nbk_), r / nbk_, scr, F.lane); continue; } r -= ni_; }
constexpr int ITEMS_SMALL = 16 * 168 + 6 * 24 + 4 * 32 + 8 * 32 + 16 * 32 + 16 * 32 + 16 * (8 + 4 * 4 + 32) + 4 * 32 + 4 * 32;
constexpr int ITEMS_EXP = NEXP * 384;
__device__ __forceinline__ void p0_small_weights(Frame& F) {
    LAS float* scr = (LAS float*)(F.lds + RING_OFF + F.wave * 16384);
    const int gw = F.vcu * NWAVES + F.wave, NGW = F.G * NWAVES;
    for (int it = gw; it < DEPTH * ITEMS_SMALL; it += NGW) {
        const int L = it / ITEMS_SMALL; int r = it % ITEMS_SMALL;
        unsigned char* wl = F.ws + WS_WSM + (size_t)L * WSM_LAYER;
        const float* w_in = (const float*)F.in[3] + (size_t)L * 1024 * NCOLS;
        TJOB(w_in, NCOLS, 1024, NCOLS, NPAD, (bf16*)(wl + WO_WIN));
        TJOB((const float*)F.in[5] + (size_t)L * 384 * 768, 768, 384, 768, 768, (bf16*)(wl + WO_WQ));
        TJOB((const float*)F.in[7] + (size_t)L * 256 * 1024, 1024, 256, 1024, 1024, (bf16*)(wl + WO_WKV));
        TJOB((const float*)F.in[14] + (size_t)L * 512 * 1024, 1024, 512, 1024, 1024, (bf16*)(wl + WO_WAB));
        TJOB((const float*)F.in[15] + (size_t)L * 1024 * 1024, 1024, 1024, 1024, 1024, (bf16*)(wl + WO_WSB));
        TJOB((const float*)F.in[16] + (size_t)L * 1024 * 1024, 1024, 1024, 1024, 1024, (bf16*)(wl + WO_WO));
        bf16* wcat = (bf16*)(wl + WO_WCAT);
        const float* shg = (const float*)F.in[24] + (size_t)L * 1024 * 256; const float* shu = (const float*)F.in[25] + (size_t)L * 1024 * 256;
        TJOB((const float*)F.in[19] + (size_t)L * 1024 * 256, 256, 1024, 256, 256, wcat);
        TJOB(shg, 256, 1024, 128, 128, wcat + (size_t)256 * 1024);
        TJOB(shu, 256, 1024, 128, 128, wcat + (size_t)384 * 1024);
        TJOB(shg + 128, 256, 1024, 128, 128, wcat + (size_t)512 * 1024);
        TJOB(shu + 128, 256, 1024, 128, 128, wcat + (size_t)640 * 1024);
        TJOB((const float*)F.in[28] + (size_t)L * 1024 * 1024, 1024, 1024, 1024, 1024, wcat + (size_t)768 * 1024);
        TJOB((const float*)F.in[26] + (size_t)L * 256 * 1024, 1024, 256, 1024, 1024, (bf16*)(wl + WO_WSD));
        TJOB((const float*)F.in[27] + (size_t)L * 256 * 1024, 1024, 256, 1024, 1024, (bf16*)(wl + WO_WPLE));
    }
}
__device__ __forceinline__ void p0_expert_weights(Frame& F, int L) {
    LAS float* scr = (LAS float*)(F.lds + RING_OFF + F.wave * 16384);
    int lane_ = F.lane; asm volatile("" : "+v"(lane_));
    const int gw = F.vcu * NWAVES + F.wave, NGW = F.G * NWAVES, lane = lane_, n4 = lane & 7, kq = lane >> 3;
    const float* wg = (const float*)F.in[21] + (size_t)L * NEXP * 1024 * 256; const float* wu = (const float*)F.in[22] + (size_t)L * NEXP * 1024 * 256;
    const float* wd = (const float*)F.in[23] + (size_t)L * NEXP * 256 * 1024;
    bf16* wgu_t = (bf16*)(F.ws + WS_WGU + (size_t)L * WGU_LAYER); bf16* wd_t = (bf16*)(F.ws + WS_WD + (size_t)L * WD_LAYER);
#define TP_DECODE(it_, SRC, LD, DST, KK) do { const int e_ = (it_) / 384, r_ = (it_) % 384, which_ = r_ >> 7, rr_ = r_ & 127; \
        if (which_ < 2) { const int kb_ = rr_ >> 3, nb_ = rr_ & 7; LD = 256; KK = 1024; \
            SRC = (which_ ? wu : wg) + (size_t)e_ * 1024 * 256 + (size_t)(64 * kb_ + kq) * 256 + 32 * nb_ + 4 * n4; \
            DST = wgu_t + (size_t)e_ * 512 * 1024 + (size_t)((nb_ >> 2) * 256 + which_ * 128 + 32 * (nb_ & 3)) * 1024 + 64 * kb_; } \
        else { const int kb_ = rr_ >> 5, nb_ = rr_ & 31; LD = 1024; KK = 256; \
            SRC = wd + (size_t)e_ * 256 * 1024 + (size_t)(64 * kb_ + kq) * 1024 + 32 * nb_ + 4 * n4; \
            DST = wd_t + (size_t)e_ * 1024 * 256 + (size_t)(32 * nb_) * 256 + 64 * kb_; } } while (0)
#define TP_LOAD(BUF, DSTV, KV, item) do { const float* s__; int ld__; TP_DECODE((item), s__, ld__, DSTV, KV); \
        _Pragma("unroll") for (int i = 0; i < 8; ++i) asm volatile("global_load_dwordx4 %0, %1, off nt" : "=v"(BUF[i]) : "v"(s__ + (size_t)(8 * i) * ld__) : "memory"); } while (0)
#define TP_WAIT7(BUF) asm volatile("s_waitcnt vmcnt(7)" ::: "memory")
#define TP_PROC(BUF, DSTV, KV) do { \
        _Pragma("unroll") for (int i = 0; i < 8; ++i) { LAS float* d = scr + (8 * i + kq) * 33 + 4 * n4; d[0] = BUF[i][0]; d[1] = BUF[i][1]; d[2] = BUF[i][2]; d[3] = BUF[i][3]; } \
        LDS_WAIT(); asm volatile("" ::: "memory"); \
        _Pragma("unroll") for (int j = 0; j < 4; ++j) { const int n = (lane >> 3) + 8 * j; const LAS float* s_ = scr + (8 * (lane & 7)) * 33 + n; \
            u32x4 o; o.x = pk2(s_[0 * 33], s_[1 * 33]); o.y = pk2(s_[2 * 33], s_[3 * 33]); o.z = pk2(s_[4 * 33], s_[5 * 33]); o.w = pk2(s_[6 * 33], s_[7 * 33]); \
            __builtin_nontemporal_store(o, (u32x4*)(DSTV + (size_t)n * KV + 8 * (lane & 7))); } \
        LDS_WAIT(); asm volatile("" ::: "memory"); } while (0)
#define TP_WAIT0(BUF) asm volatile("s_waitcnt vmcnt(0)" ::: "memory")
    for (int it = gw; it < ITEMS_EXP; it += 2 * NGW) {
        f32x4 b0[8], b1[8]; bf16 *d0, *d1 = wgu_t; int K0, K1 = 0;
        const bool two = it + NGW < ITEMS_EXP;
        TP_LOAD(b0, d0, K0, it);
        if (two) { TP_LOAD(b1, d1, K1, it + NGW); TP_WAIT7(b0); } else TP_WAIT0(b0);
        TP_PROC(b0, d0, K0);
        if (two) { TP_WAIT0(b1); TP_PROC(b1, d1, K1); }
    }
#undef TP_WAIT0
#undef TP_WAIT7
#undef TP_PROC
#undef TP_LOAD
#undef TP_DECODE
}
__device__ __forceinline__ bool conv_acquire(Frame& F, int L, bool block) {
    volatile LAS int* flag = (volatile LAS int*)(F.lds + LDSCTL_OFF + 384);
    unsigned* sem = (unsigned*)(F.ctl + CW_SEM + 64 * L);
    if (cur_tid() == 0) {
        int ok = 0;
        for (;;) {
            const unsigned old = __hip_atomic_fetch_add(sem, 1u, __ATOMIC_RELAXED, __HIP_MEMORY_SCOPE_AGENT);
            if (old < CONV_LIMIT) { ok = 1; break; }
            __hip_atomic_fetch_sub(sem, 1u, __ATOMIC_RELAXED, __HIP_MEMORY_SCOPE_AGENT);
            if (!block) break;
            __builtin_amdgcn_s_sleep(64);
        }
        *flag = ok;
    }
    WG_BAR();
    const int ok = __builtin_amdgcn_readfirstlane(*flag);
    WG_BAR();
    return ok != 0;
}
__device__ __forceinline__ void conv_release(Frame& F, int L) {
    if (cur_tid() == 0) __hip_atomic_fetch_sub((unsigned*)(F.ctl + CW_SEM + 64 * L), 1u, __ATOMIC_RELAXED, __HIP_MEMORY_SCOPE_AGENT);
}
__device__ __forceinline__ void p0_misc(Frame& F) {
    const int gw = F.vcu * NWAVES + F.wave, NGW = F.G * NWAVES;
    const float* x = (const float*)F.in[0]; bf16* hb = (bf16*)(F.ws + WS_HB);
    for (int m0 = gw; m0 < T; m0 += 2 * NGW) {
        const bool two = m0 + NGW < T; const int m1 = two ? m0 + NGW : m0;
        f32x4 v[2][4];
#pragma unroll
        for (int r = 0; r < 2; ++r) { const f32x4* xr = (const f32x4*)(x + (size_t)(r ? m1 : m0) * D) + F.lane;
#pragma unroll
            for (int j = 0; j < 4; ++j) v[r][j] = xr[64 * j]; }
#pragma unroll
        for (int r = 0; r < 2; ++r) { if (r == 1 && !two) break; u32x2* hr = (u32x2*)(hb + (size_t)(r ? m1 : m0) * D) + F.lane;
#pragma unroll
            for (int j = 0; j < 4; ++j) hr[64 * j] = (u32x2){pk2(v[r][j][0], v[r][j][1]), pk2(v[r][j][2], v[r][j][3])}; }
    }
    const int* pos = (const int*)F.in[2]; float* rc = (float*)(F.ws + WS_ROPE); float* rs = rc + (size_t)T * 16;
    const double cfr[16] = {0.15915494309189535, 0.08949940160889101, 0.050329212104487035, 0.0283021958306234, 0.015915494309189534, 0.008949940160889102, 0.005032921210448704, 0.00283021958306234,
                            0.0015915494309189536, 0.0008949940160889102, 0.0005032921210448703, 0.00028302195830623395, 0.00015915494309189535, 8.949940160889102e-05, 5.0329212104487035e-05, 2.8302195830623396e-05};
    for (int idx = (F.vcu * NWAVES * 64) + F.tid; idx < T * 16; idx += F.G * NWAVES * 64) {
        const int t = idx >> 4, i = idx & 15; double rev = (double)pos[t] * cfr[i]; rev -= __builtin_floor(rev);
        rc[idx] = __builtin_amdgcn_cosf((float)rev); rs[idx] = __builtin_amdgcn_sinf((float)rev);
    }
}

__device__ __forceinline__ void prep_rows(Frame& F, int L) {
    const int gw = F.vcu * NWAVES + F.wave, NGW = F.G * NWAVES, lane = F.lane;
    const bf16* proj = (const bf16*)(F.ws + X_PROJ); bf16* qn = (bf16*)(F.ws + X_QN); bf16* ckvn = (bf16*)(F.ws + X_CKVN); bf16* kpe = (bf16*)(F.ws + X_KPE);
    const float* qg = (const float*)F.in[4] + L * 384; const float* kg = (const float*)F.in[6] + L * 256;
    const float* rc = (const float*)(F.ws + WS_ROPE); const float* rs = rc + (size_t)T * 16;
    float gq[6], gk[4];
#pragma unroll
    for (int j = 0; j < 6; ++j) gq[j] = qg[lane * 2 + (j & 1) + 128 * (j >> 1)];
#pragma unroll
    for (int j = 0; j < 4; ++j) gk[j] = kg[lane * 4 + j];
    for (int t0 = gw; t0 < T; t0 += 2 * NGW) {
        const bool two = t0 + NGW < T; const int t1 = two ? t0 + NGW : t0;
        unsigned qw[2][3]; u32x2 kw[2]; float xv[2], cc[2], ss[2];
#pragma unroll
        for (int r = 0; r < 2; ++r) { const int t = r ? t1 : t0; const bf16* pr = proj + (size_t)t * NPAD;
#pragma unroll
            for (int j = 0; j < 3; ++j) qw[r][j] = *(const unsigned*)(pr + CQ + 128 * j + 2 * lane);
            kw[r] = *(const u32x2*)(pr + CKV + 4 * lane);
            xv[r] = bf2f(pr[CKPE + (lane & 31)]); cc[r] = rc[(size_t)t * 16 + (lane & 15)]; ss[r] = rs[(size_t)t * 16 + (lane & 15)]; }
#pragma unroll
        for (int r = 0; r < 2; ++r) { if (r == 1 && !two) break; const int t = r ? t1 : t0;
            float q[6], k[4];
#pragma unroll
            for (int j = 0; j < 3; ++j) { q[2 * j] = bflo(qw[r][j]); q[2 * j + 1] = bfhi(qw[r][j]); }
            k[0] = bflo(kw[r].x); k[1] = bfhi(kw[r].x); k[2] = bflo(kw[r].y); k[3] = bfhi(kw[r].y);
            float sq = 0.f, sk = 0.f;
#pragma unroll
            for (int j = 0; j < 6; ++j) sq += q[j] * q[j];
#pragma unroll
            for (int j = 0; j < 4; ++j) sk += k[j] * k[j];
            sq = wave_sum(sq); sk = wave_sum(sk);
            const float rq = __builtin_amdgcn_rsqf(sq * (1.f / 384.f) + 1e-6f), rk = __builtin_amdgcn_rsqf(sk * (1.f / 256.f) + 1e-6f);
#pragma unroll
            for (int j = 0; j < 3; ++j) *(unsigned*)(qn + (size_t)t * 384 + 128 * j + 2 * lane) = pk2(q[2 * j] * rq * gq[2 * j], q[2 * j + 1] * rq * gq[2 * j + 1]);
            *(u32x2*)(ckvn + (size_t)t * 256 + 4 * lane) = (u32x2){pk2(k[0] * rk * gk[0], k[1] * rk * gk[1]), pk2(k[2] * rk * gk[2], k[3] * rk * gk[3])};
            const float yv = __shfl_xor(xv[r], 16);
            const float o = (lane & 16) ? (yv * ss[r] + xv[r] * cc[r]) : (xv[r] * cc[r] - yv * ss[r]);
            if (lane < 32) kpe[(size_t)t * 32 + lane] = f2bf(o); }
    }
}
template <bool COMBINE, bool OUT32> __device__ __forceinline__ void ln_rows(Frame& F, const bf16* src, const float* g, const float* b, const int* rpos, const unsigned char* Y8, const float* rwt) {
    const int gw = F.vcu * NWAVES + F.wave, NGW = F.G * NWAVES, lane = F.lane;
    bf16* hb = (bf16*)(F.ws + WS_HB);
    f32x4 gv[4], bv[4];
#pragma unroll
    for (int j = 0; j < 4; ++j) { gv[j] = *((const f32x4*)g + 4 * lane + j); bv[j] = *((const f32x4*)b + 4 * lane + j); }
    for (int t = gw; t < T; t += NGW) {
        f32x4 v[4];
#pragma unroll
        for (int i = 0; i < 2; ++i) { const u32x4 w = *((const u32x4*)(src + (size_t)t * D) + 2 * lane + i); unpack8(w, v[2 * i], v[2 * i + 1]); }
        if (COMBINE) {
            const int slot = rpos[t * TOPK + (lane & 7)]; const float wgt = rwt[t * TOPK + (lane & 7)] * (1.f / YSCALE);
            f32x4 ra[4] = {{0.f, 0.f, 0.f, 0.f}, {0.f, 0.f, 0.f, 0.f}, {0.f, 0.f, 0.f, 0.f}, {0.f, 0.f, 0.f, 0.f}};
#pragma unroll
            for (int k = 0; k < TOPK; ++k) { const int sl = __builtin_amdgcn_readlane(slot, k); const u32x4 w = *((const u32x4*)(Y8 + (size_t)sl * D) + lane);
                const unsigned ww[4] = {w.x, w.y, w.z, w.w};
                const float wk = __uint_as_float(__builtin_amdgcn_readlane(__float_as_uint(wgt), k));
#pragma unroll
                for (int j = 0; j < 4; ++j) { const f32x2 lo = __builtin_amdgcn_cvt_pk_f32_fp8((int)ww[j], false), hi = __builtin_amdgcn_cvt_pk_f32_fp8((int)ww[j], true); ra[j] += (f32x4){lo[0], lo[1], hi[0], hi[1]} * wk; } }
#pragma unroll
            for (int j = 0; j < 4; ++j) v[j] += ra[j];
        }
        float s = 0.f;
#pragma unroll
        for (int j = 0; j < 4; ++j) s += (v[j][0] + v[j][1]) + (v[j][2] + v[j][3]);
        const float mean = wave_sum(s) * (1.f / D); float s2 = 0.f;
#pragma unroll
        for (int j = 0; j < 4; ++j) { v[j] = v[j] - mean; s2 += (v[j][0] * v[j][0] + v[j][1] * v[j][1]) + (v[j][2] * v[j][2] + v[j][3] * v[j][3]); }
        const float rstd = __builtin_amdgcn_rsqf(wave_sum(s2) * (1.f / D) + 1e-5f);
        f32x4 o[4];
#pragma unroll
        for (int j = 0; j < 4; ++j) { o[j] = v[j] * rstd * gv[j] + bv[j]; if (OUT32) *((f32x4*)(F.out + (size_t)t * D) + 4 * lane + j) = o[j]; }
        if (!OUT32) {
#pragma unroll
        for (int i = 0; i < 2; ++i) *((u32x4*)(hb + (size_t)t * D) + 2 * lane + i) = pack8(o[2 * i], o[2 * i + 1]); }
    }
}
__device__ __forceinline__ void conv_p(Frame& F, int L) {
    const float* p = (const float*)F.in[1] + (size_t)L * T * 256; bf16* pb = (bf16*)(F.ws + X_PB);
    const size_t n = (size_t)T * 256 / 4, st = (size_t)F.G * NWAVES * 64;
    for (size_t i = (size_t)(F.vcu * NWAVES * 64 + F.tid); i < n; i += 4 * st) {
        f32x4 v[4];
#pragma unroll
        for (int k = 0; k < 4; ++k) if (i + k * st < n) v[k] = ((const f32x4*)p)[i + k * st];
#pragma unroll
        for (int k = 0; k < 4; ++k) if (i + k * st < n) ((u32x2*)pb)[i + k * st] = (u32x2){pk2(v[k][0], v[k][1]), pk2(v[k][2], v[k][3])}; }
}

template <int CTRL> __device__ __forceinline__ float dppf(float v) { return __int_as_float(__builtin_amdgcn_update_dpp(0, __float_as_int(v), CTRL, 0xF, 0xF, false)); }
__device__ __forceinline__ float rdlane(float v, int l) { return __uint_as_float(__builtin_amdgcn_readlane(__float_as_uint(v), l)); }
__device__ __forceinline__ float wave_max_uniform(float v) {
    v = fmaxf(v, dppf<0xB1>(v)); v = fmaxf(v, dppf<0x4E>(v)); v = fmaxf(v, dppf<0x141>(v)); v = fmaxf(v, dppf<0x140>(v));
    return fmaxf(fmaxf(rdlane(v, 0), rdlane(v, 16)), fmaxf(rdlane(v, 32), rdlane(v, 48)));
}
__device__ __forceinline__ void topk_rows(Frame& F, int L) {
    const int gw = F.vcu * NWAVES + F.wave, NGW = F.G * NWAVES, lane = F.lane;
    const float* logits = (const float*)(F.ws + X_LOGITS); int* ridx = (int*)(F.ws + X_RIDX); float* rw = (float*)(F.ws + X_RW); int* rrank = (int*)(F.ws + X_RRANK);
    unsigned* cnt = (unsigned*)(F.ctl + CW_CNT + L * NEXP);
    const f32x4 bias = *((const f32x4*)((const float*)F.in[20] + L * NEXP) + lane);
    const int g = lane >> 3;
    auto route = [&](const f32x4& lg, int& myidx, float& mysc, float& ssum) {
        float sc[4], sel[4];
#pragma unroll
        for (int j = 0; j < 4; ++j) { sc[j] = __builtin_amdgcn_rcpf(1.f + __expf(-lg[j])); sel[j] = sc[j] + bias[j]; }
        float m1 = fmaxf(sel[0], sel[1]), m2 = fminf(sel[0], sel[1]);
        { const float a = fmaxf(sel[2], sel[3]), bb = fminf(sel[2], sel[3]); const float n1 = fmaxf(m1, a), n2 = fmaxf(fminf(m1, a), fmaxf(m2, bb)); m1 = n1; m2 = n2; }
#define TK_MERGE(CTRL) do { const float a1 = dppf<CTRL>(m1), a2 = dppf<CTRL>(m2); const float n1 = fmaxf(m1, a1), n2 = fmaxf(fminf(m1, a1), fmaxf(m2, a2)); m1 = n1; m2 = n2; } while (0)
        TK_MERGE(0xB1); TK_MERGE(0x4E); TK_MERGE(0x141);
#undef TK_MERGE
        const float gs = m1 + m2; int rank = 0;
#pragma unroll
        for (int j = 0; j < 8; ++j) { const float o = rdlane(gs, 8 * j); rank += (o > gs || (o == gs && j < g)) ? 1 : 0; }
        if (rank >= 4) {
#pragma unroll
            for (int j = 0; j < 4; ++j) sel[j] = -INFINITY; }
        myidx = 0; mysc = 0.f; ssum = 0.f;
#pragma unroll
        for (int k = 0; k < TOPK; ++k) {
            float bv = sel[0]; int bi = 0;
#pragma unroll
            for (int j = 1; j < 4; ++j) if (sel[j] > bv) { bv = sel[j]; bi = j; }
            const float wmax = wave_max_uniform(bv);
            const unsigned long long mask = __ballot(bv == wmax);
            const int wl = (int)__builtin_ctzll(mask);
            const int wj = __builtin_amdgcn_readlane(bi, wl);
            const float cand = (wj == 0) ? sc[0] : (wj == 1) ? sc[1] : (wj == 2) ? sc[2] : sc[3];
            const float wsc = rdlane(cand, wl);
            if (lane == wl) {
#pragma unroll
                for (int j = 0; j < 4; ++j) if (wj == j) sel[j] = -INFINITY; }
            ssum += wsc;
            if (lane == k) { myidx = 4 * wl + wj; mysc = wsc; }
        }
    };
    for (int t0 = gw; t0 < T; t0 += 2 * NGW) {
        const bool two = t0 + NGW < T; const int t1 = two ? t0 + NGW : t0;
        const f32x4 lg0 = *((const f32x4*)(logits + (size_t)t0 * NEXP) + lane), lg1 = *((const f32x4*)(logits + (size_t)t1 * NEXP) + lane);
        int i0, i1; float s0, s1, q0, q1;
        route(lg0, i0, s0, q0); route(lg1, i1, s1, q1);
        if (lane < TOPK) {
            const float w0 = s0 * __builtin_amdgcn_rcpf(q0) * 2.5f, w1 = s1 * __builtin_amdgcn_rcpf(q1) * 2.5f;
            const unsigned r0 = __hip_atomic_fetch_add(cnt + i0, 1u, __ATOMIC_RELAXED, __HIP_MEMORY_SCOPE_AGENT);
            unsigned r1 = 0; if (two) r1 = __hip_atomic_fetch_add(cnt + i1, 1u, __ATOMIC_RELAXED, __HIP_MEMORY_SCOPE_AGENT);
            ridx[t0 * TOPK + lane] = i0; rw[t0 * TOPK + lane] = w0; rrank[t0 * TOPK + lane] = (int)r0;
            if (two) { ridx[t1 * TOPK + lane] = i1; rw[t1 * TOPK + lane] = w1; rrank[t1 * TOPK + lane] = (int)r1; }
        }
    }
}
__device__ __forceinline__ void build_toff(Frame& F, int L, LAS int* toff) {
    const unsigned* cnt = (const unsigned*)(F.ctl + CW_CNT + L * NEXP);
    if (F.wave == 0) {
        int run = 0;
#pragma unroll
        for (int j = 0; j < 4; ++j) {
            const int e = 64 * j + F.lane; const int nt = ((int)__hip_atomic_load(cnt + e, __ATOMIC_RELAXED, __HIP_MEMORY_SCOPE_AGENT) + 255) >> 8;
            int inc = nt;
#pragma unroll
            for (int o = 1; o < 64; o <<= 1) { const int v = __shfl_up(inc, o); if (F.lane >= o) inc += v; }
            toff[e] = run + inc - nt; run += __shfl(inc, 63);
        }
        if (F.lane == 0) toff[NEXP] = run;
    }
    WG_BAR();
}
__device__ __forceinline__ void scatter_slots(Frame& F, int L, const LAS int* toff) {
    const int* ridx = (const int*)(F.ws + X_RIDX); const float* rw = (const float*)(F.ws + X_RW); int* rrank = (int*)(F.ws + X_RRANK);
    int* stok = (int*)(F.ws + X_STOK); float* sw = (float*)(F.ws + X_SW);
    const unsigned* cnt = (const unsigned*)(F.ctl + CW_CNT + L * NEXP);
    for (int i = F.vcu * NWAVES * 64 + F.tid; i < T * TOPK; i += F.G * NWAVES * 64) {
        const int e = ridx[i], slot = 256 * toff[e] + rrank[i];
        stok[slot] = i >> 3; sw[slot] = rw[i]; rrank[i] = slot;
    }
    for (int e = F.vcu; e < NEXP; e += F.G) {
        const int n = (int)__hip_atomic_load(cnt + e, __ATOMIC_RELAXED, __HIP_MEMORY_SCOPE_AGENT), s0 = 256 * toff[e] + n, s1 = 256 * toff[e + 1];
        for (int s = s0 + F.tid; s < s1; s += NWAVES * 64) { stok[s] = 0; sw[s] = 0.f; }
    }
}

namespace at {
constexpr int KSLOT = 12288, VSLOT = 8192, LDS_K = 0, LDS_V = 4 * KSLOT, LDS_WS = LDS_V + 3 * VSLOT, LDS_END = LDS_WS + 8 * 256;
__device__ __forceinline__ void glds16(const void* gsrc, unsigned lds_dst) { unsigned keep;
    asm volatile("s_mov_b32 %0, m0\n\ts_mov_b32 m0, %2\n\ts_nop 0\n\tglobal_load_lds_dwordx4 %1, off\n\ts_mov_b32 m0, %0" : "=&s"(keep) : "v"(gsrc), "s"(lds_dst) : "memory"); }
#define AT_SBAR() __builtin_amdgcn_sched_barrier(0)
#define AT_PIN(x) asm volatile("" : "+v"(x))
#define AT_MF(a, b, c) __builtin_amdgcn_mfma_f32_32x32x16_bf16(a, b, c, 0, 0, 0)
#define AT_MX3(a, b, c) __builtin_fmaxf(__builtin_fmaxf((a), (b)), (c))
__device__ __forceinline__ float rowmax(const f32x16& p0, const f32x16& p1) {
    float a = AT_MX3(p0[0], p0[1], p1[0]), b = AT_MX3(p0[2], p0[3], p1[1]); a = AT_MX3(a, p1[2], p1[3]);
#pragma unroll
    for (int r = 4; r < 16; r += 4) { a = AT_MX3(a, p0[r], p0[r + 1]); b = AT_MX3(b, p0[r + 2], p0[r + 3]); a = AT_MX3(a, p1[r], p1[r + 1]); b = AT_MX3(b, p1[r + 2], p1[r + 3]); }
    const float m = __builtin_fmaxf(a, b); auto rr = __builtin_amdgcn_permlane32_swap(__float_as_uint(m), __float_as_uint(m), false, false);
    return __builtin_fmaxf(__uint_as_float(rr[0]), __uint_as_float(rr[1])); }
__device__ __forceinline__ void cmask(f32x16& p0, f32x16& p1, int jb, int qrel, int hi) {
    const int kb = 64 * jb + 4 * hi;
#pragma unroll
    for (int r = 0; r < 16; ++r) { const int kv = kb + (r & 3) + 8 * (r >> 2); if (kv > qrel) p0[r] = -INFINITY; if (kv + 32 > qrel) p1[r] = -INFINITY; } }
__device__ __forceinline__ void attn_unit(int b, int h, int qb, const bf16* Q, const bf16* KV, const bf16* KPE, bf16* O, LAS unsigned char* shm) {
    int tid_ = cur_tid(); asm volatile("" : "+v"(tid_));
    const int tid = tid_, lane = tid & 63, r32 = lane & 31, hi = lane >> 5; const int wid = __builtin_amdgcn_readfirstlane(tid >> 6);
    const size_t tb = (size_t)b * SEQ; const int q0 = qb * 256;
    const unsigned lds0 = (unsigned)(size_t)shm;
    LAS float* wsf = (LAS float*)(shm + LDS_WS) + wid * 64;
    const int NT = (q0 + 256) / 64;
    bf16x8 qr[6];
    { const bf16* qp = Q + (tb + q0 + wid * 32 + r32) * 768 + h * 96 + hi * 8;
#pragma unroll
      for (int d0 = 0; d0 < 6; ++d0) qr[d0] = *(const bf16x8*)(qp + d0 * 16); }
    asm volatile("s_waitcnt vmcnt(0)" ::: "memory");
    const bf16* ksrc0 = KV + (tb + lane) * 1024 + h * 128 + wid * 8;
    const bf16* ksrc1 = KPE + (tb + lane) * 32 + (wid & 3) * 8;
    const bf16* vsrc = KV + (tb + 16 * (wid & 3) + (lane >> 2)) * 1024 + h * 128 + 64 + (wid >> 2) * 32 + (lane & 3) * 8;
#define AT_DMAK(t, s) do { glds16(ksrc0 + (size_t)(t) * 64 * 1024, (unsigned)__builtin_amdgcn_readfirstlane(lds0 + LDS_K + (s) * KSLOT + wid * 1024)); \
        if (wid < 4) glds16(ksrc1 + (size_t)(t) * 64 * 32, (unsigned)__builtin_amdgcn_readfirstlane(lds0 + LDS_K + (s) * KSLOT + (8 + wid) * 1024)); } while (0)
#define AT_DMAV(t, s) glds16(vsrc + (size_t)(t) * 64 * 1024, (unsigned)__builtin_amdgcn_readfirstlane(lds0 + LDS_V + (s) * VSLOT + wid * 1024))
#define AT_WAITC() do { if (wid < 4) asm volatile("s_waitcnt vmcnt(3) lgkmcnt(0)\n\ts_barrier" ::: "memory"); else asm volatile("s_waitcnt vmcnt(2) lgkmcnt(0)\n\ts_barrier" ::: "memory"); } while (0)
#define AT_WAIT0() asm volatile("s_waitcnt vmcnt(0) lgkmcnt(0)\n\ts_barrier" ::: "memory")
    AT_DMAK(0, 0); AT_DMAV(0, 0); AT_DMAK(1, 1); AT_DMAK(2, 2);
    constexpr float THR = 8.f;
    float mhat = 0.f, l_reg = 0.f; f32x2 mh2 = {0.f, 0.f}; f32x16 o0 = {}, o1 = {}; const f32x16 zero16 = {};
    const int qrel = wid * 32 + r32;
    bool resc = false;
    f32x16 pA0, pA1, pB0, pB1; bf16x8 kf[12]; s16x4 vlo[8], vhi[8]; u32x4 pw0, pw1, pw2, pw3;
    LAS const unsigned char* const kp0 = shm + LDS_K + hi * 1024 + r32 * 16;
    LAS const unsigned char* const vp0 = shm + LDS_V + ((lane >> 4) & 1) * 32 + (lane & 3) * 8 + (4 * hi + ((lane & 15) >> 2)) * 64;
    int sl_prev = 0, sl_cur = 0, sl_next = 1;
#define AT_ROT() do { sl_prev = sl_cur; sl_cur = sl_next; sl_next = (sl_next == 2) ? 0 : sl_next + 1; } while (0)
#define AT_KRDP(kp_, d0) do { kf[2 * (d0)] = *(LAS const bf16x8*)((kp_) + (d0) * 2048); kf[2 * (d0) + 1] = *(LAS const bf16x8*)((kp_) + (d0) * 2048 + 512); } while (0)
#define AT_KRD(d0) AT_KRDP(kp_, d0)
#define AT_VRD(i) do { vlo[i] = ldstr(vp_ + (((i) >> 2) * 4096 + ((i) & 3) * 1024)); vhi[i] = ldstr(vp_ + (((i) >> 2) * 4096 + ((i) & 3) * 1024 + 512)); } while (0)
#define AT_VFR(i) (bf16x8){vlo[i][0], vlo[i][1], vlo[i][2], vlo[i][3], vhi[i][0], vhi[i][1], vhi[i][2], vhi[i][3]}
#define AT_PAF(k) __builtin_bit_cast(bf16x8, pw##k)
#define AT_PK(P, i) pk2(P[i], P[i + 1])
#define AT_EX(X, i) X[i] = __builtin_amdgcn_exp2f(X[i])
#define AT_RESC() do { if (resc) { _Pragma("unroll") for (int r = 0; r < 16; ++r) { const float f = wsf[crow(r, hi)]; o0[r] *= f; o1[r] *= f; } } } while (0)
    if (wid < 4) asm volatile("s_waitcnt vmcnt(2) lgkmcnt(0)\n\ts_barrier" ::: "memory"); else asm volatile("s_waitcnt vmcnt(1) lgkmcnt(0)\n\ts_barrier" ::: "memory");
    AT_DMAK(3, 3); AT_DMAV(1, 1);
    { LAS const unsigned char* kp_ = kp0;
      _Pragma("unroll") for (int d0 = 0; d0 < 6; ++d0) AT_KRD(d0);
      pA0 = AT_MF(kf[0], qr[0], zero16); pA1 = AT_MF(kf[1], qr[0], zero16);
      _Pragma("unroll") for (int d0 = 1; d0 < 6; ++d0) { pA0 = AT_MF(kf[2 * d0], qr[d0], pA0); pA1 = AT_MF(kf[2 * d0 + 1], qr[d0], pA1); } }
    if (NT == 4) cmask(pA0, pA1, 0, qrel, hi);
    { mhat = rowmax(pA0, pA1); mh2 = (f32x2){-mhat, -mhat}; AT_PIN(mh2);
#pragma unroll
      for (int r = 0; r < 16; ++r) pA0[r] = __builtin_amdgcn_exp2f(pA0[r] - mhat); }
    AT_KRDP(kp0 + KSLOT, 0); AT_KRDP(kp0 + KSLOT, 1);
    sl_prev = 0; sl_cur = 1; sl_next = 2;
#define AT_GA(MFS, FILL) do { MFS; FILL; AT_SBAR(); } while (0)
#define AT_EX2(X, i) do { f32x2 x_ = {X[i], X[(i) + 1]}; x_ += mh2; X[i] = __builtin_amdgcn_exp2f(x_[0]); X[(i) + 1] = __builtin_amdgcn_exp2f(x_[1]); } while (0)
#define AT_SUM2(X, i) s2 += (f32x2){X[i], X[(i) + 1]}
#define AT_STEP(C0, C1, P0, P1, t, MASK, GK, GV, GL, CNT) do { \
    if (CNT) AT_WAITC(); else AT_WAIT0(); \
    if (GK) AT_DMAK((t) + 3, ((t) + 3) & 3); if (GV) AT_DMAV((t) + 1, sl_next); \
    LAS const unsigned char* const kp_ = kp0 + ((t) & 3) * KSLOT; LAS const unsigned char* const kpn_ = kp0 + (((t) + 1) & 3) * KSLOT; LAS const unsigned char* const vp_ = vp0 + sl_prev * VSLOT; \
    f32x2 s2 = {0.f, 0.f}; \
    AT_KRD(2); AT_SBAR(); \
    AT_GA(C0 = AT_MF(kf[0], qr[0], zero16), AT_EX2(P1, 0); pw0[0] = AT_PK(P0, 0); AT_SUM2(P0, 0); AT_PIN(P1); AT_PIN(pw0); AT_PIN(s2)); \
    AT_GA(C1 = AT_MF(kf[1], qr[0], zero16), AT_KRD(3); AT_EX2(P1, 2); pw0[1] = AT_PK(P0, 2); AT_SUM2(P0, 2); pw2[0] = AT_PK(P1, 0); AT_SUM2(P1, 0); AT_PIN(P1); AT_PIN(pw0); AT_PIN(pw2); AT_PIN(s2)); \
    AT_GA(C0 = AT_MF(kf[2], qr[1], C0), pw0[2] = AT_PK(P0, 4); AT_SUM2(P0, 4); pw2[1] = AT_PK(P1, 2); AT_SUM2(P1, 2); AT_PIN(pw0); AT_PIN(pw2); AT_PIN(s2)); \
    AT_GA(C1 = AT_MF(kf[3], qr[1], C1), AT_KRD(4); AT_EX2(P1, 4); pw0[3] = AT_PK(P0, 6); AT_SUM2(P0, 6); AT_PIN(P1); AT_PIN(pw0); AT_PIN(s2)); \
    AT_GA(C0 = AT_MF(kf[4], qr[2], C0), AT_EX2(P1, 6); pw1[0] = AT_PK(P0, 8); AT_SUM2(P0, 8); pw2[2] = AT_PK(P1, 4); AT_SUM2(P1, 4); AT_PIN(P1); AT_PIN(pw1); AT_PIN(pw2); AT_PIN(s2)); \
    AT_GA(C1 = AT_MF(kf[5], qr[2], C1), AT_KRD(5); pw1[1] = AT_PK(P0, 10); AT_SUM2(P0, 10); pw2[3] = AT_PK(P1, 6); AT_SUM2(P1, 6); AT_PIN(pw1); AT_PIN(pw2); AT_PIN(s2)); \
    AT_GA(C0 = AT_MF(kf[6], qr[3], C0), AT_EX2(P1, 8); pw1[2] = AT_PK(P0, 12); AT_SUM2(P0, 12); AT_PIN(P1); AT_PIN(pw1); AT_PIN(s2)); \
    AT_GA(C1 = AT_MF(kf[7], qr[3], C1), AT_EX2(P1, 10); pw1[3] = AT_PK(P0, 14); AT_SUM2(P0, 14); pw3[0] = AT_PK(P1, 8); AT_SUM2(P1, 8); AT_PIN(P1); AT_PIN(pw1); AT_PIN(pw3); AT_PIN(s2)); \
    AT_GA(C0 = AT_MF(kf[8], qr[4], C0), pw3[1] = AT_PK(P1, 10); AT_SUM2(P1, 10); AT_PIN(pw3); AT_PIN(s2)); \
    AT_GA(C1 = AT_MF(kf[9], qr[4], C1), AT_EX2(P1, 12); AT_PIN(P1)); \
    AT_GA(C0 = AT_MF(kf[10], qr[5], C0), AT_VRD(0); AT_EX2(P1, 14); pw3[2] = AT_PK(P1, 12); AT_SUM2(P1, 12); AT_PIN(P1); AT_PIN(pw3); AT_PIN(s2)); \
    AT_GA(C1 = AT_MF(kf[11], qr[5], C1), AT_VRD(4); pw3[3] = AT_PK(P1, 14); AT_SUM2(P1, 14); AT_PIN(pw3); AT_PIN(s2)); \
    l_reg += s2[0] + s2[1]; \
    if (MASK) cmask(C0, C1, (t) - (NT - 4), qrel, hi); \
    { const float rm = rowmax(C0, C1) - mhat; resc = false;                                                       \
      if (__builtin_expect(__any(rm > THR), 0)) { const float dl = __builtin_fmaxf(rm, 0.f); mhat += dl; mh2 = (f32x2){-mhat, -mhat}; AT_PIN(mh2);     \
          const float f = __builtin_amdgcn_exp2f(-dl); l_reg *= f; if (hi == 0) wsf[r32] = f; resc = true; } } \
    AT_PIN(l_reg); AT_SBAR(); \
    AT_GA(o0 = AT_MF(AT_PAF(0), AT_VFR(0), o0), AT_VRD(1); AT_EX2(C0, 0); AT_PIN(C0)); \
    AT_GA(o1 = AT_MF(AT_PAF(0), AT_VFR(4), o1), AT_VRD(5); AT_EX2(C0, 2); AT_PIN(C0)); \
    AT_GA(o0 = AT_MF(AT_PAF(1), AT_VFR(1), o0), AT_VRD(2); AT_EX2(C0, 4); AT_PIN(C0)); \
    AT_GA(o1 = AT_MF(AT_PAF(1), AT_VFR(5), o1), AT_VRD(6); AT_EX2(C0, 6); AT_PIN(C0)); \
    AT_GA(o0 = AT_MF(AT_PAF(2), AT_VFR(2), o0), AT_VRD(3); AT_EX2(C0, 8); AT_PIN(C0)); \
    AT_GA(o1 = AT_MF(AT_PAF(2), AT_VFR(6), o1), AT_VRD(7); AT_EX2(C0, 10); AT_PIN(C0)); \
    AT_GA(o0 = AT_MF(AT_PAF(3), AT_VFR(3), o0), if (GL) AT_KRDP(kpn_, 0); AT_EX2(C0, 12); AT_PIN(C0)); \
    AT_GA(o1 = AT_MF(AT_PAF(3), AT_VFR(7), o1), if (GL) AT_KRDP(kpn_, 1); AT_EX2(C0, 14); AT_PIN(C0)); \
    AT_RESC(); AT_ROT(); \
    } while (0)
    int t = 1;
    for (; t + 5 < NT; t += 2) {
        AT_STEP(pB0, pB1, pA0, pA1, t, false, true, true, true, true);
        AT_STEP(pA0, pA1, pB0, pB1, t + 1, false, true, true, true, true);
    }
    for (; t + 1 < NT; t += 2) {
        AT_STEP(pB0, pB1, pA0, pA1, t, true, (t + 3 < NT), (t + 1 < NT), (t + 1 < NT), false);
        AT_STEP(pA0, pA1, pB0, pB1, t + 1, true, (t + 4 < NT), (t + 2 < NT), (t + 2 < NT), false);
    }
    AT_STEP(pB0, pB1, pA0, pA1, NT - 1, true, false, false, false, false);
    { LAS const unsigned char* const vp_ = vp0 + sl_prev * VSLOT;
#pragma unroll
      for (int i = 0; i < 8; ++i) AT_VRD(i);
#pragma unroll
      for (int r = 0; r < 16; ++r) pB1[r] = __builtin_amdgcn_exp2f(pB1[r] - mhat);
      pw0 = (u32x4){AT_PK(pB0, 0), AT_PK(pB0, 2), AT_PK(pB0, 4), AT_PK(pB0, 6)}; pw1 = (u32x4){AT_PK(pB0, 8), AT_PK(pB0, 10), AT_PK(pB0, 12), AT_PK(pB0, 14)};
      pw2 = (u32x4){AT_PK(pB1, 0), AT_PK(pB1, 2), AT_PK(pB1, 4), AT_PK(pB1, 6)}; pw3 = (u32x4){AT_PK(pB1, 8), AT_PK(pB1, 10), AT_PK(pB1, 12), AT_PK(pB1, 14)};
      { float sa = 0.f;
#pragma unroll
        for (int r = 0; r < 16; ++r) sa += pB0[r] + pB1[r];
        l_reg += sa; }
      o0 = AT_MF(AT_PAF(0), AT_VFR(0), o0); o1 = AT_MF(AT_PAF(0), AT_VFR(4), o1);
      o0 = AT_MF(AT_PAF(1), AT_VFR(1), o0); o1 = AT_MF(AT_PAF(1), AT_VFR(5), o1);
      o0 = AT_MF(AT_PAF(2), AT_VFR(2), o0); o1 = AT_MF(AT_PAF(2), AT_VFR(6), o1);
      o0 = AT_MF(AT_PAF(3), AT_VFR(3), o0); o1 = AT_MF(AT_PAF(3), AT_VFR(7), o1); }
#undef AT_STEP
#undef AT_GA
#undef AT_EX2
#undef AT_SUM2
#undef AT_RESC
#undef AT_EX
#undef AT_PK
#undef AT_PAF
#undef AT_VFR
#undef AT_VRD
#undef AT_KRD
#undef AT_KRDP
#undef AT_ROT
#undef AT_WAIT0
#undef AT_WAITC
#undef AT_DMAV
#undef AT_DMAK
    { auto rr = __builtin_amdgcn_permlane32_swap(__float_as_uint(l_reg), __float_as_uint(l_reg), false, false); l_reg = __uint_as_float(rr[0]) + __uint_as_float(rr[1]); }
    if (hi == 0) wsf[32 + r32] = l_reg;
    bf16* Ow = O + (tb + q0 + wid * 32) * 512 + h * 64 + r32;
#pragma unroll
    for (int r = 0; r < 16; ++r) { const int q = crow(r, hi); const float f = __builtin_amdgcn_rcpf(wsf[32 + q]); Ow[(size_t)q * 512] = f2bf(o0[r] * f); Ow[(size_t)q * 512 + 32] = f2bf(o1[r] * f); }
    asm volatile("s_waitcnt lgkmcnt(0)\n\ts_barrier" ::: "memory");
}
}

namespace ssd {
constexpr int L_BM = 0, L_CG = 32768, L_X = 65536;
constexpr int S_ACUM = 0, S_DT = 2048;
template <class F> __device__ __forceinline__ void conv8(const bf16* proj, const float* cw, const float* cb, int ccol, size_t t0, int tr0, bool seq_start, F sink) {
    float w[4][8], bia[8];
#pragma unroll
    for (int k = 0; k < 4; ++k) { const f32x4 a = *(const f32x4*)(cw + k * 1536 + ccol), b = *(const f32x4*)(cw + k * 1536 + ccol + 4);
        w[k][0] = a[0]; w[k][1] = a[1]; w[k][2] = a[2]; w[k][3] = a[3]; w[k][4] = b[0]; w[k][5] = b[1]; w[k][6] = b[2]; w[k][7] = b[3]; }
    { const f32x4 a = *(const f32x4*)(cb + ccol), b = *(const f32x4*)(cb + ccol + 4); bia[0] = a[0]; bia[1] = a[1]; bia[2] = a[2]; bia[3] = a[3]; bia[4] = b[0]; bia[5] = b[1]; bia[6] = b[2]; bia[7] = b[3]; }
    float x0[8], x1[8], x2[8];
    auto ld = [&](int tr, float (&x)[8]) {
        if (seq_start && tr < 0) {
#pragma unroll
            for (int e = 0; e < 8; ++e) x[e] = 0.f;
        } else {
            const u32x4 v = *(const u32x4*)(proj + (t0 + tr) * NPAD + CXBC + ccol);
            x[0] = bflo(v.x); x[1] = bfhi(v.x); x[2] = bflo(v.y); x[3] = bfhi(v.y); x[4] = bflo(v.z); x[5] = bfhi(v.z); x[6] = bflo(v.w); x[7] = bfhi(v.w);
        } };
    ld(tr0 - 3, x0); ld(tr0 - 2, x1); ld(tr0 - 1, x2);
#pragma unroll
    for (int i = 0; i < 8; ++i) {
        float x3[8], y[8]; ld(tr0 + i, x3);
#pragma unroll
        for (int e = 0; e < 8; ++e) { const float v = bia[e] + w[0][e] * x0[e] + w[1][e] * x1[e] + w[2][e] * x2[e] + w[3][e] * x3[e]; y[e] = siluf_(v); x0[e] = x1[e]; x1[e] = x2[e]; x2[e] = x3[e]; }
        sink(tr0 + i, y);
    }
}
__device__ __forceinline__ void s1_unit(Frame& F, int L, int b, int c, int g) {
    LAS unsigned char* lds = F.lds; LAS float* side = (LAS float*)(F.lds + SIDE_OFF);
    int tid_ = cur_tid(); asm volatile("" : "+v"(tid_));
    const int tid = tid_, lane = tid & 63, wid = __builtin_amdgcn_readfirstlane(tid >> 6), r32 = lane & 31, hi = lane >> 5;
    const size_t t0 = (size_t)b * SEQ + (size_t)c * 128; const bool seq_start = (c == 0);
    const bf16* proj = (const bf16*)(F.ws + X_PROJ); const float* dtraw = (const float*)(F.ws + X_DTRAW);
    const float* cw = (const float*)F.in[8] + (size_t)L * 4 * 1536; const float* cb = (const float*)F.in[9] + L * 1536;
    const float* dtb = (const float*)F.in[10] + L * 16; const float* alog = (const float*)F.in[11] + L * 16; const float* dsk = (const float*)F.in[12] + L * 16;
    bf16* Cc = (bf16*)(F.ws + X_CC); float* eacum = (float*)(F.ws + X_EACUM); float* cdec = (float*)(F.ws + X_CDEC);
    bf16* ypart = (bf16*)(F.ws + X_YPART); bf16* states = (bf16*)(F.ws + X_STATES);
    { const int ch = tid & 31, tg = tid >> 5; const bool isC = ch >= 16; const int ccol = 1024 + (isC ? 256 : 0) + g * 128 + 8 * (ch & 15);
      conv8(proj, cw, cb, ccol, t0, 8 * tg, seq_start, [&](int tr, const float (&y)[8]) {
          const u32x4 w = {pk2(y[0], y[1]), pk2(y[2], y[3]), pk2(y[4], y[5]), pk2(y[6], y[7])};
          *(LAS u32x4*)(lds + (isC ? L_CG : L_BM) + off_b(tr, ch & 15)) = w;
          if (isC) *(u32x4*)(Cc + (t0 + tr) * 256 + g * 128 + 8 * (ch & 15)) = w; }); }
    LDS_BAR();
    { const int lb = wid >> 1; f32x16 gacc[2];
#pragma unroll
      for (int i = 0; i < 2; ++i) { const int sb = 2 * (wid & 1) + i; gacc[i] = (f32x16){};
          if (sb <= lb) {
#pragma unroll
              for (int ks = 0; ks < 8; ++ks) { const bf16x8 a = *(LAS const bf16x8*)(lds + L_CG + row_read_addr(32 * lb, lane, ks)), bb = *(LAS const bf16x8*)(lds + L_BM + row_read_addr(32 * sb, lane, ks));
                  gacc[i] = __builtin_amdgcn_mfma_f32_32x32x16_bf16(a, bb, gacc[i], 0, 0, 0); } } }
      LDS_BAR();
#pragma unroll
      for (int i = 0; i < 2; ++i) { const int sb = 2 * (wid & 1) + i;
          if (sb <= lb) {
#pragma unroll
              for (int r = 0; r < 16; ++r) { const int row = 32 * lb + crow(r, hi), col = 32 * sb + r32; *(LAS unsigned short*)(lds + L_CG + off_b(row, col >> 3) + (col & 7) * 2) = f2bf(gacc[i][r]); } } } }
#pragma unroll 1
    for (int rd = 0; rd < 2; ++rd) {
        if (wid < 4) {
            const int h = 8 * g + 4 * rd + wid; const float bia = dtb[h], a = -__expf(alog[h]);
            float d0 = dtraw[(t0 + lane) * 16 + h] + bia, d1 = dtraw[(t0 + 64 + lane) * 16 + h] + bia;
            d0 = fmaxf(d0, 0.f) + __logf(1.f + __expf(-fabsf(d0))); d1 = fmaxf(d1, 0.f) + __logf(1.f + __expf(-fabsf(d1)));
            d0 = fmaxf(d0, 1e-20f); d1 = fmaxf(d1, 1e-20f);
            float c0 = d0 * a, c1 = d1 * a;
#pragma unroll
            for (int o = 1; o < 64; o <<= 1) { const float v0 = __shfl_up(c0, o), v1 = __shfl_up(c1, o); if (lane >= o) { c0 += v0; c1 += v1; } }
            c1 += __shfl(c0, 63);
            side[S_ACUM / 4 + wid * 128 + lane] = c0; side[S_ACUM / 4 + wid * 128 + 64 + lane] = c1;
            side[S_DT / 4 + wid * 128 + lane] = d0; side[S_DT / 4 + wid * 128 + 64 + lane] = d1;
            eacum[(t0 + lane) * 16 + h] = __expf(c0); eacum[(t0 + 64 + lane) * 16 + h] = __expf(c1);
            if (lane == 63) cdec[((size_t)b * 64 + c) * 16 + h] = __expf(c1);
        }
        LDS_BAR();
        {
          const int ch = tid & 31, tg = tid >> 5, hd = ch >> 3, pch = ch & 7; const int ccol = (8 * g + 4 * rd + hd) * 64 + 8 * pch;
          conv8(proj, cw, cb, ccol, t0, 8 * tg, seq_start, [&](int tr, const float (&y)[8]) {
              const float d = side[S_DT / 4 + hd * 128 + tr];
              *(LAS u32x4*)(lds + L_X + (hd >> 1) * 32768 + off_b(tr, (hd & 1) * 8 + pch)) = (u32x4){pk2(y[0] * d, y[1] * d), pk2(y[2] * d, y[3] * d), pk2(y[4] * d, y[5] * d), pk2(y[6] * d, y[7] * d)}; }); }
        LDS_BAR();
        {
          const int hd = wid >> 1, sub = wid & 1, h = 8 * g + 4 * rd + hd;
          LAS const unsigned char* Xt = lds + L_X + (hd >> 1) * 32768; const int cb0 = (hd & 1) * 2;
          LAS const float* ac = side + S_ACUM / 4 + hd * 128; LAS const float* dts = side + S_DT / 4 + hd * 128;
          const float dskip = dsk[h];
#pragma unroll 1
          for (int rbi = 0; rbi < 2; ++rbi) {
              const int rb = sub ? (1 + rbi) : (3 * rbi); const int l = 32 * rb + r32; const float al = ac[l], dl = dskip * __builtin_amdgcn_rcpf(dts[l]);
              f32x16 y0 = {}, y1 = {};
              for (int ks = 0; ks <= 2 * rb + 1; ++ks) {
                  const u32x4 gw = *(LAS const u32x4*)(lds + L_CG + row_read_addr(32 * rb, lane, ks));
                  const f32x4 as0 = *(LAS const f32x4*)(ac + 16 * ks + 8 * hi), as1 = *(LAS const f32x4*)(ac + 16 * ks + 8 * hi + 4);
                  const float gv[8] = {bflo(gw.x), bfhi(gw.x), bflo(gw.y), bfhi(gw.y), bflo(gw.z), bfhi(gw.z), bflo(gw.w), bfhi(gw.w)};
                  const float asv[8] = {as0[0], as0[1], as0[2], as0[3], as1[0], as1[1], as1[2], as1[3]};
                  float mv[8];
#pragma unroll
                  for (int j = 0; j < 8; ++j) { const int s = 16 * ks + 8 * hi + j; float m = (s <= l) ? gv[j] * __expf(al - asv[j]) : 0.f; if (s == l) m += dl; mv[j] = m; }
                  const bf16x8 af = __builtin_bit_cast(bf16x8, (u32x4){pk2(mv[0], mv[1]), pk2(mv[2], mv[3]), pk2(mv[4], mv[5]), pk2(mv[6], mv[7])});
                  y0 = __builtin_amdgcn_mfma_f32_32x32x16_bf16(af, tr_frag(Xt, lane, cb0, ks), y0, 0, 0, 0);
                  y1 = __builtin_amdgcn_mfma_f32_32x32x16_bf16(af, tr_frag(Xt, lane, cb0 + 1, ks), y1, 0, 0, 0);
              }
#pragma unroll
              for (int i = 0; i < 2; ++i) { bf16* yp = ypart + (((size_t)b * 64 + c) * 16 + h) * 8192 + (size_t)(rb * 2) * 1024 + lane * 16 + 8 * i;
                  *(u32x4*)yp = (u32x4){pk2(y0[8 * i], y0[8 * i + 1]), pk2(y0[8 * i + 2], y0[8 * i + 3]), pk2(y0[8 * i + 4], y0[8 * i + 5]), pk2(y0[8 * i + 6], y0[8 * i + 7])};
                  *(u32x4*)(yp + 1024) = (u32x4){pk2(y1[8 * i], y1[8 * i + 1]), pk2(y1[8 * i + 2], y1[8 * i + 3]), pk2(y1[8 * i + 4], y1[8 * i + 5]), pk2(y1[8 * i + 6], y1[8 * i + 7])}; }
          }
          { f32x16 st[4] = {{}, {}, {}, {}}; const float aend = ac[127];
            for (int ks = 0; ks < 8; ++ks) {
                const bf16x8 xf = tr_frag(Xt, lane, cb0 + sub, ks); const u32x4 xw = __builtin_bit_cast(u32x4, xf);
                const f32x4 as0 = *(LAS const f32x4*)(ac + 16 * ks + 8 * hi), as1 = *(LAS const f32x4*)(ac + 16 * ks + 8 * hi + 4);
                const bf16x8 af = __builtin_bit_cast(bf16x8, (u32x4){pk2(bflo(xw.x) * __expf(aend - as0[0]), bfhi(xw.x) * __expf(aend - as0[1])), pk2(bflo(xw.y) * __expf(aend - as0[2]), bfhi(xw.y) * __expf(aend - as0[3])),
                                                                       pk2(bflo(xw.z) * __expf(aend - as1[0]), bfhi(xw.z) * __expf(aend - as1[1])), pk2(bflo(xw.w) * __expf(aend - as1[2]), bfhi(xw.w) * __expf(aend - as1[3]))});
#pragma unroll
                for (int nb = 0; nb < 4; ++nb) st[nb] = __builtin_amdgcn_mfma_f32_32x32x16_bf16(af, tr_frag(lds + L_BM, lane, nb, ks), st[nb], 0, 0, 0);
            }
            bf16* sp = states + (((size_t)b * 64 + c) * 16 + h) * 8192;
#pragma unroll
            for (int nb = 0; nb < 4; ++nb)
#pragma unroll
                for (int r = 0; r < 16; ++r) sp[(32 * sub + crow(r, hi)) * 128 + 32 * nb + r32] = f2bf(st[nb][r]); }
        }
        LDS_BAR();
    }
}
__device__ __forceinline__ void scan_phase(Frame& F) {
    const bf16* states = (const bf16*)(F.ws + X_STATES); const float* cdec = (const float*)(F.ws + X_CDEC); bf16* prev = (bf16*)(F.ws + X_PREV);
    for (int idx = F.vcu * NWAVES * 64 + F.tid; idx < NB * 16 * 64 * 32; idx += F.G * NWAVES * 64) {
        const int n4 = idx & 31, p = (idx >> 5) & 63, h = (idx >> 11) & 15, b = idx >> 15;
        f32x4 st = {0.f, 0.f, 0.f, 0.f};
#pragma unroll 1
        for (int c0 = 0; c0 < 64; c0 += 16) {
            const size_t o0 = ((((size_t)b * 64 + c0) * 16 + h) * 64 + p) * 128 + 4 * n4;
            u32x2 cw[16]; float d[16];
#pragma unroll
            for (int k = 0; k < 16; ++k) { cw[k] = *(const u32x2*)(states + o0 + (size_t)k * (16 * 64 * 128)); d[k] = cdec[((size_t)b * 64 + c0 + k) * 16 + h]; }
#pragma unroll
            for (int k = 0; k < 16; ++k) {
                *(u32x2*)(prev + o0 + (size_t)k * (16 * 64 * 128)) = (u32x2){pk2(st[0], st[1]), pk2(st[2], st[3])};
                const f32x4 cs = {bflo(cw[k].x), bfhi(cw[k].x), bflo(cw[k].y), bfhi(cw[k].y)};
                st = st * d[k] + cs; }
        }
    }
}
__device__ __forceinline__ void s3_unit(Frame& F, int L, int b, int c, int g) {
    LAS unsigned char* lds = F.lds; LAS float* side = (LAS float*)(F.lds + SIDE_OFF);
    int tid_ = cur_tid(); asm volatile("" : "+v"(tid_));
    const int tid = tid_, lane = tid & 63, wid = __builtin_amdgcn_readfirstlane(tid >> 6), r32 = lane & 31, hi = lane >> 5, h = 8 * g + wid;
    const size_t t0 = (size_t)b * SEQ + (size_t)c * 128;
    const bf16* proj = (const bf16*)(F.ws + X_PROJ); const bf16* Cc = (const bf16*)(F.ws + X_CC); const float* eacum = (const float*)(F.ws + X_EACUM);
    const bf16* ypf = (const bf16*)(F.ws + X_YPART) + (((size_t)b * 64 + c) * 16 + h) * 8192 + lane * 16; const bf16* prev = (const bf16*)(F.ws + X_PREV) + (((size_t)b * 64 + c) * 16 + h) * 8192;
    const float* nw = (const float*)F.in[13] + L * 1024; bf16* ynorm = (bf16*)(F.ws + X_YNORM);
    LAS unsigned char* zst = lds + 32768 + wid * 8192;
    LAS float* eac = side + 1280 + wid * 128;
#pragma unroll
    for (int i = 0; i < 4; ++i) { const int q = tid + 512 * i, row = q >> 4, ch = q & 15; *(LAS u32x4*)(lds + off_b(row, ch)) = *(const u32x4*)(Cc + (t0 + row) * 256 + g * 128 + 8 * ch); }
    eac[lane] = eacum[(t0 + lane) * 16 + h]; eac[64 + lane] = eacum[(t0 + 64 + lane) * 16 + h];
    bf16x8 pf[8][2];
#pragma unroll
    for (int ks = 0; ks < 8; ++ks)
#pragma unroll
        for (int pb = 0; pb < 2; ++pb) pf[ks][pb] = *(const bf16x8*)(prev + (32 * pb + r32) * 128 + 16 * ks + 8 * hi);
    LDS_BAR();
    const int srow = lane >> 1, shalf = lane & 1;
#define S3_LOAD(rb, Z, Y0, Y1) do { \
        _Pragma("unroll") for (int i = 0; i < 4; ++i) { const int q = lane + 64 * i, row = q >> 3, ch = q & 7; Z[i] = *(const u32x4*)(proj + (t0 + 32 * (rb) + row) * NPAD + CZ + h * 64 + 8 * ch); } \
        _Pragma("unroll") for (int i = 0; i < 2; ++i) { Y0[i] = *(const u32x4*)(ypf + ((rb) * 2 + 0) * 1024 + 8 * i); Y1[i] = *(const u32x4*)(ypf + ((rb) * 2 + 1) * 1024 + 8 * i); } } while (0)
    auto s3_body = [&](const int rb, const u32x4 (&zq)[4], const u32x4 (&yq0)[2], const u32x4 (&yq1)[2]) {
#pragma unroll
        for (int i = 0; i < 4; ++i) { const int q = lane + 64 * i, row = q >> 3, ch = q & 7; *(LAS u32x4*)(zst + row * 128 + ch * 16) = zq[i]; }
        f32x16 a0 = {}, a1 = {};
#pragma unroll
        for (int ks = 0; ks < 8; ++ks) { const bf16x8 cf = *(LAS const bf16x8*)(lds + row_read_addr(32 * rb, lane, ks));
            a0 = __builtin_amdgcn_mfma_f32_32x32x16_bf16(cf, pf[ks][0], a0, 0, 0, 0); a1 = __builtin_amdgcn_mfma_f32_32x32x16_bf16(cf, pf[ks][1], a1, 0, 0, 0); }
#pragma unroll
        for (int r = 0; r < 16; ++r) { const int lr = crow(r, hi); const float ea = eac[32 * rb + lr];
            const float z0 = bf2f(*(LAS const unsigned short*)(zst + lr * 128 + r32 * 2)), z1 = bf2f(*(LAS const unsigned short*)(zst + lr * 128 + 64 + r32 * 2));
            const unsigned w0_ = yq0[r >> 3][(r >> 1) & 3], w1_ = yq1[r >> 3][(r >> 1) & 3];
            const float y0 = (((r & 1) ? bfhi(w0_) : bflo(w0_)) + ea * a0[r]) * siluf_(z0), y1 = (((r & 1) ? bfhi(w1_) : bflo(w1_)) + ea * a1[r]) * siluf_(z1);
            *(LAS unsigned short*)(zst + 4096 + lr * 128 + r32 * 2) = f2bf(y0); *(LAS unsigned short*)(zst + 4096 + lr * 128 + 64 + r32 * 2) = f2bf(y1); }
        { float ss = 0.f; u32x4 w[4];
#pragma unroll
          for (int i = 0; i < 4; ++i) { w[i] = *(LAS const u32x4*)(zst + 4096 + srow * 128 + shalf * 64 + i * 16);
              const float e[8] = {bflo(w[i].x), bfhi(w[i].x), bflo(w[i].y), bfhi(w[i].y), bflo(w[i].z), bfhi(w[i].z), bflo(w[i].w), bfhi(w[i].w)};
#pragma unroll
              for (int k = 0; k < 8; ++k) ss += e[k] * e[k]; }
          ss += __shfl_xor(ss, 1);
          if (shalf == 0) side[wid * 128 + 32 * rb + srow] = ss;
          bf16* yo = ynorm + (t0 + 32 * rb + srow) * 1024 + h * 64 + shalf * 32;
#pragma unroll
          for (int i = 0; i < 4; ++i) *(u32x4*)(yo + 8 * i) = w[i]; }
    };
    { u32x4 zA[4], yA0[2], yA1[2], zB[4], yB0[2], yB1[2];
      S3_LOAD(0, zA, yA0, yA1);
      S3_LOAD(1, zB, yB0, yB1); s3_body(0, zA, yA0, yA1);
      S3_LOAD(2, zA, yA0, yA1); s3_body(1, zB, yB0, yB1);
      S3_LOAD(3, zB, yB0, yB1); s3_body(2, zA, yA0, yA1);
      s3_body(3, zB, yB0, yB1); }
#undef S3_LOAD
    WG_BAR();
    if (tid < 128) { float s = 0.f;
#pragma unroll
        for (int w = 0; w < 8; ++w) s += side[w * 128 + tid];
        side[1024 + tid] = __builtin_amdgcn_rsqf(s * (1.f / 512.f) + 1e-6f); }
    LDS_BAR();
    float wv[32];
#pragma unroll
    for (int i = 0; i < 8; ++i) { const f32x4 t4 = *(const f32x4*)(nw + h * 64 + shalf * 32 + 4 * i); wv[4 * i] = t4[0]; wv[4 * i + 1] = t4[1]; wv[4 * i + 2] = t4[2]; wv[4 * i + 3] = t4[3]; }
    u32x4 yw[4][4];
#pragma unroll
    for (int rb = 0; rb < 4; ++rb) { const bf16* yo = ynorm + (t0 + 32 * rb + srow) * 1024 + h * 64 + shalf * 32;
#pragma unroll
        for (int i = 0; i < 4; ++i) yw[rb][i] = *(const u32x4*)(yo + 8 * i); }
#pragma unroll
    for (int rb = 0; rb < 4; ++rb) { const float rs = side[1024 + 32 * rb + srow]; bf16* yo = ynorm + (t0 + 32 * rb + srow) * 1024 + h * 64 + shalf * 32;
#pragma unroll
        for (int i = 0; i < 4; ++i) { const u32x4 w = yw[rb][i]; u32x4 o;
            o.x = pk2(bflo(w.x) * rs * wv[8 * i], bfhi(w.x) * rs * wv[8 * i + 1]); o.y = pk2(bflo(w.y) * rs * wv[8 * i + 2], bfhi(w.y) * rs * wv[8 * i + 3]);
            o.z = pk2(bflo(w.z) * rs * wv[8 * i + 4], bfhi(w.z) * rs * wv[8 * i + 5]); o.w = pk2(bflo(w.w) * rs * wv[8 * i + 6], bfhi(w.w) * rs * wv[8 * i + 7]);
            *(u32x4*)(yo + 8 * i) = o; } }
    LDS_BAR();
}
}

#ifndef PHM
#define PHM 0x3fff
#endif
template <int L> __device__ __forceinline__ void layer_body(Frame& F, const XcdBarrier bar, LAS unsigned char* ring, LAS int* toff, bf16* hb, const int bx) {
        unsigned char* wl = F.ws + WS_WSM + (size_t)L * WSM_LAYER; (void)wl;
#if (PHM >> 1) & 1
        frame_refresh(F);
        { ge::Dense<EpiProj> P{hb, (const bf16*)(wl + WO_WIN), 1024, 1024, {}, {(bf16*)(F.ws + X_PROJ), (float*)(F.ws + X_DTRAW)}}; P.S.init(T, NPAD, F.G, bx);
          ge::gemm_phase(ring, P); }
        xcd_barrier(bar);
#endif
#if (PHM >> 2) & 1
        frame_refresh(F);
#ifndef NO_PREP
        prep_rows(F, L);
#endif
#ifndef NO_S1
        { const int nk_ = (NB * 64 * 2 + F.G - 1) / F.G, kmax_ = nk_ < 2 ? 2 : nk_;
#pragma unroll 1
          for (int k_ = 0; k_ < kmax_; ++k_) { const int u = F.vcu + k_ * F.G;
              if (u < NB * 64 * 2) ssd::s1_unit(F, L, u >> 7, (u >> 1) & 63, u & 1); } }
#endif
        xcd_barrier(bar);
#endif
#if (PHM >> 3) & 1
        frame_refresh(F);
        { ge::Dense<EpiQ> P{(const bf16*)(F.ws + X_QN), (const bf16*)(wl + WO_WQ), 384, 384, {}, {(bf16*)(F.ws + X_QB), (const float*)(F.ws + WS_ROPE), (const float*)(F.ws + WS_ROPE) + (size_t)T * 16}}; P.S.init(T, 768, F.G, bx);
          ge::gemm_phase(ring, P); }
        { ge::Dense<EpiStoreBf16> P{(const bf16*)(F.ws + X_CKVN), (const bf16*)(wl + WO_WKV), 256, 256, {}, {(bf16*)(F.ws + X_KVB), 1024}}; P.S.init(T, 1024, F.G, bx);
          ge::gemm_phase(ring, P); }
        ssd::scan_phase(F);
        xcd_barrier(bar);
#endif
#if (PHM >> 4) & 1
        frame_refresh(F);
#ifndef NO_ATTN
        { const int s = F.vcu & 7, bh = F.vcu >> 3; const bool bal = F.G == 256;
          const int nk_ = bal ? 4 : (1024 + F.G - 1) / F.G, kmax_ = nk_ < 4 ? 4 : nk_;
          bool conv_done = false;
#pragma unroll 1
          for (int i = 0; i < kmax_; ++i) {
              if (!conv_done && conv_acquire(F, L, false)) { p0_expert_weights(F, L); WG_BAR(); conv_release(F, L); conv_done = true; }
              const int qb = (i == 0) ? 31 - s : (i == 1) ? 16 + s : (i == 2) ? 15 - s : s;     const int u = F.vcu + i * F.G;
              if (bal || u < 1024)
                  at::attn_unit(bal ? (bh >> 3) : (u >> 8), bal ? (bh & 7) : ((u >> 5) & 7), bal ? qb : (u & 31), (const bf16*)(F.ws + X_QB), (const bf16*)(F.ws + X_KVB), (const bf16*)(F.ws + X_KPE), (bf16*)(F.ws + X_OB), ring); }
          if (!conv_done) { conv_acquire(F, L, true); p0_expert_weights(F, L); WG_BAR(); conv_release(F, L); } }
#endif
#ifndef NO_S3
        for (int u = F.vcu; u < NB * 64 * 2; u += F.G) ssd::s3_unit(F, L, u >> 7, (u >> 1) & 63, u & 1);
#endif
        xcd_barrier(bar);
#endif
#if (PHM >> 5) & 1
        frame_refresh(F);
        { ge::Dense<EpiGate> P{(const bf16*)(F.ws + X_OB), (const bf16*)(wl + WO_WAB), 512, 512, {}, {(bf16*)(F.ws + X_MB), (const bf16*)(F.ws + X_PROJ), CGA, 0}}; P.S.init(T, 1024, F.G, bx);
          ge::gemm_phase(ring, P); }
        { ge::Dense<EpiGate> P{(const bf16*)(F.ws + X_YNORM), (const bf16*)(wl + WO_WSB), 1024, 1024, {}, {(bf16*)(F.ws + X_MB), (const bf16*)(F.ws + X_PROJ), CGB, 1}}; P.S.init(T, 1024, F.G, bx);
          ge::gemm_phase(ring, P); }
        xcd_barrier(bar);
#endif
#if (PHM >> 6) & 1
        frame_refresh(F);
        { ge::Dense<EpiWo> P{(const bf16*)(F.ws + X_MB), (const bf16*)(wl + WO_WO), 1024, 1024, {}, {(bf16*)(F.ws + X_PRE), (const bf16*)hb}}; P.S.init(T, 1024, F.G, bx);
          ge::gemm_phase(ring, P); }
        xcd_barrier(bar);
#endif
#if (PHM >> 7) & 1
        frame_refresh(F);
        ln_rows<false, false>(F, (const bf16*)(F.ws + X_PRE), (const float*)F.in[17] + L * D, (const float*)F.in[18] + L * D, nullptr, nullptr, nullptr);
        conv_p(F, L);
        xcd_barrier(bar);
#endif
#if (PHM >> 8) & 1
        frame_refresh(F);
        { ge::Dense<EpiCat> P{hb, (const bf16*)(wl + WO_WCAT), 1024, 1024, {}, {(float*)(F.ws + X_LOGITS), (bf16*)(F.ws + X_SHHID), (bf16*)(F.ws + X_SG)}}; P.S.init(T, 1792, F.G, bx);
          ge::gemm_phase(ring, P); }
        xcd_barrier(bar);
#endif
#if (PHM >> 9) & 1
        frame_refresh(F);
        topk_rows(F, L);
        { ge::Dense<EpiPle> P{(const bf16*)(F.ws + X_PB), (const bf16*)(wl + WO_WPLE), 256, 256, {}, {(bf16*)(F.ws + X_BASE), (const bf16*)hb, (const bf16*)(F.ws + X_SG)}}; P.S.init(T, 1024, F.G, bx);
          ge::gemm_phase(ring, P); }
        { ge::Dense<EpiAddF32> P{(const bf16*)(F.ws + X_SHHID), (const bf16*)(wl + WO_WSD), 256, 256, {}, {(bf16*)(F.ws + X_BASE)}}; P.S.init(T, 1024, F.G, bx);
          ge::gemm_phase(ring, P); }
        xcd_barrier(bar);
#endif
#if (PHM >> 10) & 1
        frame_refresh(F);
        build_toff(F, L, toff);
        scatter_slots(F, L, toff);
        xcd_barrier(bar);
#endif
#if (PHM >> 11) & 1
        frame_refresh(F);
        { MoeGU P{hb, (const bf16*)(F.ws + WS_WGU + (size_t)L * WGU_LAYER), (const int*)(F.ws + X_STOK), (bf16*)(F.ws + X_HID), toff, F.G, F.vcu, 1024};
          ge::gemm_phase(ring, P); }
        xcd_barrier(bar);
#endif
#if (PHM >> 12) & 1
        frame_refresh(F);
        { MoeDown P{(const bf16*)(F.ws + X_HID), (const bf16*)(F.ws + WS_WD + (size_t)L * WD_LAYER), (const float*)(F.ws + X_SW), (unsigned char*)(F.ws + X_Y), toff, F.G, F.vcu, 256};
          ge::gemm_phase(ring, P); }
        xcd_barrier(bar);
#endif
#if (PHM >> 13) & 1
        frame_refresh(F);
        ln_rows<true, L == DEPTH - 1>(F, (const bf16*)(F.ws + X_BASE), (const float*)F.in[29] + L * D, (const float*)F.in[30] + L * D, (const int*)(F.ws + X_RRANK), (const unsigned char*)(F.ws + X_Y), (const float*)(F.ws + X_RW));
        xcd_barrier(bar);
#endif
}
struct Args { const void* in[31]; float* out; unsigned char* ws; };
__global__ void __launch_bounds__(NWAVES * 64, 2) fwd(Args args) {
    Frame F;
    F.lds = (LAS unsigned char*)lds_raw;
    F.tid = threadIdx.x; F.lane = F.tid & 63; F.wave = __builtin_amdgcn_readfirstlane(F.tid >> 6);
    F.G = gridDim.x; { const int bx = blockIdx.x; F.vcu = (F.G % 8 == 0) ? (bx % 8) * (F.G / 8) + bx / 8 : bx; }
    F.ws = args.ws; F.out = args.out; F.in = args.in; F.ctl = (gu32*)(args.ws + WS_CTL);
    for (int u = F.tid; u < (LDS_BYTES - LDSCTL_OFF) / 4; u += NWAVES * 64) ((LAS unsigned*)(F.lds + LDSCTL_OFF))[u] = 0u;
    __syncthreads();
    if (F.lane == 0) *(volatile LAS int*)(F.lds + LDSCTL_OFF + 64 + 4 * hw_wave_slot()) = F.wave;
    __syncthreads();
    frame_refresh(F);
    XcdBarrier bar = xcd_barrier_post((unsigned*)(F.ctl + CW_BAR), (volatile LAS unsigned*)(F.lds + LDSCTL_OFF));
    LAS unsigned char* ring = F.lds + RING_OFF;
    LAS int* toff = (LAS int*)(F.lds + SIDE_OFF + 8192);
    bf16* hb = (bf16*)(F.ws + WS_HB);
    const int bx = (int)blockIdx.x;

#if (PHM >> 0) & 1
        frame_refresh(F);
    p0_small_weights(F); p0_misc(F);
    xcd_barrier(bar);

#endif
    layer_body<0>(F, bar, ring, toff, hb, bx);
    layer_body<1>(F, bar, ring, toff, hb, bx);
}

extern "C" void kernel_launch(void* const* d_in, const int* in_sizes, int n_in, void* d_out, int out_size, void* d_ws, size_t ws_size, hipStream_t stream) {
    static int grid = 0;
    if (grid == 0) {
        if (n_in != 31 || out_size != T * D || ws_size < WS_END) { fprintf(stderr, "kernel_launch: unexpected shapes (n_in %d out %d ws %zu)\n", n_in, out_size, ws_size); grid = -1; return; }
        int dev = 0, cus = 0, per_cu = 0;
        if (hipGetDevice(&dev) != hipSuccess || hipDeviceGetAttribute(&cus, hipDeviceAttributeMultiprocessorCount, dev) != hipSuccess) { grid = -1; return; }
        if (hipFuncSetAttribute((const void*)fwd, hipFuncAttributeMaxDynamicSharedMemorySize, LDS_BYTES) != hipSuccess) { fprintf(stderr, "kernel_launch: hipFuncSetAttribute failed\n"); grid = -1; return; }
        if (hipOccupancyMaxActiveBlocksPerMultiprocessor(&per_cu, (const void*)fwd, NWAVES * 64, LDS_BYTES) != hipSuccess || per_cu < 1) { fprintf(stderr, "kernel_launch: occupancy query says %d\n", per_cu); }
        (void)hipGetLastError();
        grid = cus;
    }
    if (grid < 0) return;
    (void)hipMemsetAsync((char*)d_ws + WS_CTL, 0, CTL_ZERO_BYTES, stream);
    Args a{};
    for (int i = 0; i < 31; ++i) a.in[i] = d_in[i];
    a.out = (float*)d_out; a.ws = (unsigned char*)d_ws;
    hipLaunchKernelGGL(fwd, dim3(grid), dim3(NWAVES * 64), LDS_BYTES, stream, a);
}
```

```cpp
#include <hip/hip_runtime.h>
#include <cstdio>
#include <cstdint>

#define LAS __attribute__((address_space(3)))
#define GAS __attribute__((address_space(1)))
typedef unsigned short bf16;
typedef short bf16x8 __attribute__((ext_vector_type(8)));
typedef short s16x4 __attribute__((ext_vector_type(4)));
typedef float f32x2 __attribute__((ext_vector_type(2)));
typedef float f32x4 __attribute__((ext_vector_type(4)));
typedef float f32x16 __attribute__((ext_vector_type(16)));
typedef unsigned u32x2 __attribute__((ext_vector_type(2)));
typedef unsigned u32x4 __attribute__((ext_vector_type(4)));
typedef GAS unsigned gu32;

constexpr int NB = 4, SEQ = 8192, T = NB * SEQ, D = 1024, DEPTH = 2;
constexpr int NCOLS = 5296, NPAD = 5376;
constexpr int CQ = 0, CKV = 384, CKPE = 640, CZ = 672, CXBC = 1696, CDT = 3232, CGA = 3248, CGB = 4272;
constexpr int NEXP = 256, TOPK = 8;
constexpr int SMAX = T * TOPK + NEXP * 255;
constexpr float ALPHA = 1.4142135623730951f;
constexpr float QSCALE = 0.10206207261596577f * 1.4426950408889634f;
constexpr int NWAVES = 8;
constexpr float YSCALE = 32.f;

constexpr size_t MiB = 1u << 20;
constexpr size_t WS_CTL = 0, CTL_ZERO_BYTES = 1 * MiB;
constexpr size_t WS_WSM = 1 * MiB, WSM_LAYER = 22 * MiB;
constexpr size_t WO_WIN = 0, WO_WQ = WO_WIN + (size_t)NPAD * 1024 * 2, WO_WKV = WO_WQ + 768 * 384 * 2, WO_WAB = WO_WKV + 1024 * 256 * 2,
                 WO_WSB = WO_WAB + 1024 * 512 * 2, WO_WO = WO_WSB + 1024 * 1024 * 2, WO_WCAT = WO_WO + 1024 * 1024 * 2,
                 WO_WSD = WO_WCAT + 1792 * 1024 * 2, WO_WPLE = WO_WSD + 1024 * 256 * 2, WO_END = WO_WPLE + 1024 * 256 * 2;
static_assert(WO_END <= WSM_LAYER, "small weights");
constexpr size_t WS_ROPE = 45 * MiB;
constexpr size_t WS_HB = 49 * MiB;
constexpr size_t WS_WGU = 113 * MiB, WGU_LAYER = 256 * MiB;
constexpr size_t WS_WD = 625 * MiB, WD_LAYER = 128 * MiB;
constexpr size_t WS_X = 881 * MiB;
constexpr size_t X_PROJ = WS_X, X_DTRAW = X_PROJ + 336 * MiB, X_QN = X_DTRAW + 2 * MiB, X_CKVN = X_QN + 24 * MiB, X_KPE = X_CKVN + 16 * MiB,
                 X_QB = X_KPE + 2 * MiB, X_KVB = X_QB + 48 * MiB, X_OB = X_KVB + 64 * MiB, X_YPART = X_OB + 32 * MiB, X_CC = X_YPART + 128 * MiB,
                 X_EACUM = X_CC + 16 * MiB, X_CDEC = X_EACUM + 2 * MiB, X_STATES = X_CDEC + 1 * MiB, X_PREV = X_STATES + 128 * MiB,
                 X_YNORM = X_PREV + 64 * MiB, X_MB = X_YNORM + 64 * MiB, X_PRE = X_MB + 64 * MiB, X_MIX_END = X_PRE + 128 * MiB;
constexpr size_t X_LOGITS = WS_X, X_RIDX = X_LOGITS + 32 * MiB, X_RW = X_RIDX + 1 * MiB, X_RRANK = X_RW + 1 * MiB, X_STOK = X_RRANK + 1 * MiB,
                 X_SW = X_STOK + 2 * MiB, X_PB = X_SW + 2 * MiB, X_SHHID = X_PB + 16 * MiB, X_SG = X_SHHID + 16 * MiB, X_BASE = X_SG + 64 * MiB,
                 X_HID = X_BASE + 128 * MiB, X_Y = X_HID + 160 * MiB, X_MOE_END = X_Y + 640 * MiB;
constexpr size_t WS_END = 2048 * MiB;
static_assert(X_MIX_END <= WS_END && X_MOE_END <= WS_END && X_PB + 16 * MiB <= X_PRE, "d_ws map");
static_assert((size_t)SMAX * 256 * 2 <= 160 * MiB && (size_t)SMAX * 1024 * 2 <= 640 * MiB && (size_t)SMAX * 4 <= 2 * MiB, "slot buffers");
constexpr int CW_TMO = 0, CW_BAR = 4096, CW_CNT = 16384, CW_SEM = 32768;
constexpr unsigned CONV_LIMIT = 96;

constexpr int RING_OFF = 0, RING_BYTES = 131072, SIDE_OFF = 131072, SIDE_BYTES = 16384, LDSCTL_OFF = SIDE_OFF + SIDE_BYTES, LDS_BYTES = LDSCTL_OFF + 512;


extern __shared__ __attribute__((aligned(16))) unsigned char lds_raw[];
__device__ __forceinline__ int lane_id() { return (int)__builtin_amdgcn_mbcnt_hi(~0u, __builtin_amdgcn_mbcnt_lo(~0u, 0u)); }
__device__ __forceinline__ unsigned hw_wave_slot() { return (unsigned)__builtin_amdgcn_s_getreg(((6 - 1) << 11) | 4) & 63u; }
__device__ __forceinline__ int wave_index() { return __builtin_amdgcn_readfirstlane(*(volatile LAS int*)((LAS unsigned char*)lds_raw + LDSCTL_OFF + 64 + 4 * hw_wave_slot())); }
__device__ __forceinline__ int cur_tid() { return wave_index() * 64 + lane_id(); }
__device__ __forceinline__ float bf2f(unsigned short b) { return __uint_as_float(((unsigned)b) << 16); }
__device__ __forceinline__ float bflo(unsigned w) { return __uint_as_float(w << 16); }
__device__ __forceinline__ float bfhi(unsigned w) { return __uint_as_float(w & 0xffff0000u); }
typedef __bf16 bf16x2_t __attribute__((ext_vector_type(2)));
__device__ __forceinline__ unsigned pk2(float lo, float hi) { const f32x2 v = {lo, hi}; const bf16x2_t b = __builtin_convertvector(v, bf16x2_t); return __builtin_bit_cast(unsigned, b); }
__device__ __forceinline__ unsigned short f2bf(float f) { return (unsigned short)(pk2(f, 0.f) & 0xffffu); }
__device__ __forceinline__ float sigmoidf_(float x) { return __builtin_amdgcn_rcpf(1.f + __expf(-x)); }
__device__ __forceinline__ float siluf_(float x) { return x * sigmoidf_(x); }
__device__ __forceinline__ float wave_sum(float v) {
#pragma unroll
    for (int o = 1; o < 64; o <<= 1) v += __shfl_xor(v, o);
    return v;
}
template <class Tp> __device__ __forceinline__ Tp* uni_ptr(Tp* p) {
    const unsigned long long v = (unsigned long long)p; unsigned lo = __builtin_amdgcn_readfirstlane((unsigned)v), hi = __builtin_amdgcn_readfirstlane((unsigned)(v >> 32));
    asm volatile("" : "+s"(lo), "+s"(hi)); return (Tp*)(GAS Tp*)(((unsigned long long)hi << 32) | lo); }
__device__ __forceinline__ int uni_int(int x) { x = __builtin_amdgcn_readfirstlane(x); asm volatile("" : "+s"(x)); return x; }
#define LDS_WAIT() asm volatile("s_waitcnt lgkmcnt(0)" ::: "memory")
#define VM_WAIT() asm volatile("s_waitcnt vmcnt(0)" ::: "memory")
#define LDS_BAR() do { asm volatile("s_waitcnt lgkmcnt(0)" ::: "memory"); __builtin_amdgcn_s_barrier(); asm volatile("" ::: "memory"); } while (0)
#define WG_BAR() do { asm volatile("s_waitcnt vmcnt(0) lgkmcnt(0)" ::: "memory"); __builtin_amdgcn_s_barrier(); asm volatile("" ::: "memory"); } while (0)

__device__ __forceinline__ unsigned off_b(unsigned row, unsigned ch) { return 256u * row + 16u * (ch ^ (((row & 3) << 2) | ((row >> 2) & 3))); }
__device__ __forceinline__ unsigned row_read_addr(unsigned rowbase, unsigned lane, unsigned s) { return off_b(rowbase + (lane & 31), 2 * s + (lane >> 5)); }
__device__ __forceinline__ unsigned tr_read_addr(unsigned lane, unsigned c, unsigned ks, unsigned t) {
    const unsigned h = lane >> 5, blk = (lane >> 4) & 1, q = (lane & 15) >> 2, p = lane & 3;
    return off_b(16 * ks + 8 * h + 4 * t + q, 4 * c + 2 * blk + (p >> 1)) + 8 * (p & 1);
}
typedef short v4i16_t __attribute__((ext_vector_type(4)));
__device__ __forceinline__ s16x4 ldstr(LAS const unsigned char* p) { return __builtin_bit_cast(s16x4, __builtin_amdgcn_ds_read_tr16_b64_v4i16((LAS v4i16_t*)p)); }
__device__ __forceinline__ bf16x8 tr_frag(LAS const unsigned char* tile, unsigned lane, unsigned c, unsigned ks) {
    const s16x4 a = ldstr(tile + tr_read_addr(lane, c, ks, 0)), b = ldstr(tile + tr_read_addr(lane, c, ks, 1));
    return (bf16x8){a[0], a[1], a[2], a[3], b[0], b[1], b[2], b[3]};
}
__device__ __forceinline__ int crow(int r, int hi) { return (r & 3) + 8 * (r >> 2) + 4 * hi; }

#define XB_TMO      128
#define XB_XCNT(j)  (256  + 64 * (j))
#define XB_XSUB(j)  (1280 + 64 * (j))
#define XB_XGEN(j)  (2304 + 64 * (j))
#define XB_TOP      3328
#define XB_TOPGEN   3392
#define XCD_BAR_WORDS 3456
#define XB_SPIN_CAP (1u << 22)
__device__ __forceinline__ unsigned xb_ld(unsigned* p)              { return __hip_atomic_load(p, __ATOMIC_RELAXED, __HIP_MEMORY_SCOPE_AGENT); }
__device__ __forceinline__ unsigned xb_add(unsigned* p, unsigned v) { return __hip_atomic_fetch_add(p, v, __ATOMIC_RELAXED, __HIP_MEMORY_SCOPE_AGENT); }
__device__ __forceinline__ unsigned xb_xcc_id() { return (unsigned)__builtin_amdgcn_s_getreg((3 << 11) | 20) & 0xFu; }
#define XB_SPIN(cond, bar) do { unsigned _sp = 0; while (cond) { __builtin_amdgcn_s_sleep(1); \
    if ((++_sp & 255u) == 0u) { if (xb_ld(&(bar)[XB_TMO])) break; if (_sp > XB_SPIN_CAP) { atomicAdd(&(bar)[XB_TMO], 1u); break; } } } } while (0)
struct XcdBarrier { unsigned* bar; unsigned x; volatile LAS unsigned* st; };
__device__ __forceinline__ XcdBarrier xcd_barrier_post(unsigned* bar, volatile LAS unsigned* st) {
    XcdBarrier b; b.bar = bar; b.x = xb_xcc_id(); b.st = st;
    if (cur_tid() == 0) (void)xb_add(&bar[XB_XCNT(b.x)], 1u);
    return b;
}
__device__ __forceinline__ void xcd_barrier_complete(unsigned* bar, unsigned x, unsigned& nloc, unsigned& nx) {
    const unsigned G = gridDim.x * gridDim.y * gridDim.z;
    unsigned sum, cnt, mine, sp = 0u;
    for (;;) {
        sum = 0u; cnt = 0u; mine = 0u;
#pragma unroll 1
        for (unsigned j = 0; j < 16; ++j) { const unsigned c = xb_ld(&bar[XB_XCNT(j)]); sum += c; cnt += (c > 0u) ? 1u : 0u; mine = (j == x) ? c : mine; }
        if (sum == G) break;
        __builtin_amdgcn_s_sleep(1);
        if ((++sp & 255u) == 0u) { if (xb_ld(&bar[XB_TMO])) break; if (sp > XB_SPIN_CAP) { atomicAdd(&bar[XB_TMO], 1u); break; } }
    }
    nloc = mine > 0u ? mine : 1u; nx = cnt > 0u ? cnt : 1u;
}
__device__ __attribute__((noinline)) void xcd_barrier(const XcdBarrier b) {
    asm volatile("s_waitcnt vmcnt(0)" ::: "memory");
    __syncthreads();
    if (cur_tid() == 0) {
        unsigned* bar = uni_ptr(b.bar);
        __builtin_amdgcn_s_waitcnt(0);
        unsigned nloc = b.st[0], nx = b.st[1];
        if (nloc == 0u) { xcd_barrier_complete(bar, b.x, nloc, nx); b.st[0] = nloc; b.st[1] = nx; }
        const unsigned old = xb_add(&bar[XB_XSUB(b.x)], 1u);
        const unsigned gen = old / nloc;
        if (old + 1u == (gen + 1u) * nloc) {
            __builtin_amdgcn_fence(__ATOMIC_RELEASE, "agent");
            asm volatile("s_waitcnt vmcnt(0)" ::: "memory");
            const unsigned og = xb_add(&bar[XB_TOP], 1u);
            const unsigned tg = og / nx;
            if (og + 1u == (tg + 1u) * nx) xb_add(&bar[XB_TOPGEN], 1u);
            else XB_SPIN(xb_ld(&bar[XB_TOPGEN]) == tg, bar);
            __builtin_amdgcn_fence(__ATOMIC_ACQUIRE, "agent");
            xb_add(&bar[XB_XGEN(b.x)], 1u);
            asm volatile("s_waitcnt vmcnt(0)" ::: "memory");
        } else {
            XB_SPIN(xb_ld(&bar[XB_XGEN(b.x)]) == gen, bar);
            __builtin_amdgcn_fence(__ATOMIC_ACQUIRE, "agent");
            asm volatile("s_waitcnt vmcnt(0)" ::: "memory");
        }
    }
    __syncthreads();
}

namespace ge {
constexpr int BM = 256, BK = 64, HALF = 128, HTB = HALF * BK * 2, STAGE_BYTES = 8 * HTB, NXCD = 8, WGM = 8;
__device__ __forceinline__ int lds_byte(int r, int c) { const int st = (r >> 4) * 2 + (c >> 5), rr = r & 15, cc = c & 31, ob = rr * 64 + cc * 2; return st * 1024 + (ob ^ (((ob >> 9) & 1) << 5)); }
__device__ __forceinline__ void stage_rc(int b, int& R, int& C) { const int st = b / 1024, sb = b % 1024, swz = sb ^ (((sb >> 9) & 1) << 5); R = (st >> 1) * 16 + swz / 64; C = (st & 1) * 32 + (swz % 64) / 2; }
__device__ __forceinline__ int perm32(int rho) { const int n = rho >> 4, i = rho & 15; return 8 * (i >> 2) + 4 * n + (i & 3); }
struct GU { const char* A; const char* B; int pm, pn, x0; };
typedef f32x4 Acc[2][2][4][2];
struct StaticOrder {
    int nM, nN, nwg, G, c;
    __device__ __forceinline__ void init(int M, int N, int G_, int c_) { nM = M / BM; nN = N / BM; nwg = nM * nN; G = G_; c = c_; }
    __device__ __forceinline__ bool next(int i, int& pm, int& pn) const {
        const long L = (long)i * G + c; if (L >= nwg) return false;
        int wgid = (int)L; { const int q = nwg / NXCD, r = nwg % NXCD, xcd = wgid % NXCD, off = wgid / NXCD; wgid = (xcd < r ? xcd * (q + 1) : r * (q + 1) + (xcd - r) * q) + off; }
        const int nig = WGM * nN, gid = wgid / nig, fm = gid * WGM, gsz = (nM - fm) < WGM ? (nM - fm) : WGM;
        pm = fm + ((wgid % nig) % gsz); pn = (wgid % nig) / gsz; return true;
    }
};

template <class P>
__device__ __forceinline__ void gemm_phase(LAS unsigned char* lds, const P& p) {
    int tid_ = cur_tid(); asm volatile("" : "+v"(tid_));
    const int tid = tid_, wid = __builtin_amdgcn_readfirstlane(tid >> 6), lane = tid & 63, wr = wid >> 2, wc = wid & 3, fr = lane & 15, fq = lane >> 4;
    const int K = p.K, nt = K / BK;
    int Rp[2], Cp[2]; unsigned voffB[2];
#pragma unroll
    for (int i = 0; i < 2; ++i) { int R, C; stage_rc(tid * 16 + i * 8192, R, C); Rp[i] = R; Cp[i] = C; const int Rb = (R & ~31) + perm32(R & 31); voffB[i] = (unsigned)(Rb * K + C) * 2u; }
    const size_t kstep = (size_t)(BK * 2);
    const size_t hstepB = (size_t)HALF * K * 2;
    const unsigned ldsw = (unsigned)wid * 1024u;
    const int aoff = lds_byte(wr * 64 + fr, fq * 8), boff = lds_byte(wc * 32 + fr, fq * 8);
#define PG8_SA(b, h) (((b) * 2 + (h)) * HTB)
#define PG8_SB(b, h) ((4 + (b) * 2 + (h)) * HTB)
#define PG8_STAGE(bufoff, gbase, voff) do { _Pragma("unroll") for (int _i = 0; _i < 2; ++_i) \
        __builtin_amdgcn_global_load_lds((const unsigned*)((const char*)(gbase) + (voff)[_i]), (LAS unsigned*)(lds + (bufoff) + ldsw + _i * 8192), 16, 0, 0); } while (0)
#define PG8_LDA(dst, b, h) do { _Pragma("unroll") for (int m = 0; m < 4; ++m) _Pragma("unroll") for (int k = 0; k < 2; ++k) dst[m][k] = *(const LAS bf16x8*)(lds + PG8_SA(b, h) + aoff + m * 2048 + k * 1024); } while (0)
#define PG8_LDB(dst, b, h) do { _Pragma("unroll") for (int n = 0; n < 2; ++n) _Pragma("unroll") for (int k = 0; k < 2; ++k) dst[n][k] = *(const LAS bf16x8*)(lds + PG8_SB(b, h) + boff + n * 2048 + k * 1024); } while (0)
#define PG8_MMA(ai, bj, At, Bt) do { __builtin_amdgcn_s_setprio(1); _Pragma("unroll") for (int m = 0; m < 4; ++m) _Pragma("unroll") for (int n = 0; n < 2; ++n) _Pragma("unroll") for (int k = 0; k < 2; ++k) \
        acc[ai][bj][m][n] = __builtin_amdgcn_mfma_f32_16x16x32_bf16(Bt[n][k], At[m][k], acc[ai][bj][m][n], 0, 0, 0); __builtin_amdgcn_s_setprio(0); } while (0)
#define PG8_WAIT_V(n) asm volatile("s_waitcnt vmcnt(" #n ")" ::: "memory")
#define PG8_WAIT_L(n) asm volatile("s_waitcnt lgkmcnt(" #n ")" ::: "memory")
#define PG8_BAR __builtin_amdgcn_s_barrier()
#define PG8_SCHED __builtin_amdgcn_sched_barrier(0)
    GU cur, nxt; int ui = 0;
    if (!p.next(0, cur)) return;
    Acc acc;
#pragma unroll
    for (int a = 0; a < 2; ++a)
#pragma unroll
        for (int b = 0; b < 2; ++b)
#pragma unroll
            for (int m = 0; m < 4; ++m)
#pragma unroll
                for (int n = 0; n < 2; ++n) acc[a][b][m][n] = (f32x4){0.f, 0.f, 0.f, 0.f};
    bf16x8 At[4][2], B0[2][2], B1[2][2];
    unsigned vA[2][2], vN[2][2];
    p.rowoff(cur, Rp, Cp, vA);
    const char* cA = cur.A; const char* cB = cur.B;
    PG8_STAGE(PG8_SB(0, 0), cB, voffB); PG8_STAGE(PG8_SB(0, 1), cB + hstepB, voffB); PG8_STAGE(PG8_SA(0, 0), cA, vA[0]); PG8_STAGE(PG8_SA(0, 1), cA, vA[1]);
    if (wr == 1) PG8_BAR;
    PG8_WAIT_V(2); PG8_BAR;
    PG8_STAGE(PG8_SB(1, 0), cB + kstep, voffB); PG8_STAGE(PG8_SA(1, 0), cA + kstep, vA[0]); PG8_STAGE(PG8_SB(1, 1), cB + hstepB + kstep, voffB);
    PG8_WAIT_V(6); PG8_BAR;
    for (;;) {
        const bool has_next = p.next(ui + 1, nxt);
        if (has_next) p.rowoff(nxt, Rp, Cp, vN);
        else {
#pragma unroll
            for (int h = 0; h < 2; ++h)
#pragma unroll
                for (int i = 0; i < 2; ++i) vN[h][i] = vA[h][i]; }
        const char* nA = has_next ? nxt.A : cA; const char* nB = has_next ? nxt.B : cB;
        for (int t = 0; t < nt; t += 2) {
            const bool last = (t == nt - 2);
            const char* a1 = cA + (size_t)(t + 1) * kstep;
            const char* a2 = last ? nA : cA + (size_t)(t + 2) * kstep; const char* b2 = last ? nB : cB + (size_t)(t + 2) * kstep;
            const char* a3 = a2 + kstep; const char* b3 = b2 + kstep;
            unsigned v2[2][2];
#pragma unroll
            for (int h = 0; h < 2; ++h)
#pragma unroll
                for (int i = 0; i < 2; ++i) v2[h][i] = last ? vN[h][i] : vA[h][i];
            PG8_LDB(B0, 0, 0); PG8_LDB(B1, 0, 1); PG8_SCHED; PG8_LDA(At, 0, 0); PG8_STAGE(PG8_SA(1, 1), a1, vA[1]);
            PG8_WAIT_V(8); PG8_WAIT_L(0); PG8_BAR; PG8_MMA(0, 0, At, B0); PG8_MMA(0, 1, At, B1); PG8_BAR; PG8_SCHED;
            PG8_LDA(At, 0, 1); PG8_STAGE(PG8_SB(0, 0), b2, voffB); PG8_STAGE(PG8_SB(0, 1), b2 + hstepB, voffB); PG8_STAGE(PG8_SA(0, 0), a2, v2[0]);
            PG8_WAIT_V(8); PG8_WAIT_L(0); PG8_BAR; PG8_MMA(1, 0, At, B0); PG8_MMA(1, 1, At, B1); PG8_BAR; PG8_SCHED;
            PG8_LDB(B0, 1, 0); PG8_LDB(B1, 1, 1); PG8_SCHED; PG8_LDA(At, 1, 0); PG8_STAGE(PG8_SA(0, 1), a2, v2[1]);
            PG8_WAIT_V(8); PG8_WAIT_L(0); PG8_BAR; PG8_MMA(0, 0, At, B0); PG8_MMA(0, 1, At, B1); PG8_BAR; PG8_SCHED;
            PG8_LDA(At, 1, 1); PG8_STAGE(PG8_SB(1, 0), b3, voffB); PG8_STAGE(PG8_SB(1, 1), b3 + hstepB, voffB); PG8_STAGE(PG8_SA(1, 0), a3, v2[0]);
            PG8_WAIT_V(8); PG8_WAIT_L(0); PG8_BAR; PG8_MMA(1, 0, At, B0); PG8_MMA(1, 1, At, B1); PG8_BAR; PG8_SCHED;
        }
        if (wr == 0) PG8_BAR;
        p.epi(acc, cur, wr, wc, fr, fq);
        if (!has_next) break;
#pragma unroll
        for (int a = 0; a < 2; ++a)
#pragma unroll
            for (int b = 0; b < 2; ++b)
#pragma unroll
                for (int m = 0; m < 4; ++m)
#pragma unroll
                    for (int n = 0; n < 2; ++n) acc[a][b][m][n] = (f32x4){0.f, 0.f, 0.f, 0.f};
        cur = nxt; cA = nA; cB = nB; ++ui;
#pragma unroll
        for (int h = 0; h < 2; ++h)
#pragma unroll
            for (int i = 0; i < 2; ++i) vA[h][i] = vN[h][i];
        if (wr == 1) PG8_BAR;
    }
    PG8_WAIT_V(0);
    PG8_BAR;
#undef PG8_SA
#undef PG8_SB
#undef PG8_STAGE
#undef PG8_LDA
#undef PG8_LDB
#undef PG8_MMA
#undef PG8_WAIT_V
#undef PG8_WAIT_L
#undef PG8_BAR
#undef PG8_SCHED
}

template <class Epi> struct Dense {
    const bf16* A; const bf16* Bt; int lda, K; StaticOrder S; Epi E;
    __device__ __forceinline__ bool next(int i, GU& u) const {
        int pm, pn; if (!S.next(i, pm, pn)) return false;
        u.pm = pm; u.pn = pn; u.x0 = 0; u.A = (const char*)A + (size_t)pm * BM * lda * 2; u.B = (const char*)Bt + (size_t)pn * BM * K * 2; return true;
    }
    __device__ __forceinline__ void rowoff(const GU&, const int (&R)[2], const int (&C)[2], unsigned (&v)[2][2]) const {
#pragma unroll
        for (int h = 0; h < 2; ++h)
#pragma unroll
            for (int i = 0; i < 2; ++i) v[h][i] = (unsigned)((h * HALF + R[i]) * lda + C[i]) * 2u;
    }
    __device__ __forceinline__ void epi(const Acc& acc, const GU& u, int wr, int wc, int fr, int fq) const {
        const int row0 = u.pm * BM + wr * 64 + fr, col0 = u.pn * BM + wc * 32 + 8 * fq;
        E.unit(acc, u, row0, col0);
    }
};
}

struct Frame {
    LAS unsigned char* lds;
    gu32* ctl;
    int tid, lane, wave, G, vcu;
    unsigned char* ws;
    float* out;
    const void* const* in;
};

__device__ __forceinline__ void frame_refresh(Frame& F) {
    int t = cur_tid(); asm volatile("" : "+v"(t)); F.tid = t; F.lane = t & 63; F.wave = __builtin_amdgcn_readfirstlane(t >> 6);
    F.ws = uni_ptr(F.ws); F.ctl = (gu32*)(F.ws + WS_CTL); F.G = uni_int(F.G); F.vcu = uni_int(F.vcu); F.out = uni_ptr(F.out);
}
template <class F> __device__ __forceinline__ void epi_rows(const ge::Acc& acc, int row0, int col0, F f) {
#pragma unroll
    for (int ai = 0; ai < 2; ++ai)
#pragma unroll
        for (int m = 0; m < 4; ++m)
        {
#pragma unroll
            for (int bj = 0; bj < 2; ++bj) f(row0 + ai * 128 + m * 16, col0 + bj * 128, acc[ai][bj][m][0], acc[ai][bj][m][1]);
            asm volatile("" ::: "memory"); }
}
template <class LD, class US> __device__ __forceinline__ void epi_rows_pf(const ge::Acc& acc, int row0, int col0, LD ld, US us) {
#pragma unroll
    for (int ai = 0; ai < 2; ++ai) {
        decltype(ld(0, 0)) pre[4][2];
#pragma unroll
        for (int m = 0; m < 4; ++m)
#pragma unroll
            for (int bj = 0; bj < 2; ++bj) pre[m][bj] = ld(row0 + ai * 128 + m * 16, col0 + bj * 128);
#pragma unroll
        for (int m = 0; m < 4; ++m)
#pragma unroll
            for (int bj = 0; bj < 2; ++bj) us(row0 + ai * 128 + m * 16, col0 + bj * 128, acc[ai][bj][m][0], acc[ai][bj][m][1], pre[m][bj]);
        asm volatile("" ::: "memory"); }
}
struct Pre2 { u32x4 a, b; };
__device__ __forceinline__ u32x4 pack8(f32x4 a, f32x4 b) { u32x4 w; w.x = pk2(a[0], a[1]); w.y = pk2(a[2], a[3]); w.z = pk2(b[0], b[1]); w.w = pk2(b[2], b[3]); return w; }
__device__ __forceinline__ void unpack8(u32x4 w, f32x4& a, f32x4& b) { a = (f32x4){bflo(w.x), bfhi(w.x), bflo(w.y), bfhi(w.y)}; b = (f32x4){bflo(w.z), bfhi(w.z), bflo(w.w), bfhi(w.w)}; }

struct EpiProj {
    bf16* proj; float* dtraw;
    __device__ __forceinline__ void unit(const ge::Acc& acc, const ge::GU& u, int row0, int col0) const {
        epi_rows(acc, row0, col0, [&](int row, int col, f32x4 a, f32x4 b) {
            *(u32x4*)(proj + (size_t)row * NPAD + col) = pack8(a, b);
            if (col >= CDT && col < CDT + 16) { float* d = dtraw + (size_t)row * 16 + (col - CDT); *(f32x4*)d = a; *(f32x4*)(d + 4) = b; }
        });
    }
};
struct EpiQ {
    bf16* Q; const float* rc; const float* rs;
    __device__ __forceinline__ void unit(const ge::Acc& acc, const ge::GU& u, int row0, int col0) const {
        const int fq = lane_id() >> 4;
        epi_rows(acc, row0, col0, [&](int row, int col, f32x4 a, f32x4 b) {
            const int cg = col & ~31;
            if ((cg % 96) == 64) {
                const int i0 = 8 * (fq & 1);
#pragma unroll
                for (int hf = 0; hf < 2; ++hf) {
                    f32x4& x = hf ? b : a;
                    const f32x4 c = *(const f32x4*)(rc + (size_t)row * 16 + i0 + 4 * hf), sn = *(const f32x4*)(rs + (size_t)row * 16 + i0 + 4 * hf);
                    f32x4 y;
#pragma unroll
                    for (int e = 0; e < 4; ++e) y[e] = __shfl_xor(x[e], 32);
                    x = (fq < 2) ? (x * c - y * sn) : (y * sn + x * c);
                }
            }
            *(u32x4*)(Q + (size_t)row * 768 + col) = pack8(a * QSCALE, b * QSCALE);
        });
    }
};
struct EpiStoreBf16 {
    bf16* O; int ld;
    __device__ __forceinline__ void unit(const ge::Acc& acc, const ge::GU& u, int row0, int col0) const {
        epi_rows(acc, row0, col0, [&](int row, int col, f32x4 a, f32x4 b) { *(u32x4*)(O + (size_t)row * ld + col) = pack8(a, b); });
    }
};
struct EpiGate {
    bf16* mb; const bf16* proj; int gcol0; int add;
    __device__ __forceinline__ void unit(const ge::Acc& acc, const ge::GU& u, int row0, int col0) const {
        epi_rows_pf(acc, row0, col0,
            [&](int row, int col) { Pre2 r; r.a = *(const u32x4*)(proj + (size_t)row * NPAD + gcol0 + col); r.b = r.a; if (add) r.b = *(const u32x4*)(mb + (size_t)row * D + col); return r; },
            [&](int row, int col, f32x4 a, f32x4 b, const Pre2& pr) {
            f32x4 g0, g1; unpack8(pr.a, g0, g1);
#pragma unroll
            for (int e = 0; e < 4; ++e) { a[e] *= sigmoidf_(g0[e]); b[e] *= sigmoidf_(g1[e]); }
            bf16* o = mb + (size_t)row * D + col;
            if (add) { f32x4 p0, p1; unpack8(pr.b, p0, p1); a += p0; b += p1; }
            *(u32x4*)o = pack8(a, b);
        });
    }
};
struct EpiWo {
    bf16* pre; const bf16* h;
    __device__ __forceinline__ void unit(const ge::Acc& acc, const ge::GU& u, int row0, int col0) const {
        epi_rows_pf(acc, row0, col0, [&](int row, int col) { return *(const u32x4*)(h + (size_t)row * D + col); },
            [&](int row, int col, f32x4 a, f32x4 b, const u32x4& hw) {
            f32x4 h0, h1; unpack8(hw, h0, h1);
            *(u32x4*)(pre + (size_t)row * D + col) = pack8(h0 * ALPHA + a, h1 * ALPHA + b);
        });
    }
};
struct EpiCat {
    float* logits; bf16* shhid; bf16* sg;
    __device__ __forceinline__ void unit(const ge::Acc& acc, const ge::GU& u, int row0, int col0) const {
        if (u.pn == 0) {
            epi_rows(acc, row0, col0, [&](int row, int col, f32x4 a, f32x4 b) { float* o = logits + (size_t)row * 256 + col; *(f32x4*)o = a; *(f32x4*)(o + 4) = b; });
        } else if (u.pn <= 2) {
            const int hc = (u.pn - 1) * 128 + (col0 & 127);
#pragma unroll
            for (int ai = 0; ai < 2; ++ai)
#pragma unroll
                for (int m = 0; m < 4; ++m) {
                    f32x4 g0 = acc[ai][0][m][0], g1 = acc[ai][0][m][1], u0 = acc[ai][1][m][0], u1 = acc[ai][1][m][1];
#pragma unroll
                    for (int e = 0; e < 4; ++e) { g0[e] = siluf_(g0[e]) * u0[e]; g1[e] = siluf_(g1[e]) * u1[e]; }
                    *(u32x4*)(shhid + (size_t)(row0 + ai * 128 + m * 16) * 256 + hc) = pack8(g0, g1);
                }
        } else {
            epi_rows(acc, row0, col0, [&](int row, int col, f32x4 a, f32x4 b) {
#pragma unroll
                for (int e = 0; e < 4; ++e) { a[e] = sigmoidf_(a[e]); b[e] = sigmoidf_(b[e]); }
                *(u32x4*)(sg + (size_t)row * D + (col - 768)) = pack8(a, b);
            });
        }
    }
};
struct EpiPle {
    bf16* base; const bf16* h; const bf16* sg;
    __device__ __forceinline__ void unit(const ge::Acc& acc, const ge::GU& u, int row0, int col0) const {
        epi_rows_pf(acc, row0, col0, [&](int row, int col) { Pre2 r; r.a = *(const u32x4*)(sg + (size_t)row * D + col); r.b = *(const u32x4*)(h + (size_t)row * D + col); return r; },
            [&](int row, int col, f32x4 a, f32x4 b, const Pre2& pr) {
            f32x4 g0, g1; unpack8(pr.a, g0, g1);
            f32x4 h0, h1; unpack8(pr.b, h0, h1);
            *(u32x4*)(base + (size_t)row * D + col) = pack8(h0 * ALPHA + a * g0, h1 * ALPHA + b * g1);
        });
    }
};
struct EpiAddF32 {
    bf16* base;
    __device__ __forceinline__ void unit(const ge::Acc& acc, const ge::GU& u, int row0, int col0) const {
        epi_rows_pf(acc, row0, col0, [&](int row, int col) { return *(const u32x4*)(base + (size_t)row * D + col); },
            [&](int row, int col, f32x4 a, f32x4 b, const u32x4& pw) {
            bf16* o = base + (size_t)row * D + col; f32x4 p0, p1; unpack8(pw, p0, p1);
            *(u32x4*)o = pack8(p0 + a, p1 + b);
        });
    }
};

__device__ __forceinline__ int find_expert(const LAS int* toff, int j) {
    int lo = 0, hi = NEXP;
    while (hi - lo > 1) { const int mid = (lo + hi) >> 1; if (toff[mid] <= j) lo = mid; else hi = mid; }
    return lo;
}
struct MoeGU {
    const bf16* hb; const bf16* wgu; const int* stok; bf16* hid; const LAS int* toff; int G, c, K;
    __device__ __forceinline__ bool next(int i, ge::GU& u) const {
        const int L = i * G + c, ntile = toff[NEXP]; if (L >= ntile * 2) return false;
        const int j = L >> 1, pn = L & 1, e = find_expert(toff, j);
        u.pm = j; u.pn = pn; u.x0 = e; u.A = (const char*)hb; u.B = (const char*)wgu + ((size_t)e * 512 + pn * 256) * 1024 * 2; return true;
    }
    __device__ __forceinline__ void rowoff(const ge::GU& u, const int (&R)[2], const int (&C)[2], unsigned (&v)[2][2]) const {
#pragma unroll
        for (int h = 0; h < 2; ++h)
#pragma unroll
            for (int i = 0; i < 2; ++i) v[h][i] = (unsigned)(stok[u.pm * 256 + h * 128 + R[i]] * D + C[i]) * 2u;
    }
    __device__ __forceinline__ void epi(const ge::Acc& acc, const ge::GU& u, int wr, int wc, int fr, int fq) const {
        const int slot0 = u.pm * 256 + wr * 64 + fr, hc = u.pn * 128 + wc * 32 + 8 * fq;
#pragma unroll
        for (int ai = 0; ai < 2; ++ai)
#pragma unroll
            for (int m = 0; m < 4; ++m) {
                f32x4 g0 = acc[ai][0][m][0], g1 = acc[ai][0][m][1], u0 = acc[ai][1][m][0], u1 = acc[ai][1][m][1];
#pragma unroll
                for (int e = 0; e < 4; ++e) { g0[e] = siluf_(g0[e]) * u0[e]; g1[e] = siluf_(g1[e]) * u1[e]; }
                *(u32x4*)(hid + (size_t)(slot0 + ai * 128 + m * 16) * 256 + hc) = pack8(g0, g1);
            }
    }
};
struct MoeDown {
    const bf16* hid; const bf16* wd; const float* sw; unsigned char* Y; const LAS int* toff; int G, c, K;
    __device__ __forceinline__ bool next(int i, ge::GU& u) const {
        const int L = i * G + c, ntile = toff[NEXP]; if (L >= ntile * 4) return false;
        const int j = L >> 2, pn = L & 3, e = find_expert(toff, j);
        u.pm = j; u.pn = pn; u.x0 = e; u.A = (const char*)hid + (size_t)j * 256 * 256 * 2; u.B = (const char*)wd + ((size_t)e * 1024 + pn * 256) * 256 * 2; return true;
    }
    __device__ __forceinline__ void rowoff(const ge::GU&, const int (&R)[2], const int (&C)[2], unsigned (&v)[2][2]) const {
#pragma unroll
        for (int h = 0; h < 2; ++h)
#pragma unroll
            for (int i = 0; i < 2; ++i) v[h][i] = (unsigned)((h * 128 + R[i]) * 256 + C[i]) * 2u;
    }
    __device__ __forceinline__ void epi(const ge::Acc& acc, const ge::GU& u, int wr, int wc, int fr, int fq) const {
        const int slot0 = u.pm * 256 + wr * 64 + fr, col0 = u.pn * 256 + wc * 32 + 8 * fq;
#pragma unroll
        for (int ai = 0; ai < 2; ++ai)
#pragma unroll
            for (int m = 0; m < 4; ++m) { const int slot = slot0 + ai * 128 + m * 16;
#pragma unroll
                for (int bj = 0; bj < 2; ++bj) { const f32x4 a = acc[ai][bj][m][0] * YSCALE, bq = acc[ai][bj][m][1] * YSCALE;
                    int w0 = __builtin_amdgcn_cvt_pk_fp8_f32(a[0], a[1], 0, false); w0 = __builtin_amdgcn_cvt_pk_fp8_f32(a[2], a[3], w0, true);
                    int w1 = __builtin_amdgcn_cvt_pk_fp8_f32(bq[0], bq[1], 0, false); w1 = __builtin_amdgcn_cvt_pk_fp8_f32(bq[2], bq[3], w1, true);
                    *(u32x2*)(Y + (size_t)slot * D + col0 + bj * 128) = (u32x2){(unsigned)w0, (unsigned)w1}; } }
    }
};

__device__ __forceinline__ void transpose_item(const float* W, int ld, int K, int nvalid, int col0, bf16* WT, int dst_row, int kb, LAS float* scr, int lane) {
    const int k0 = 64 * kb, n4 = lane & 7, kq = lane >> 3, cc = col0 + 4 * n4; const bool ok = cc < nvalid;
    const float* src = W + (size_t)(k0 + kq) * ld + cc;
    f32x4 v[8];
#pragma unroll
    for (int i = 0; i < 8; ++i) v[i] = ok ? *(const f32x4*)(src + (size_t)(8 * i) * ld) : (f32x4){0.f, 0.f, 0.f, 0.f};
#pragma unroll
    for (int i = 0; i < 8; ++i) { LAS float* d = scr + (8 * i + kq) * 33 + 4 * n4; d[0] = v[i][0]; d[1] = v[i][1]; d[2] = v[i][2]; d[3] = v[i][3]; }
    LDS_WAIT(); asm volatile("" ::: "memory");
    const int c = lane & 7;
#pragma unroll
    for (int j = 0; j < 4; ++j) { const int n = (lane >> 3) + 8 * j; const LAS float* s_ = scr + (8 * c) * 33 + n;
        u32x4 o; o.x = pk2(s_[0 * 33], s_[1 * 33]); o.y = pk2(s_[2 * 33], s_[3 * 33]); o.z = pk2(s_[4 * 33], s_[5 * 33]); o.w = pk2(s_[6 * 33], s_[7 * 33]);
        *(u32x4*)(WT + (size_t)(dst_row + n) * K + k0 + 8 * c) = o; }
    LDS_WAIT(); asm volatile("" ::: "memory");
}
#define TJOB(src_, ld_, K_, nvalid_, nrows_, dst_) { const int ni_ = ((K_) / 64) * ((nrows_) / 32); if (r < ni_) { const int nbk_ = (nrows_) / 32; \
        transpose_item((src_), (ld_), (K_), (nvalid_), 32 * (r % nbk_), (dst_), 32 * (r % nbk_), r / nbk_, scr, F.lane); continue; } r -= ni_; }
constexpr int ITEMS_SMALL = 16 * 168 + 6 * 24 + 4 * 32 + 8 * 32 + 16 * 32 + 16 * 32 + 16 * (8 + 4 * 4 + 32) + 4 * 32 + 4 * 32;
constexpr int ITEMS_EXP = NEXP * 384;
__device__ __forceinline__ void p0_small_weights(Frame& F) {
    LAS float* scr = (LAS float*)(F.lds + RING_OFF + F.wave * 16384);
    const int gw = F.vcu * NWAVES + F.wave, NGW = F.G * NWAVES;
    for (int it = gw; it < DEPTH * ITEMS_SMALL; it += NGW) {
        const int L = it / ITEMS_SMALL; int r = it % ITEMS_SMALL;
        unsigned char* wl = F.ws + WS_WSM + (size_t)L * WSM_LAYER;
        const float* w_in = (const float*)F.in[3] + (size_t)L * 1024 * NCOLS;
        TJOB(w_in, NCOLS, 1024, NCOLS, NPAD, (bf16*)(wl + WO_WIN));
        TJOB((const float*)F.in[5] + (size_t)L * 384 * 768, 768, 384, 768, 768, (bf16*)(wl + WO_WQ));
        TJOB((const float*)F.in[7] + (size_t)L * 256 * 1024, 1024, 256, 1024, 1024, (bf16*)(wl + WO_WKV));
        TJOB((const float*)F.in[14] + (size_t)L * 512 * 1024, 1024, 512, 1024, 1024, (bf16*)(wl + WO_WAB));
        TJOB((const float*)F.in[15] + (size_t)L * 1024 * 1024, 1024, 1024, 1024, 1024, (bf16*)(wl + WO_WSB));
        TJOB((const float*)F.in[16] + (size_t)L * 1024 * 1024, 1024, 1024, 1024, 1024, (bf16*)(wl + WO_WO));
        bf16* wcat = (bf16*)(wl + WO_WCAT);
        const float* shg = (const float*)F.in[24] + (size_t)L * 1024 * 256; const float* shu = (const float*)F.in[25] + (size_t)L * 1024 * 256;
        TJOB((const float*)F.in[19] + (size_t)L * 1024 * 256, 256, 1024, 256, 256, wcat);
        TJOB(shg, 256, 1024, 128, 128, wcat + (size_t)256 * 1024);
        TJOB(shu, 256, 1024, 128, 128, wcat + (size_t)384 * 1024);
        TJOB(shg + 128, 256, 1024, 128, 128, wcat + (size_t)512 * 1024);
        TJOB(shu + 128, 256, 1024, 128, 128, wcat + (size_t)640 * 1024);
        TJOB((const float*)F.in[28] + (size_t)L * 1024 * 1024, 1024, 1024, 1024, 1024, wcat + (size_t)768 * 1024);
        TJOB((const float*)F.in[26] + (size_t)L * 256 * 1024, 1024, 256, 1024, 1024, (bf16*)(wl + WO_WSD));
        TJOB((const float*)F.in[27] + (size_t)L * 256 * 1024, 1024, 256, 1024, 1024, (bf16*)(wl + WO_WPLE));
    }
}
__device__ __forceinline__ void p0_expert_weights(Frame& F, int L) {
    LAS float* scr = (LAS float*)(F.lds + RING_OFF + F.wave * 16384);
    int lane_ = F.lane; asm volatile("" : "+v"(lane_));
    const int gw = F.vcu * NWAVES + F.wave, NGW = F.G * NWAVES, lane = lane_, n4 = lane & 7, kq = lane >> 3;
    const float* wg = (const float*)F.in[21] + (size_t)L * NEXP * 1024 * 256; const float* wu = (const float*)F.in[22] + (size_t)L * NEXP * 1024 * 256;
    const float* wd = (const float*)F.in[23] + (size_t)L * NEXP * 256 * 1024;
    bf16* wgu_t = (bf16*)(F.ws + WS_WGU + (size_t)L * WGU_LAYER); bf16* wd_t = (bf16*)(F.ws + WS_WD + (size_t)L * WD_LAYER);
#define TP_DECODE(it_, SRC, LD, DST, KK) do { const int e_ = (it_) / 384, r_ = (it_) % 384, which_ = r_ >> 7, rr_ = r_ & 127; \
        if (which_ < 2) { const int kb_ = rr_ >> 3, nb_ = rr_ & 7; LD = 256; KK = 1024; \
            SRC = (which_ ? wu : wg) + (size_t)e_ * 1024 * 256 + (size_t)(64 * kb_ + kq) * 256 + 32 * nb_ + 4 * n4; \
            DST = wgu_t + (size_t)e_ * 512 * 1024 + (size_t)((nb_ >> 2) * 256 + which_ * 128 + 32 * (nb_ & 3)) * 1024 + 64 * kb_; } \
        else { const int kb_ = rr_ >> 5, nb_ = rr_ & 31; LD = 1024; KK = 256; \
            SRC = wd + (size_t)e_ * 256 * 1024 + (size_t)(64 * kb_ + kq) * 1024 + 32 * nb_ + 4 * n4; \
            DST = wd_t + (size_t)e_ * 1024 * 256 + (size_t)(32 * nb_) * 256 + 64 * kb_; } } while (0)
#define TP_LOAD(BUF, DSTV, KV, item) do { const float* s__; int ld__; TP_DECODE((item), s__, ld__, DSTV, KV); \
        _Pragma("unroll") for (int i = 0; i < 8; ++i) asm volatile("global_load_dwordx4 %0, %1, off nt" : "=v"(BUF[i]) : "v"(s__ + (size_t)(8 * i) * ld__) : "memory"); } while (0)
#define TP_WAIT7(BUF) asm volatile("s_waitcnt vmcnt(7)" ::: "memory")
#define TP_PROC(BUF, DSTV, KV) do { \
        _Pragma("unroll") for (int i = 0; i < 8; ++i) { LAS float* d = scr + (8 * i + kq) * 33 + 4 * n4; d[0] = BUF[i][0]; d[1] = BUF[i][1]; d[2] = BUF[i][2]; d[3] = BUF[i][3]; } \
        LDS_WAIT(); asm volatile("" ::: "memory"); \
        _Pragma("unroll") for (int j = 0; j < 4; ++j) { const int n = (lane >> 3) + 8 * j; const LAS float* s_ = scr + (8 * (lane & 7)) * 33 + n; \
            u32x4 o; o.x = pk2(s_[0 * 33], s_[1 * 33]); o.y = pk2(s_[2 * 33], s_[3 * 33]); o.z = pk2(s_[4 * 33], s_[5 * 33]); o.w = pk2(s_[6 * 33], s_[7 * 33]); \
            __builtin_nontemporal_store(o, (u32x4*)(DSTV + (size_t)n * KV + 8 * (lane & 7))); } \
        LDS_WAIT(); asm volatile("" ::: "memory"); } while (0)
#define TP_WAIT0(BUF) asm volatile("s_waitcnt vmcnt(0)" ::: "memory")
    for (int it = gw; it < ITEMS_EXP; it += 2 * NGW) {
        f32x4 b0[8], b1[8]; bf16 *d0, *d1 = wgu_t; int K0, K1 = 0;
        const bool two = it + NGW < ITEMS_EXP;
        TP_LOAD(b0, d0, K0, it);
        if (two) { TP_LOAD(b1, d1, K1, it + NGW); TP_WAIT7(b0); } else TP_WAIT0(b0);
        TP_PROC(b0, d0, K0);
        if (two) { TP_WAIT0(b1); TP_PROC(b1, d1, K1); }
    }
#undef TP_WAIT0
#undef TP_WAIT7
#undef TP_PROC
#undef TP_LOAD
#undef TP_DECODE
}
__device__ __forceinline__ bool conv_acquire(Frame& F, int L, bool block) {
    volatile LAS int* flag = (volatile LAS int*)(F.lds + LDSCTL_OFF + 384);
    unsigned* sem = (unsigned*)(F.ctl + CW_SEM + 64 * L);
    if (cur_tid() == 0) {
        int ok = 0;
        for (;;) {
            const unsigned old = __hip_atomic_fetch_add(sem, 1u, __ATOMIC_RELAXED, __HIP_MEMORY_SCOPE_AGENT);
            if (old < CONV_LIMIT) { ok = 1; break; }
            __hip_atomic_fetch_sub(sem, 1u, __ATOMIC_RELAXED, __HIP_MEMORY_SCOPE_AGENT);
            if (!block) break;
            __builtin_amdgcn_s_sleep(64);
        }
        *flag = ok;
    }
    WG_BAR();
    const int ok = __builtin_amdgcn_readfirstlane(*flag);
    WG_BAR();
    return ok != 0;
}
__device__ __forceinline__ void conv_release(Frame& F, int L) {
    if (cur_tid() == 0) __hip_atomic_fetch_sub((unsigned*)(F.ctl + CW_SEM + 64 * L), 1u, __ATOMIC_RELAXED, __HIP_MEMORY_SCOPE_AGENT);
}
__device__ __forceinline__ void p0_misc(Frame& F) {
    const int gw = F.vcu * NWAVES + F.wave, NGW = F.G * NWAVES;
    const float* x = (const float*)F.in[0]; bf16* hb = (bf16*)(F.ws + WS_HB);
    for (int m0 = gw; m0 < T; m0 += 2 * NGW) {
        const bool two = m0 + NGW < T; const int m1 = two ? m0 + NGW : m0;
        f32x4 v[2][4];
#pragma unroll
        for (int r = 0; r < 2; ++r) { const f32x4* xr = (const f32x4*)(x + (size_t)(r ? m1 : m0) * D) + F.lane;
#pragma unroll
            for (int j = 0; j < 4; ++j) v[r][j] = xr[64 * j]; }
#pragma unroll
        for (int r = 0; r < 2; ++r) { if (r == 1 && !two) break; u32x2* hr = (u32x2*)(hb + (size_t)(r ? m1 : m0) * D) + F.lane;
#pragma unroll
            for (int j = 0; j < 4; ++j) hr[64 * j] = (u32x2){pk2(v[r][j][0], v[r][j][1]), pk2(v[r][j][2], v[r][j][3])}; }
    }
    const int* pos = (const int*)F.in[2]; float* rc = (float*)(F.ws + WS_ROPE); float* rs = rc + (size_t)T * 16;
    const double cfr[16] = {0.15915494309189535, 0.08949940160889101, 0.050329212104487035, 0.0283021958306234, 0.015915494309189534, 0.008949940160889102, 0.005032921210448704, 0.00283021958306234,
                            0.0015915494309189536, 0.0008949940160889102, 0.0005032921210448703, 0.00028302195830623395, 0.00015915494309189535, 8.949940160889102e-05, 5.0329212104487035e-05, 2.8302195830623396e-05};
    for (int idx = (F.vcu * NWAVES * 64) + F.tid; idx < T * 16; idx += F.G * NWAVES * 64) {
        const int t = idx >> 4, i = idx & 15; double rev = (double)pos[t] * cfr[i]; rev -= __builtin_floor(rev);
        rc[idx] = __builtin_amdgcn_cosf((float)rev); rs[idx] = __builtin_amdgcn_sinf((float)rev);
    }
}

__device__ __forceinline__ void prep_rows(Frame& F, int L) {
    const int gw = F.vcu * NWAVES + F.wave, NGW = F.G * NWAVES, lane = F.lane;
    const bf16* proj = (const bf16*)(F.ws + X_PROJ); bf16* qn = (bf16*)(F.ws + X_QN); bf16* ckvn = (bf16*)(F.ws + X_CKVN); bf16* kpe = (bf16*)(F.ws + X_KPE);
    const float* qg = (const float*)F.in[4] + L * 384; const float* kg = (const float*)F.in[6] + L * 256;
    const float* rc = (const float*)(F.ws + WS_ROPE); const float* rs = rc + (size_t)T * 16;
    float gq[6], gk[4];
#pragma unroll
    for (int j = 0; j < 6; ++j) gq[j] = qg[lane * 2 + (j & 1) + 128 * (j >> 1)];
#pragma unroll
    for (int j = 0; j < 4; ++j) gk[j] = kg[lane * 4 + j];
    for (int t0 = gw; t0 < T; t0 += 2 * NGW) {
        const bool two = t0 + NGW < T; const int t1 = two ? t0 + NGW : t0;
        unsigned qw[2][3]; u32x2 kw[2]; float xv[2], cc[2], ss[2];
#pragma unroll
        for (int r = 0; r < 2; ++r) { const int t = r ? t1 : t0; const bf16* pr = proj + (size_t)t * NPAD;
#pragma unroll
            for (int j = 0; j < 3; ++j) qw[r][j] = *(const unsigned*)(pr + CQ + 128 * j + 2 * lane);
            kw[r] = *(const u32x2*)(pr + CKV + 4 * lane);
            xv[r] = bf2f(pr[CKPE + (lane & 31)]); cc[r] = rc[(size_t)t * 16 + (lane & 15)]; ss[r] = rs[(size_t)t * 16 + (lane & 15)]; }
#pragma unroll
        for (int r = 0; r < 2; ++r) { if (r == 1 && !two) break; const int t = r ? t1 : t0;
            float q[6], k[4];
#pragma unroll
            for (int j = 0; j < 3; ++j) { q[2 * j] = bflo(qw[r][j]); q[2 * j + 1] = bfhi(qw[r][j]); }
            k[0] = bflo(kw[r].x); k[1] = bfhi(kw[r].x); k[2] = bflo(kw[r].y); k[3] = bfhi(kw[r].y);
            float sq = 0.f, sk = 0.f;
#pragma unroll
            for (int j = 0; j < 6; ++j) sq += q[j] * q[j];
#pragma unroll
            for (int j = 0; j < 4; ++j) sk += k[j] * k[j];
            sq = wave_sum(sq); sk = wave_sum(sk);
            const float rq = __builtin_amdgcn_rsqf(sq * (1.f / 384.f) + 1e-6f), rk = __builtin_amdgcn_rsqf(sk * (1.f / 256.f) + 1e-6f);
#pragma unroll
            for (int j = 0; j < 3; ++j) *(unsigned*)(qn + (size_t)t * 384 + 128 * j + 2 * lane) = pk2(q[2 * j] * rq * gq[2 * j], q[2 * j + 1] * rq * gq[2 * j + 1]);
            *(u32x2*)(ckvn + (size_t)t * 256 + 4 * lane) = (u32x2){pk2(k[0] * rk * gk[0], k[1] * rk * gk[1]), pk2(k[2] * rk * gk[2], k[3] * rk * gk[3])};
            const float yv = __shfl_xor(xv[r], 16);
            const float o = (lane & 16) ? (yv * ss[r] + xv[r] * cc[r]) : (xv[r] * cc[r] - yv * ss[r]);
            if (lane < 32) kpe[(size_t)t * 32 + lane] = f2bf(o); }
    }
}
template <bool COMBINE, bool OUT32> __device__ __forceinline__ void ln_rows(Frame& F, const bf16* src, const float* g, const float* b, const int* rpos, const unsigned char* Y8, const float* rwt) {
    const int gw = F.vcu * NWAVES + F.wave, NGW = F.G * NWAVES, lane = F.lane;
    bf16* hb = (bf16*)(F.ws + WS_HB);
    f32x4 gv[4], bv[4];
#pragma unroll
    for (int j = 0; j < 4; ++j) { gv[j] = *((const f32x4*)g + 4 * lane + j); bv[j] = *((const f32x4*)b + 4 * lane + j); }
    for (int t = gw; t < T; t += NGW) {
        f32x4 v[4];
#pragma unroll
        for (int i = 0; i < 2; ++i) { const u32x4 w = *((const u32x4*)(src + (size_t)t * D) + 2 * lane + i); unpack8(w, v[2 * i], v[2 * i + 1]); }
        if (COMBINE) {
            const int slot = rpos[t * TOPK + (lane & 7)]; const float wgt = rwt[t * TOPK + (lane & 7)] * (1.f / YSCALE);
            f32x4 ra[4] = {{0.f, 0.f, 0.f, 0.f}, {0.f, 0.f, 0.f, 0.f}, {0.f, 0.f, 0.f, 0.f}, {0.f, 0.f, 0.f, 0.f}};
#pragma unroll
            for (int k = 0; k < TOPK; ++k) { const int sl = __builtin_amdgcn_readlane(slot, k); const u32x4 w = *((const u32x4*)(Y8 + (size_t)sl * D) + lane);
                const unsigned ww[4] = {w.x, w.y, w.z, w.w};
                const float wk = __uint_as_float(__builtin_amdgcn_readlane(__float_as_uint(wgt), k));
#pragma unroll
                for (int j = 0; j < 4; ++j) { const f32x2 lo = __builtin_amdgcn_cvt_pk_f32_fp8((int)ww[j], false), hi = __builtin_amdgcn_cvt_pk_f32_fp8((int)ww[j], true); ra[j] += (f32x4){lo[0], lo[1], hi[0], hi[1]} * wk; } }
#pragma unroll
            for (int j = 0; j < 4; ++j) v[j] += ra[j];
        }
        float s = 0.f;
#pragma unroll
        for (int j = 0; j < 4; ++j) s += (v[j][0] + v[j][1]) + (v[j][2] + v[j][3]);
        const float mean = wave_sum(s) * (1.f / D); float s2 = 0.f;
#pragma unroll
        for (int j = 0; j < 4; ++j) { v[j] = v[j] - mean; s2 += (v[j][0] * v[j][0] + v[j][1] * v[j][1]) + (v[j][2] * v[j][2] + v[j][3] * v[j][3]); }
        const float rstd = __builtin_amdgcn_rsqf(wave_sum(s2) * (1.f / D) + 1e-5f);
        f32x4 o[4];
#pragma unroll
        for (int j = 0; j < 4; ++j) { o[j] = v[j] * rstd * gv[j] + bv[j]; if (OUT32) *((f32x4*)(F.out + (size_t)t * D) + 4 * lane + j) = o[j]; }
        if (!OUT32) {
#pragma unroll
        for (int i = 0; i < 2; ++i) *((u32x4*)(hb + (size_t)t * D) + 2 * lane + i) = pack8(o[2 * i], o[2 * i + 1]); }
    }
}
__device__ __forceinline__ void conv_p(Frame& F, int L, int rank, int nwgs) {
    const float* p = (const float*)F.in[1] + (size_t)L * T * 256; bf16* pb = (bf16*)(F.ws + X_PB);
    const size_t n = (size_t)T * 256 / 4, st = (size_t)nwgs * NWAVES * 64;
    for (size_t i = (size_t)(rank * NWAVES * 64 + F.tid); i < n; i += 4 * st) {
        f32x4 v[4];
#pragma unroll
        for (int k = 0; k < 4; ++k) if (i + k * st < n) v[k] = ((const f32x4*)p)[i + k * st];
#pragma unroll
        for (int k = 0; k < 4; ++k) if (i + k * st < n) ((u32x2*)pb)[i + k * st] = (u32x2){pk2(v[k][0], v[k][1]), pk2(v[k][2], v[k][3])}; }
}

template <int CTRL> __device__ __forceinline__ float dppf(float v) { return __int_as_float(__builtin_amdgcn_update_dpp(0, __float_as_int(v), CTRL, 0xF, 0xF, false)); }
__device__ __forceinline__ float rdlane(float v, int l) { return __uint_as_float(__builtin_amdgcn_readlane(__float_as_uint(v), l)); }
__device__ __forceinline__ float wave_max_uniform(float v) {
    v = fmaxf(v, dppf<0xB1>(v)); v = fmaxf(v, dppf<0x4E>(v)); v = fmaxf(v, dppf<0x141>(v)); v = fmaxf(v, dppf<0x140>(v));
    return fmaxf(fmaxf(rdlane(v, 0), rdlane(v, 16)), fmaxf(rdlane(v, 32), rdlane(v, 48)));
}
__device__ __forceinline__ void topk_rows(Frame& F, int L) {
    const int gw = F.vcu * NWAVES + F.wave, NGW = F.G * NWAVES, lane = F.lane;
    const float* logits = (const float*)(F.ws + X_LOGITS); int* ridx = (int*)(F.ws + X_RIDX); float* rw = (float*)(F.ws + X_RW); int* rrank = (int*)(F.ws + X_RRANK);
    unsigned* cnt = (unsigned*)(F.ctl + CW_CNT + L * NEXP);
    const f32x4 bias = *((const f32x4*)((const float*)F.in[20] + L * NEXP) + lane);
    const int g = lane >> 3;
    auto route = [&](const f32x4& lg, int& myidx, float& mysc, float& ssum) {
        float sc[4], sel[4];
#pragma unroll
        for (int j = 0; j < 4; ++j) { sc[j] = __builtin_amdgcn_rcpf(1.f + __expf(-lg[j])); sel[j] = sc[j] + bias[j]; }
        float m1 = fmaxf(sel[0], sel[1]), m2 = fminf(sel[0], sel[1]);
        { const float a = fmaxf(sel[2], sel[3]), bb = fminf(sel[2], sel[3]); const float n1 = fmaxf(m1, a), n2 = fmaxf(fminf(m1, a), fmaxf(m2, bb)); m1 = n1; m2 = n2; }
#define TK_MERGE(CTRL) do { const float a1 = dppf<CTRL>(m1), a2 = dppf<CTRL>(m2); const float n1 = fmaxf(m1, a1), n2 = fmaxf(fminf(m1, a1), fmaxf(m2, a2)); m1 = n1; m2 = n2; } while (0)
        TK_MERGE(0xB1); TK_MERGE(0x4E); TK_MERGE(0x141);
#undef TK_MERGE
        const float gs = m1 + m2; int rank = 0;
#pragma unroll
        for (int j = 0; j < 8; ++j) { const float o = rdlane(gs, 8 * j); rank += (o > gs || (o == gs && j < g)) ? 1 : 0; }
        if (rank >= 4) {
#pragma unroll
            for (int j = 0; j < 4; ++j) sel[j] = -INFINITY; }
        myidx = 0; mysc = 0.f; ssum = 0.f;
#pragma unroll
        for (int k = 0; k < TOPK; ++k) {
            float bv = sel[0]; int bi = 0;
#pragma unroll
            for (int j = 1; j < 4; ++j) if (sel[j] > bv) { bv = sel[j]; bi = j; }
            const float wmax = wave_max_uniform(bv);
            const unsigned long long mask = __ballot(bv == wmax);
            const int wl = (int)__builtin_ctzll(mask);
            const int wj = __builtin_amdgcn_readlane(bi, wl);
            const float cand = (wj == 0) ? sc[0] : (wj == 1) ? sc[1] : (wj == 2) ? sc[2] : sc[3];
            const float wsc = rdlane(cand, wl);
            if (lane == wl) {
#pragma unroll
                for (int j = 0; j < 4; ++j) if (wj == j) sel[j] = -INFINITY; }
            ssum += wsc;
            if (lane == k) { myidx = 4 * wl + wj; mysc = wsc; }
        }
    };
    for (int t0 = gw; t0 < T; t0 += 2 * NGW) {
        const bool two = t0 + NGW < T; const int t1 = two ? t0 + NGW : t0;
        const f32x4 lg0 = *((const f32x4*)(logits + (size_t)t0 * NEXP) + lane), lg1 = *((const f32x4*)(logits + (size_t)t1 * NEXP) + lane);
        int i0, i1; float s0, s1, q0, q1;
        route(lg0, i0, s0, q0); route(lg1, i1, s1, q1);
        if (lane < TOPK) {
            const float w0 = s0 * __builtin_amdgcn_rcpf(q0) * 2.5f, w1 = s1 * __builtin_amdgcn_rcpf(q1) * 2.5f;
            const unsigned r0 = __hip_atomic_fetch_add(cnt + i0, 1u, __ATOMIC_RELAXED, __HIP_MEMORY_SCOPE_AGENT);
            unsigned r1 = 0; if (two) r1 = __hip_atomic_fetch_add(cnt + i1, 1u, __ATOMIC_RELAXED, __HIP_MEMORY_SCOPE_AGENT);
            ridx[t0 * TOPK + lane] = i0; rw[t0 * TOPK + lane] = w0; rrank[t0 * TOPK + lane] = (int)r0;
            if (two) { ridx[t1 * TOPK + lane] = i1; rw[t1 * TOPK + lane] = w1; rrank[t1 * TOPK + lane] = (int)r1; }
        }
    }
}
__device__ __forceinline__ void build_toff(Frame& F, int L, LAS int* toff) {
    const unsigned* cnt = (const unsigned*)(F.ctl + CW_CNT + L * NEXP);
    if (F.wave == 0) {
        int run = 0;
#pragma unroll
        for (int j = 0; j < 4; ++j) {
            const int e = 64 * j + F.lane; const int nt = ((int)__hip_atomic_load(cnt + e, __ATOMIC_RELAXED, __HIP_MEMORY_SCOPE_AGENT) + 255) >> 8;
            int inc = nt;
#pragma unroll
            for (int o = 1; o < 64; o <<= 1) { const int v = __shfl_up(inc, o); if (F.lane >= o) inc += v; }
            toff[e] = run + inc - nt; run += __shfl(inc, 63);
        }
        if (F.lane == 0) toff[NEXP] = run;
    }
    WG_BAR();
}
__device__ __forceinline__ void scatter_slots(Frame& F, int L, const LAS int* toff) {
    const int* ridx = (const int*)(F.ws + X_RIDX); const float* rw = (const float*)(F.ws + X_RW); int* rrank = (int*)(F.ws + X_RRANK);
    int* stok = (int*)(F.ws + X_STOK); float* sw = (float*)(F.ws + X_SW);
    const unsigned* cnt = (const unsigned*)(F.ctl + CW_CNT + L * NEXP);
    for (int i = F.vcu * NWAVES * 64 + F.tid; i < T * TOPK; i += F.G * NWAVES * 64) {
        const int e = ridx[i], slot = 256 * toff[e] + rrank[i];
        stok[slot] = i >> 3; sw[slot] = rw[i]; rrank[i] = slot;
    }
    for (int e = F.vcu; e < NEXP; e += F.G) {
        const int n = (int)__hip_atomic_load(cnt + e, __ATOMIC_RELAXED, __HIP_MEMORY_SCOPE_AGENT), s0 = 256 * toff[e] + n, s1 = 256 * toff[e + 1];
        for (int s = s0 + F.tid; s < s1; s += NWAVES * 64) { stok[s] = 0; sw[s] = 0.f; }
    }
}

namespace at {
constexpr int KSLOT = 12288, VSLOT = 8192, LDS_K = 0, LDS_V = 4 * KSLOT, LDS_WS = LDS_V + 3 * VSLOT, LDS_END = LDS_WS + 8 * 256;
__device__ __forceinline__ void glds16(const void* gsrc, unsigned lds_dst) { unsigned keep;
    asm volatile("s_mov_b32 %0, m0\n\ts_mov_b32 m0, %2\n\ts_nop 0\n\tglobal_load_lds_dwordx4 %1, off\n\ts_mov_b32 m0, %0" : "=&s"(keep) : "v"(gsrc), "s"(lds_dst) : "memory"); }
#define AT_SBAR() __builtin_amdgcn_sched_barrier(0)
#define AT_PIN(x) asm volatile("" : "+v"(x))
#define AT_MF(a, b, c) __builtin_amdgcn_mfma_f32_32x32x16_bf16(a, b, c, 0, 0, 0)
#define AT_MX3(a, b, c) __builtin_fmaxf(__builtin_fmaxf((a), (b)), (c))
__device__ __forceinline__ float rowmax(const f32x16& p0, const f32x16& p1) {
    float a = AT_MX3(p0[0], p0[1], p1[0]), b = AT_MX3(p0[2], p0[3], p1[1]); a = AT_MX3(a, p1[2], p1[3]);
#pragma unroll
    for (int r = 4; r < 16; r += 4) { a = AT_MX3(a, p0[r], p0[r + 1]); b = AT_MX3(b, p0[r + 2], p0[r + 3]); a = AT_MX3(a, p1[r], p1[r + 1]); b = AT_MX3(b, p1[r + 2], p1[r + 3]); }
    const float m = __builtin_fmaxf(a, b); auto rr = __builtin_amdgcn_permlane32_swap(__float_as_uint(m), __float_as_uint(m), false, false);
    return __builtin_fmaxf(__uint_as_float(rr[0]), __uint_as_float(rr[1])); }
__device__ __forceinline__ void cmask(f32x16& p0, f32x16& p1, int jb, int qrel, int hi) {
    const int kb = 64 * jb + 4 * hi;
#pragma unroll
    for (int r = 0; r < 16; ++r) { const int kv = kb + (r & 3) + 8 * (r >> 2); if (kv > qrel) p0[r] = -INFINITY; if (kv + 32 > qrel) p1[r] = -INFINITY; } }
__device__ __forceinline__ void attn_unit(int b, int h, int qb, const bf16* Q, const bf16* KV, const bf16* KPE, bf16* O, LAS unsigned char* shm) {
    int tid_ = cur_tid(); asm volatile("" : "+v"(tid_));
    const int tid = tid_, lane = tid & 63, r32 = lane & 31, hi = lane >> 5; const int wid = __builtin_amdgcn_readfirstlane(tid >> 6);
    const size_t tb = (size_t)b * SEQ; const int q0 = qb * 256;
    const unsigned lds0 = (unsigned)(size_t)shm;
    LAS float* wsf = (LAS float*)(shm + LDS_WS) + wid * 64;
    const int NT = (q0 + 256) / 64;
    bf16x8 qr[6];
    { const bf16* qp = Q + (tb + q0 + wid * 32 + r32) * 768 + h * 96 + hi * 8;
#pragma unroll
      for (int d0 = 0; d0 < 6; ++d0) qr[d0] = *(const bf16x8*)(qp + d0 * 16); }
    asm volatile("s_waitcnt vmcnt(0)" ::: "memory");
    const bf16* ksrc0 = KV + (tb + lane) * 1024 + h * 128 + wid * 8;
    const bf16* ksrc1 = KPE + (tb + lane) * 32 + (wid & 3) * 8;
    const bf16* vsrc = KV + (tb + 16 * (wid & 3) + (lane >> 2)) * 1024 + h * 128 + 64 + (wid >> 2) * 32 + (lane & 3) * 8;
#define AT_DMAK(t, s) do { glds16(ksrc0 + (size_t)(t) * 64 * 1024, (unsigned)__builtin_amdgcn_readfirstlane(lds0 + LDS_K + (s) * KSLOT + wid * 1024)); \
        if (wid < 4) glds16(ksrc1 + (size_t)(t) * 64 * 32, (unsigned)__builtin_amdgcn_readfirstlane(lds0 + LDS_K + (s) * KSLOT + (8 + wid) * 1024)); } while (0)
#define AT_DMAV(t, s) glds16(vsrc + (size_t)(t) * 64 * 1024, (unsigned)__builtin_amdgcn_readfirstlane(lds0 + LDS_V + (s) * VSLOT + wid * 1024))
#define AT_WAITC() do { if (wid < 4) asm volatile("s_waitcnt vmcnt(3) lgkmcnt(0)\n\ts_barrier" ::: "memory"); else asm volatile("s_waitcnt vmcnt(2) lgkmcnt(0)\n\ts_barrier" ::: "memory"); } while (0)
#define AT_WAIT0() asm volatile("s_waitcnt vmcnt(0) lgkmcnt(0)\n\ts_barrier" ::: "memory")
    AT_DMAK(0, 0); AT_DMAV(0, 0); AT_DMAK(1, 1); AT_DMAK(2, 2);
    constexpr float THR = 8.f;
    float mhat = 0.f, l_reg = 0.f; f32x2 mh2 = {0.f, 0.f}; f32x16 o0 = {}, o1 = {}; const f32x16 zero16 = {};
    const int qrel = wid * 32 + r32;
    bool resc = false;
    f32x16 pA0, pA1, pB0, pB1; bf16x8 kf[12]; s16x4 vlo[8], vhi[8]; u32x4 pw0, pw1, pw2, pw3;
    LAS const unsigned char* const kp0 = shm + LDS_K + hi * 1024 + r32 * 16;
    LAS const unsigned char* const vp0 = shm + LDS_V + ((lane >> 4) & 1) * 32 + (lane & 3) * 8 + (4 * hi + ((lane & 15) >> 2)) * 64;
    int sl_prev = 0, sl_cur = 0, sl_next = 1;
#define AT_ROT() do { sl_prev = sl_cur; sl_cur = sl_next; sl_next = (sl_next == 2) ? 0 : sl_next + 1; } while (0)
#define AT_KRDP(kp_, d0) do { kf[2 * (d0)] = *(LAS const bf16x8*)((kp_) + (d0) * 2048); kf[2 * (d0) + 1] = *(LAS const bf16x8*)((kp_) + (d0) * 2048 + 512); } while (0)
#define AT_KRD(d0) AT_KRDP(kp_, d0)
#define AT_VRD(i) do { vlo[i] = ldstr(vp_ + (((i) >> 2) * 4096 + ((i) & 3) * 1024)); vhi[i] = ldstr(vp_ + (((i) >> 2) * 4096 + ((i) & 3) * 1024 + 512)); } while (0)
#define AT_VFR(i) (bf16x8){vlo[i][0], vlo[i][1], vlo[i][2], vlo[i][3], vhi[i][0], vhi[i][1], vhi[i][2], vhi[i][3]}
#define AT_PAF(k) __builtin_bit_cast(bf16x8, pw##k)
#define AT_PK(P, i) pk2(P[i], P[i + 1])
#define AT_EX(X, i) X[i] = __builtin_amdgcn_exp2f(X[i])
#define AT_RESC() do { if (resc) { _Pragma("unroll") for (int r = 0; r < 16; ++r) { const float f = wsf[crow(r, hi)]; o0[r] *= f; o1[r] *= f; } } } while (0)
    if (wid < 4) asm volatile("s_waitcnt vmcnt(2) lgkmcnt(0)\n\ts_barrier" ::: "memory"); else asm volatile("s_waitcnt vmcnt(1) lgkmcnt(0)\n\ts_barrier" ::: "memory");
    AT_DMAK(3, 3); AT_DMAV(1, 1);
    { LAS const unsigned char* kp_ = kp0;
      _Pragma("unroll") for (int d0 = 0; d0 < 6; ++d0) AT_KRD(d0);
      pA0 = AT_MF(kf[0], qr[0], zero16); pA1 = AT_MF(kf[1], qr[0], zero16);
      _Pragma("unroll") for (int d0 = 1; d0 < 6; ++d0) { pA0 = AT_MF(kf[2 * d0], qr[d0], pA0); pA1 = AT_MF(kf[2 * d0 + 1], qr[d0], pA1); } }
    if (NT == 4) cmask(pA0, pA1, 0, qrel, hi);
    { mhat = rowmax(pA0, pA1); mh2 = (f32x2){-mhat, -mhat}; AT_PIN(mh2);
#pragma unroll
      for (int r = 0; r < 16; ++r) pA0[r] = __builtin_amdgcn_exp2f(pA0[r] - mhat); }
    AT_KRDP(kp0 + KSLOT, 0); AT_KRDP(kp0 + KSLOT, 1);
    sl_prev = 0; sl_cur = 1; sl_next = 2;
#define AT_GA(MFS, FILL) do { MFS; FILL; AT_SBAR(); } while (0)
#define AT_EX2(X, i) do { f32x2 x_ = {X[i], X[(i) + 1]}; x_ += mh2; X[i] = __builtin_amdgcn_exp2f(x_[0]); X[(i) + 1] = __builtin_amdgcn_exp2f(x_[1]); } while (0)
#define AT_SUM2(X, i) s2 += (f32x2){X[i], X[(i) + 1]}
#define AT_STEP(C0, C1, P0, P1, t, MASK, GK, GV, GL, CNT) do { \
    if (CNT) AT_WAITC(); else AT_WAIT0(); \
    if (GK) AT_DMAK((t) + 3, ((t) + 3) & 3); if (GV) AT_DMAV((t) + 1, sl_next); \
    LAS const unsigned char* const kp_ = kp0 + ((t) & 3) * KSLOT; LAS const unsigned char* const kpn_ = kp0 + (((t) + 1) & 3) * KSLOT; LAS const unsigned char* const vp_ = vp0 + sl_prev * VSLOT; \
    f32x2 s2 = {0.f, 0.f}; \
    AT_KRD(2); AT_SBAR(); \
    AT_GA(C0 = AT_MF(kf[0], qr[0], zero16), AT_EX2(P1, 0); pw0[0] = AT_PK(P0, 0); AT_SUM2(P0, 0); AT_PIN(P1); AT_PIN(pw0); AT_PIN(s2)); \
    AT_GA(C1 = AT_MF(kf[1], qr[0], zero16), AT_KRD(3); AT_EX2(P1, 2); pw0[1] = AT_PK(P0, 2); AT_SUM2(P0, 2); pw2[0] = AT_PK(P1, 0); AT_SUM2(P1, 0); AT_PIN(P1); AT_PIN(pw0); AT_PIN(pw2); AT_PIN(s2)); \
    AT_GA(C0 = AT_MF(kf[2], qr[1], C0), pw0[2] = AT_PK(P0, 4); AT_SUM2(P0, 4); pw2[1] = AT_PK(P1, 2); AT_SUM2(P1, 2); AT_PIN(pw0); AT_PIN(pw2); AT_PIN(s2)); \
    AT_GA(C1 = AT_MF(kf[3], qr[1], C1), AT_KRD(4); AT_EX2(P1, 4); pw0[3] = AT_PK(P0, 6); AT_SUM2(P0, 6); AT_PIN(P1); AT_PIN(pw0); AT_PIN(s2)); \
    AT_GA(C0 = AT_MF(kf[4], qr[2], C0), AT_EX2(P1, 6); pw1[0] = AT_PK(P0, 8); AT_SUM2(P0, 8); pw2[2] = AT_PK(P1, 4); AT_SUM2(P1, 4); AT_PIN(P1); AT_PIN(pw1); AT_PIN(pw2); AT_PIN(s2)); \
    AT_GA(C1 = AT_MF(kf[5], qr[2], C1), AT_KRD(5); pw1[1] = AT_PK(P0, 10); AT_SUM2(P0, 10); pw2[3] = AT_PK(P1, 6); AT_SUM2(P1, 6); AT_PIN(pw1); AT_PIN(pw2); AT_PIN(s2)); \
    AT_GA(C0 = AT_MF(kf[6], qr[3], C0), AT_EX2(P1, 8); pw1[2] = AT_PK(P0, 12); AT_SUM2(P0, 12); AT_PIN(P1); AT_PIN(pw1); AT_PIN(s2)); \
    AT_GA(C1 = AT_MF(kf[7], qr[3], C1), AT_EX2(P1, 10); pw1[3] = AT_PK(P0, 14); AT_SUM2(P0, 14); pw3[0] = AT_PK(P1, 8); AT_SUM2(P1, 8); AT_PIN(P1); AT_PIN(pw1); AT_PIN(pw3); AT_PIN(s2)); \
    AT_GA(C0 = AT_MF(kf[8], qr[4], C0), pw3[1] = AT_PK(P1, 10); AT_SUM2(P1, 10); AT_PIN(pw3); AT_PIN(s2)); \
    AT_GA(C1 = AT_MF(kf[9], qr[4], C1), AT_EX2(P1, 12); AT_PIN(P1)); \
    AT_GA(C0 = AT_MF(kf[10], qr[5], C0), AT_VRD(0); AT_EX2(P1, 14); pw3[2] = AT_PK(P1, 12); AT_SUM2(P1, 12); AT_PIN(P1); AT_PIN(pw3); AT_PIN(s2)); \
    AT_GA(C1 = AT_MF(kf[11], qr[5], C1), AT_VRD(4); pw3[3] = AT_PK(P1, 14); AT_SUM2(P1, 14); AT_PIN(pw3); AT_PIN(s2)); \
    l_reg += s2[0] + s2[1]; \
    if (MASK) cmask(C0, C1, (t) - (NT - 4), qrel, hi); \
    { const float rm = rowmax(C0, C1) - mhat; resc = false;                                                       \
      if (__builtin_expect(__any(rm > THR), 0)) { const float dl = __builtin_fmaxf(rm, 0.f); mhat += dl; mh2 = (f32x2){-mhat, -mhat}; AT_PIN(mh2);     \
          const float f = __builtin_amdgcn_exp2f(-dl); l_reg *= f; if (hi == 0) wsf[r32] = f; resc = true; } } \
    AT_PIN(l_reg); AT_SBAR(); \
    AT_GA(o0 = AT_MF(AT_PAF(0), AT_VFR(0), o0), AT_VRD(1); AT_EX2(C0, 0); AT_PIN(C0)); \
    AT_GA(o1 = AT_MF(AT_PAF(0), AT_VFR(4), o1), AT_VRD(5); AT_EX2(C0, 2); AT_PIN(C0)); \
    AT_GA(o0 = AT_MF(AT_PAF(1), AT_VFR(1), o0), AT_VRD(2); AT_EX2(C0, 4); AT_PIN(C0)); \
    AT_GA(o1 = AT_MF(AT_PAF(1), AT_VFR(5), o1), AT_VRD(6); AT_EX2(C0, 6); AT_PIN(C0)); \
    AT_GA(o0 = AT_MF(AT_PAF(2), AT_VFR(2), o0), AT_VRD(3); AT_EX2(C0, 8); AT_PIN(C0)); \
    AT_GA(o1 = AT_MF(AT_PAF(2), AT_VFR(6), o1), AT_VRD(7); AT_EX2(C0, 10); AT_PIN(C0)); \
    AT_GA(o0 = AT_MF(AT_PAF(3), AT_VFR(3), o0), if (GL) AT_KRDP(kpn_, 0); AT_EX2(C0, 12); AT_PIN(C0)); \
    AT_GA(o1 = AT_MF(AT_PAF(3), AT_VFR(7), o1), if (GL) AT_KRDP(kpn_, 1); AT_EX2(C0, 14); AT_PIN(C0)); \
    AT_RESC(); AT_ROT(); \
    } while (0)
    int t = 1;
    for (; t + 5 < NT; t += 2) {
        AT_STEP(pB0, pB1, pA0, pA1, t, false, true, true, true, true);
        AT_STEP(pA0, pA1, pB0, pB1, t + 1, false, true, true, true, true);
    }
    for (; t + 1 < NT; t += 2) {
        AT_STEP(pB0, pB1, pA0, pA1, t, true, (t + 3 < NT), (t + 1 < NT), (t + 1 < NT), false);
        AT_STEP(pA0, pA1, pB0, pB1, t + 1, true, (t + 4 < NT), (t + 2 < NT), (t + 2 < NT), false);
    }
    AT_STEP(pB0, pB1, pA0, pA1, NT - 1, true, false, false, false, false);
    { LAS const unsigned char* const vp_ = vp0 + sl_prev * VSLOT;
#pragma unroll
      for (int i = 0; i < 8; ++i) AT_VRD(i);
#pragma unroll
      for (int r = 0; r < 16; ++r) pB1[r] = __builtin_amdgcn_exp2f(pB1[r] - mhat);
      pw0 = (u32x4){AT_PK(pB0, 0), AT_PK(pB0, 2), AT_PK(pB0, 4), AT_PK(pB0, 6)}; pw1 = (u32x4){AT_PK(pB0, 8), AT_PK(pB0, 10), AT_PK(pB0, 12), AT_PK(pB0, 14)};
      pw2 = (u32x4){AT_PK(pB1, 0), AT_PK(pB1, 2), AT_PK(pB1, 4), AT_PK(pB1, 6)}; pw3 = (u32x4){AT_PK(pB1, 8), AT_PK(pB1, 10), AT_PK(pB1, 12), AT_PK(pB1, 14)};
      { float sa = 0.f;
#pragma unroll
        for (int r = 0; r < 16; ++r) sa += pB0[r] + pB1[r];
        l_reg += sa; }
      o0 = AT_MF(AT_PAF(0), AT_VFR(0), o0); o1 = AT_MF(AT_PAF(0), AT_VFR(4), o1);
      o0 = AT_MF(AT_PAF(1), AT_VFR(1), o0); o1 = AT_MF(AT_PAF(1), AT_VFR(5), o1);
      o0 = AT_MF(AT_PAF(2), AT_VFR(2), o0); o1 = AT_MF(AT_PAF(2), AT_VFR(6), o1);
      o0 = AT_MF(AT_PAF(3), AT_VFR(3), o0); o1 = AT_MF(AT_PAF(3), AT_VFR(7), o1); }
#undef AT_STEP
#undef AT_GA
#undef AT_EX2
#undef AT_SUM2
#undef AT_RESC
#undef AT_EX
#undef AT_PK
#undef AT_PAF
#undef AT_VFR
#undef AT_VRD
#undef AT_KRD
#undef AT_KRDP
#undef AT_ROT
#undef AT_WAIT0
#undef AT_WAITC
#undef AT_DMAV
#undef AT_DMAK
    { auto rr = __builtin_amdgcn_permlane32_swap(__float_as_uint(l_reg), __float_as_uint(l_reg), false, false); l_reg = __uint_as_float(rr[0]) + __uint_as_float(rr[1]); }
    if (hi == 0) wsf[32 + r32] = l_reg;
    bf16* Ow = O + (tb + q0 + wid * 32) * 512 + h * 64 + r32;
#pragma unroll
    for (int r = 0; r < 16; ++r) { const int q = crow(r, hi); const float f = __builtin_amdgcn_rcpf(wsf[32 + q]); Ow[(size_t)q * 512] = f2bf(o0[r] * f); Ow[(size_t)q * 512 + 32] = f2bf(o1[r] * f); }
    asm volatile("s_waitcnt lgkmcnt(0)\n\ts_barrier" ::: "memory");
}
}

namespace ssd {
constexpr int L_BM = 0, L_CG = 32768, L_X = 65536;
constexpr int S_ACUM = 0, S_DT = 2048;
template <class F> __device__ __forceinline__ void conv8(const bf16* proj, const float* cw, const float* cb, int ccol, size_t t0, int tr0, bool seq_start, F sink) {
    float w[4][8], bia[8];
#pragma unroll
    for (int k = 0; k < 4; ++k) { const f32x4 a = *(const f32x4*)(cw + k * 1536 + ccol), b = *(const f32x4*)(cw + k * 1536 + ccol + 4);
        w[k][0] = a[0]; w[k][1] = a[1]; w[k][2] = a[2]; w[k][3] = a[3]; w[k][4] = b[0]; w[k][5] = b[1]; w[k][6] = b[2]; w[k][7] = b[3]; }
    { const f32x4 a = *(const f32x4*)(cb + ccol), b = *(const f32x4*)(cb + ccol + 4); bia[0] = a[0]; bia[1] = a[1]; bia[2] = a[2]; bia[3] = a[3]; bia[4] = b[0]; bia[5] = b[1]; bia[6] = b[2]; bia[7] = b[3]; }
    float x0[8], x1[8], x2[8];
    auto ld = [&](int tr, float (&x)[8]) {
        if (seq_start && tr < 0) {
#pragma unroll
            for (int e = 0; e < 8; ++e) x[e] = 0.f;
        } else {
            const u32x4 v = *(const u32x4*)(proj + (t0 + tr) * NPAD + CXBC + ccol);
            x[0] = bflo(v.x); x[1] = bfhi(v.x); x[2] = bflo(v.y); x[3] = bfhi(v.y); x[4] = bflo(v.z); x[5] = bfhi(v.z); x[6] = bflo(v.w); x[7] = bfhi(v.w);
        } };
    ld(tr0 - 3, x0); ld(tr0 - 2, x1); ld(tr0 - 1, x2);
#pragma unroll
    for (int i = 0; i < 8; ++i) {
        float x3[8], y[8]; ld(tr0 + i, x3);
#pragma unroll
        for (int e = 0; e < 8; ++e) { const float v = bia[e] + w[0][e] * x0[e] + w[1][e] * x1[e] + w[2][e] * x2[e] + w[3][e] * x3[e]; y[e] = siluf_(v); x0[e] = x1[e]; x1[e] = x2[e]; x2[e] = x3[e]; }
        sink(tr0 + i, y);
    }
}
__device__ __forceinline__ void s1_unit(Frame& F, int L, int b, int c, int g) {
    LAS unsigned char* lds = F.lds; LAS float* side = (LAS float*)(F.lds + SIDE_OFF);
    int tid_ = cur_tid(); asm volatile("" : "+v"(tid_));
    const int tid = tid_, lane = tid & 63, wid = __builtin_amdgcn_readfirstlane(tid >> 6), r32 = lane & 31, hi = lane >> 5;
    const size_t t0 = (size_t)b * SEQ + (size_t)c * 128; const bool seq_start = (c == 0);
    const bf16* proj = (const bf16*)(F.ws + X_PROJ); const float* dtraw = (const float*)(F.ws + X_DTRAW);
    const float* cw = (const float*)F.in[8] + (size_t)L * 4 * 1536; const float* cb = (const float*)F.in[9] + L * 1536;
    const float* dtb = (const float*)F.in[10] + L * 16; const float* alog = (const float*)F.in[11] + L * 16; const float* dsk = (const float*)F.in[12] + L * 16;
    bf16* Cc = (bf16*)(F.ws + X_CC); float* eacum = (float*)(F.ws + X_EACUM); float* cdec = (float*)(F.ws + X_CDEC);
    bf16* ypart = (bf16*)(F.ws + X_YPART); bf16* states = (bf16*)(F.ws + X_STATES);
    { const int ch = tid & 31, tg = tid >> 5; const bool isC = ch >= 16; const int ccol = 1024 + (isC ? 256 : 0) + g * 128 + 8 * (ch & 15);
      conv8(proj, cw, cb, ccol, t0, 8 * tg, seq_start, [&](int tr, const float (&y)[8]) {
          const u32x4 w = {pk2(y[0], y[1]), pk2(y[2], y[3]), pk2(y[4], y[5]), pk2(y[6], y[7])};
          *(LAS u32x4*)(lds + (isC ? L_CG : L_BM) + off_b(tr, ch & 15)) = w;
          if (isC) *(u32x4*)(Cc + (t0 + tr) * 256 + g * 128 + 8 * (ch & 15)) = w; }); }
    LDS_BAR();
    { const int lb = wid >> 1; f32x16 gacc[2];
#pragma unroll
      for (int i = 0; i < 2; ++i) { const int sb = 2 * (wid & 1) + i; gacc[i] = (f32x16){};
          if (sb <= lb) {
#pragma unroll
              for (int ks = 0; ks < 8; ++ks) { const bf16x8 a = *(LAS const bf16x8*)(lds + L_CG + row_read_addr(32 * lb, lane, ks)), bb = *(LAS const bf16x8*)(lds + L_BM + row_read_addr(32 * sb, lane, ks));
                  gacc[i] = __builtin_amdgcn_mfma_f32_32x32x16_bf16(a, bb, gacc[i], 0, 0, 0); } } }
      LDS_BAR();
#pragma unroll
      for (int i = 0; i < 2; ++i) { const int sb = 2 * (wid & 1) + i;
          if (sb <= lb) {
#pragma unroll
              for (int r = 0; r < 16; ++r) { const int row = 32 * lb + crow(r, hi), col = 32 * sb + r32; *(LAS unsigned short*)(lds + L_CG + off_b(row, col >> 3) + (col & 7) * 2) = f2bf(gacc[i][r]); } } } }
#pragma unroll 1
    for (int rd = 0; rd < 2; ++rd) {
        if (wid < 4) {
            const int h = 8 * g + 4 * rd + wid; const float bia = dtb[h], a = -__expf(alog[h]);
            float d0 = dtraw[(t0 + lane) * 16 + h] + bia, d1 = dtraw[(t0 + 64 + lane) * 16 + h] + bia;
            d0 = fmaxf(d0, 0.f) + __logf(1.f + __expf(-fabsf(d0))); d1 = fmaxf(d1, 0.f) + __logf(1.f + __expf(-fabsf(d1)));
            d0 = fmaxf(d0, 1e-20f); d1 = fmaxf(d1, 1e-20f);
            float c0 = d0 * a, c1 = d1 * a;
#pragma unroll
            for (int o = 1; o < 64; o <<= 1) { const float v0 = __shfl_up(c0, o), v1 = __shfl_up(c1, o); if (lane >= o) { c0 += v0; c1 += v1; } }
            c1 += __shfl(c0, 63);
            side[S_ACUM / 4 + wid * 128 + lane] = c0; side[S_ACUM / 4 + wid * 128 + 64 + lane] = c1;
            side[S_DT / 4 + wid * 128 + lane] = d0; side[S_DT / 4 + wid * 128 + 64 + lane] = d1;
            eacum[(t0 + lane) * 16 + h] = __expf(c0); eacum[(t0 + 64 + lane) * 16 + h] = __expf(c1);
            if (lane == 63) cdec[((size_t)b * 64 + c) * 16 + h] = __expf(c1);
        }
        LDS_BAR();
        {
          const int ch = tid & 31, tg = tid >> 5, hd = ch >> 3, pch = ch & 7; const int ccol = (8 * g + 4 * rd + hd) * 64 + 8 * pch;
          conv8(proj, cw, cb, ccol, t0, 8 * tg, seq_start, [&](int tr, const float (&y)[8]) {
              const float d = side[S_DT / 4 + hd * 128 + tr];
              *(LAS u32x4*)(lds + L_X + (hd >> 1) * 32768 + off_b(tr, (hd & 1) * 8 + pch)) = (u32x4){pk2(y[0] * d, y[1] * d), pk2(y[2] * d, y[3] * d), pk2(y[4] * d, y[5] * d), pk2(y[6] * d, y[7] * d)}; }); }
        LDS_BAR();
        {
          const int hd = wid >> 1, sub = wid & 1, h = 8 * g + 4 * rd + hd;
          LAS const unsigned char* Xt = lds + L_X + (hd >> 1) * 32768; const int cb0 = (hd & 1) * 2;
          LAS const float* ac = side + S_ACUM / 4 + hd * 128; LAS const float* dts = side + S_DT / 4 + hd * 128;
          const float dskip = dsk[h];
#pragma unroll 1
          for (int rbi = 0; rbi < 2; ++rbi) {
              const int rb = sub ? (1 + rbi) : (3 * rbi); const int l = 32 * rb + r32; const float al = ac[l], dl = dskip * __builtin_amdgcn_rcpf(dts[l]);
              f32x16 y0 = {}, y1 = {};
              for (int ks = 0; ks <= 2 * rb + 1; ++ks) {
                  const u32x4 gw = *(LAS const u32x4*)(lds + L_CG + row_read_addr(32 * rb, lane, ks));
                  const f32x4 as0 = *(LAS const f32x4*)(ac + 16 * ks + 8 * hi), as1 = *(LAS const f32x4*)(ac + 16 * ks + 8 * hi + 4);
                  const float gv[8] = {bflo(gw.x), bfhi(gw.x), bflo(gw.y), bfhi(gw.y), bflo(gw.z), bfhi(gw.z), bflo(gw.w), bfhi(gw.w)};
                  const float asv[8] = {as0[0], as0[1], as0[2], as0[3], as1[0], as1[1], as1[2], as1[3]};
                  float mv[8];
#pragma unroll
                  for (int j = 0; j < 8; ++j) { const int s = 16 * ks + 8 * hi + j; float m = (s <= l) ? gv[j] * __expf(al - asv[j]) : 0.f; if (s == l) m += dl; mv[j] = m; }
                  const bf16x8 af = __builtin_bit_cast(bf16x8, (u32x4){pk2(mv[0], mv[1]), pk2(mv[2], mv[3]), pk2(mv[4], mv[5]), pk2(mv[6], mv[7])});
                  y0 = __builtin_amdgcn_mfma_f32_32x32x16_bf16(af, tr_frag(Xt, lane, cb0, ks), y0, 0, 0, 0);
                  y1 = __builtin_amdgcn_mfma_f32_32x32x16_bf16(af, tr_frag(Xt, lane, cb0 + 1, ks), y1, 0, 0, 0);
              }
#pragma unroll
              for (int i = 0; i < 2; ++i) { bf16* yp = ypart + (((size_t)b * 64 + c) * 16 + h) * 8192 + (size_t)(rb * 2) * 1024 + lane * 16 + 8 * i;
                  *(u32x4*)yp = (u32x4){pk2(y0[8 * i], y0[8 * i + 1]), pk2(y0[8 * i + 2], y0[8 * i + 3]), pk2(y0[8 * i + 4], y0[8 * i + 5]), pk2(y0[8 * i + 6], y0[8 * i + 7])};
                  *(u32x4*)(yp + 1024) = (u32x4){pk2(y1[8 * i], y1[8 * i + 1]), pk2(y1[8 * i + 2], y1[8 * i + 3]), pk2(y1[8 * i + 4], y1[8 * i + 5]), pk2(y1[8 * i + 6], y1[8 * i + 7])}; }
          }
          { f32x16 st[4] = {{}, {}, {}, {}}; const float aend = ac[127];
            for (int ks = 0; ks < 8; ++ks) {
                const bf16x8 xf = tr_frag(Xt, lane, cb0 + sub, ks); const u32x4 xw = __builtin_bit_cast(u32x4, xf);
                const f32x4 as0 = *(LAS const f32x4*)(ac + 16 * ks + 8 * hi), as1 = *(LAS const f32x4*)(ac + 16 * ks + 8 * hi + 4);
                const bf16x8 af = __builtin_bit_cast(bf16x8, (u32x4){pk2(bflo(xw.x) * __expf(aend - as0[0]), bfhi(xw.x) * __expf(aend - as0[1])), pk2(bflo(xw.y) * __expf(aend - as0[2]), bfhi(xw.y) * __expf(aend - as0[3])),
                                                                       pk2(bflo(xw.z) * __expf(aend - as1[0]), bfhi(xw.z) * __expf(aend - as1[1])), pk2(bflo(xw.w) * __expf(aend - as1[2]), bfhi(xw.w) * __expf(aend - as1[3]))});
#pragma unroll
                for (int nb = 0; nb < 4; ++nb) st[nb] = __builtin_amdgcn_mfma_f32_32x32x16_bf16(af, tr_frag(lds + L_BM, lane, nb, ks), st[nb], 0, 0, 0);
            }
            bf16* sp = states + (((size_t)b * 64 + c) * 16 + h) * 8192;
#pragma unroll
            for (int nb = 0; nb < 4; ++nb)
#pragma unroll
                for (int r = 0; r < 16; ++r) sp[(32 * sub + crow(r, hi)) * 128 + 32 * nb + r32] = f2bf(st[nb][r]); }
        }
        LDS_BAR();
    }
}
__device__ __forceinline__ void scan_phase(Frame& F) {
    const bf16* states = (const bf16*)(F.ws + X_STATES); const float* cdec = (const float*)(F.ws + X_CDEC); bf16* prev = (bf16*)(F.ws + X_PREV);
    for (int idx = F.vcu * NWAVES * 64 + F.tid; idx < NB * 16 * 64 * 32; idx += F.G * NWAVES * 64) {
        const int n4 = idx & 31, p = (idx >> 5) & 63, h = (idx >> 11) & 15, b = idx >> 15;
        f32x4 st = {0.f, 0.f, 0.f, 0.f};
#pragma unroll 1
        for (int c0 = 0; c0 < 64; c0 += 16) {
            const size_t o0 = ((((size_t)b * 64 + c0) * 16 + h) * 64 + p) * 128 + 4 * n4;
            u32x2 cw[16]; float d[16];
#pragma unroll
            for (int k = 0; k < 16; ++k) { cw[k] = *(const u32x2*)(states + o0 + (size_t)k * (16 * 64 * 128)); d[k] = cdec[((size_t)b * 64 + c0 + k) * 16 + h]; }
#pragma unroll
            for (int k = 0; k < 16; ++k) {
                *(u32x2*)(prev + o0 + (size_t)k * (16 * 64 * 128)) = (u32x2){pk2(st[0], st[1]), pk2(st[2], st[3])};
                const f32x4 cs = {bflo(cw[k].x), bfhi(cw[k].x), bflo(cw[k].y), bfhi(cw[k].y)};
                st = st * d[k] + cs; }
        }
    }
}
__device__ __forceinline__ void s3_unit(Frame& F, int L, int b, int c, int g) {
    LAS unsigned char* lds = F.lds; LAS float* side = (LAS float*)(F.lds + SIDE_OFF);
    int tid_ = cur_tid(); asm volatile("" : "+v"(tid_));
    const int tid = tid_, lane = tid & 63, wid = __builtin_amdgcn_readfirstlane(tid >> 6), r32 = lane & 31, hi = lane >> 5, h = 8 * g + wid;
    const size_t t0 = (size_t)b * SEQ + (size_t)c * 128;
    const bf16* proj = (const bf16*)(F.ws + X_PROJ); const bf16* Cc = (const bf16*)(F.ws + X_CC); const float* eacum = (const float*)(F.ws + X_EACUM);
    const bf16* ypf = (const bf16*)(F.ws + X_YPART) + (((size_t)b * 64 + c) * 16 + h) * 8192 + lane * 16; const bf16* prev = (const bf16*)(F.ws + X_PREV) + (((size_t)b * 64 + c) * 16 + h) * 8192;
    const float* nw = (const float*)F.in[13] + L * 1024; bf16* ynorm = (bf16*)(F.ws + X_YNORM);
    LAS unsigned char* zst = lds + 32768 + wid * 8192;
    LAS float* eac = side + 1280 + wid * 128;
#pragma unroll
    for (int i = 0; i < 4; ++i) { const int q = tid + 512 * i, row = q >> 4, ch = q & 15; *(LAS u32x4*)(lds + off_b(row, ch)) = *(const u32x4*)(Cc + (t0 + row) * 256 + g * 128 + 8 * ch); }
    eac[lane] = eacum[(t0 + lane) * 16 + h]; eac[64 + lane] = eacum[(t0 + 64 + lane) * 16 + h];
    bf16x8 pf[8][2];
#pragma unroll
    for (int ks = 0; ks < 8; ++ks)
#pragma unroll
        for (int pb = 0; pb < 2; ++pb) pf[ks][pb] = *(const bf16x8*)(prev + (32 * pb + r32) * 128 + 16 * ks + 8 * hi);
    LDS_BAR();
    const int srow = lane >> 1, shalf = lane & 1;
#define S3_LOAD(rb, Z, Y0, Y1) do { \
        _Pragma("unroll") for (int i = 0; i < 4; ++i) { const int q = lane + 64 * i, row = q >> 3, ch = q & 7; Z[i] = *(const u32x4*)(proj + (t0 + 32 * (rb) + row) * NPAD + CZ + h * 64 + 8 * ch); } \
        _Pragma("unroll") for (int i = 0; i < 2; ++i) { Y0[i] = *(const u32x4*)(ypf + ((rb) * 2 + 0) * 1024 + 8 * i); Y1[i] = *(const u32x4*)(ypf + ((rb) * 2 + 1) * 1024 + 8 * i); } } while (0)
    auto s3_body = [&](const int rb, const u32x4 (&zq)[4], const u32x4 (&yq0)[2], const u32x4 (&yq1)[2]) {
#pragma unroll
        for (int i = 0; i < 4; ++i) { const int q = lane + 64 * i, row = q >> 3, ch = q & 7; *(LAS u32x4*)(zst + row * 128 + ch * 16) = zq[i]; }
        f32x16 a0 = {}, a1 = {};
#pragma unroll
        for (int ks = 0; ks < 8; ++ks) { const bf16x8 cf = *(LAS const bf16x8*)(lds + row_read_addr(32 * rb, lane, ks));
            a0 = __builtin_amdgcn_mfma_f32_32x32x16_bf16(cf, pf[ks][0], a0, 0, 0, 0); a1 = __builtin_amdgcn_mfma_f32_32x32x16_bf16(cf, pf[ks][1], a1, 0, 0, 0); }
#pragma unroll
        for (int r = 0; r < 16; ++r) { const int lr = crow(r, hi); const float ea = eac[32 * rb + lr];
            const float z0 = bf2f(*(LAS const unsigned short*)(zst + lr * 128 + r32 * 2)), z1 = bf2f(*(LAS const unsigned short*)(zst + lr * 128 + 64 + r32 * 2));
            const unsigned w0_ = yq0[r >> 3][(r >> 1) & 3], w1_ = yq1[r >> 3][(r >> 1) & 3];
            const float y0 = (((r & 1) ? bfhi(w0_) : bflo(w0_)) + ea * a0[r]) * siluf_(z0), y1 = (((r & 1) ? bfhi(w1_) : bflo(w1_)) + ea * a1[r]) * siluf_(z1);
            *(LAS unsigned short*)(zst + 4096 + lr * 128 + r32 * 2) = f2bf(y0); *(LAS unsigned short*)(zst + 4096 + lr * 128 + 64 + r32 * 2) = f2bf(y1); }
        { float ss = 0.f; u32x4 w[4];
#pragma unroll
          for (int i = 0; i < 4; ++i) { w[i] = *(LAS const u32x4*)(zst + 4096 + srow * 128 + shalf * 64 + i * 16);
              const float e[8] = {bflo(w[i].x), bfhi(w[i].x), bflo(w[i].y), bfhi(w[i].y), bflo(w[i].z), bfhi(w[i].z), bflo(w[i].w), bfhi(w[i].w)};
#pragma unroll
              for (int k = 0; k < 8; ++k) ss += e[k] * e[k]; }
          ss += __shfl_xor(ss, 1);
          if (shalf == 0) side[wid * 128 + 32 * rb + srow] = ss;
          bf16* yo = ynorm + (t0 + 32 * rb + srow) * 1024 + h * 64 + shalf * 32;
#pragma unroll
          for (int i = 0; i < 4; ++i) *(u32x4*)(yo + 8 * i) = w[i]; }
    };
    { u32x4 zA[4], yA0[2], yA1[2], zB[4], yB0[2], yB1[2];
      S3_LOAD(0, zA, yA0, yA1);
      S3_LOAD(1, zB, yB0, yB1); s3_body(0, zA, yA0, yA1);
      S3_LOAD(2, zA, yA0, yA1); s3_body(1, zB, yB0, yB1);
      S3_LOAD(3, zB, yB0, yB1); s3_body(2, zA, yA0, yA1);
      s3_body(3, zB, yB0, yB1); }
#undef S3_LOAD
    WG_BAR();
    if (tid < 128) { float s = 0.f;
#pragma unroll
        for (int w = 0; w < 8; ++w) s += side[w * 128 + tid];
        side[1024 + tid] = __builtin_amdgcn_rsqf(s * (1.f / 512.f) + 1e-6f); }
    LDS_BAR();
    float wv[32];
#pragma unroll
    for (int i = 0; i < 8; ++i) { const f32x4 t4 = *(const f32x4*)(nw + h * 64 + shalf * 32 + 4 * i); wv[4 * i] = t4[0]; wv[4 * i + 1] = t4[1]; wv[4 * i + 2] = t4[2]; wv[4 * i + 3] = t4[3]; }
    u32x4 yw[4][4];
#pragma unroll
    for (int rb = 0; rb < 4; ++rb) { const bf16* yo = ynorm + (t0 + 32 * rb + srow) * 1024 + h * 64 + shalf * 32;
#pragma unroll
        for (int i = 0; i < 4; ++i) yw[rb][i] = *(const u32x4*)(yo + 8 * i); }
#pragma unroll
    for (int rb = 0; rb < 4; ++rb) { const float rs = side[1024 + 32 * rb + srow]; bf16* yo = ynorm + (t0 + 32 * rb + srow) * 1024 + h * 64 + shalf * 32;
#pragma unroll
        for (int i = 0; i < 4; ++i) { const u32x4 w = yw[rb][i]; u32x4 o;
            o.x = pk2(bflo(w.x) * rs * wv[8 * i], bfhi(w.x) * rs * wv[8 * i + 1]); o.y = pk2(bflo(w.y) * rs * wv[8 * i + 2], bfhi(w.y) * rs * wv[8 * i + 3]);
            o.z = pk2(bflo(w.z) * rs * wv[8 * i + 4], bfhi(w.z) * rs * wv[8 * i + 5]); o.w = pk2(bflo(w.w) * rs * wv[8 * i + 6], bfhi(w.w) * rs * wv[8 * i + 7]);
            *(u32x4*)(yo + 8 * i) = o; } }
    LDS_BAR();
}
}

#ifndef PHM
#define PHM 0x3fff
#endif
template <int L> __device__ __forceinline__ void layer_body(Frame& F, const XcdBarrier bar, LAS unsigned char* ring, LAS int* toff, bf16* hb, const int bx) {
        unsigned char* wl = F.ws + WS_WSM + (size_t)L * WSM_LAYER; (void)wl;
#if (PHM >> 1) & 1
        frame_refresh(F);
        { ge::Dense<EpiProj> P{hb, (const bf16*)(wl + WO_WIN), 1024, 1024, {}, {(bf16*)(F.ws + X_PROJ), (float*)(F.ws + X_DTRAW)}}; P.S.init(T, NPAD, F.G, bx);
          ge::gemm_phase(ring, P); }
        xcd_barrier(bar);
#endif
#if (PHM >> 2) & 1
        frame_refresh(F);
#ifndef NO_PREP
        prep_rows(F, L);
#endif
#ifndef NO_S1
        { const int nk_ = (NB * 64 * 2 + F.G - 1) / F.G, kmax_ = nk_ < 2 ? 2 : nk_;
#pragma unroll 1
          for (int k_ = 0; k_ < kmax_; ++k_) { const int u = F.vcu + k_ * F.G;
              if (u < NB * 64 * 2) ssd::s1_unit(F, L, u >> 7, (u >> 1) & 63, u & 1); } }
#endif
        xcd_barrier(bar);
#endif
#if (PHM >> 3) & 1
        frame_refresh(F);
        { ge::Dense<EpiQ> P{(const bf16*)(F.ws + X_QN), (const bf16*)(wl + WO_WQ), 384, 384, {}, {(bf16*)(F.ws + X_QB), (const float*)(F.ws + WS_ROPE), (const float*)(F.ws + WS_ROPE) + (size_t)T * 16}}; P.S.init(T, 768, F.G, bx);
          ge::gemm_phase(ring, P); }
        { ge::Dense<EpiStoreBf16> P{(const bf16*)(F.ws + X_CKVN), (const bf16*)(wl + WO_WKV), 256, 256, {}, {(bf16*)(F.ws + X_KVB), 1024}}; P.S.init(T, 1024, F.G, bx);
          ge::gemm_phase(ring, P); }
        ssd::scan_phase(F);
        xcd_barrier(bar);
#endif
#if (PHM >> 4) & 1
        frame_refresh(F);
#ifndef NO_ATTN
        { const int s = F.vcu & 7, bh = F.vcu >> 3; const bool bal = F.G == 256;
          const int nk_ = bal ? 4 : (1024 + F.G - 1) / F.G, kmax_ = nk_ < 4 ? 4 : nk_;
          bool conv_done = false;
#pragma unroll 1
          for (int i = 0; i < kmax_; ++i) {
              if (!conv_done && conv_acquire(F, L, false)) { p0_expert_weights(F, L); WG_BAR(); conv_release(F, L); conv_done = true; }
              const int qb = (i == 0) ? 31 - s : (i == 1) ? 16 + s : (i == 2) ? 15 - s : s;     const int u = F.vcu + i * F.G;
              if (bal || u < 1024)
                  at::attn_unit(bal ? (bh >> 3) : (u >> 8), bal ? (bh & 7) : ((u >> 5) & 7), bal ? qb : (u & 31), (const bf16*)(F.ws + X_QB), (const bf16*)(F.ws + X_KVB), (const bf16*)(F.ws + X_KPE), (bf16*)(F.ws + X_OB), ring); }
          if (!conv_done) { conv_acquire(F, L, true); p0_expert_weights(F, L); WG_BAR(); conv_release(F, L); } }
#endif
#ifndef NO_S3
        for (int u = F.vcu; u < NB * 64 * 2; u += F.G) ssd::s3_unit(F, L, u >> 7, (u >> 1) & 63, u & 1);
#endif
        xcd_barrier(bar);
#endif
#if (PHM >> 5) & 1
        frame_refresh(F);
        { ge::Dense<EpiGate> P{(const bf16*)(F.ws + X_OB), (const bf16*)(wl + WO_WAB), 512, 512, {}, {(bf16*)(F.ws + X_MB), (const bf16*)(F.ws + X_PROJ), CGA, 0}}; P.S.init(T, 1024, F.G, bx);
          ge::gemm_phase(ring, P); }
        { ge::Dense<EpiGate> P{(const bf16*)(F.ws + X_YNORM), (const bf16*)(wl + WO_WSB), 1024, 1024, {}, {(bf16*)(F.ws + X_MB), (const bf16*)(F.ws + X_PROJ), CGB, 1}}; P.S.init(T, 1024, F.G, bx);
          ge::gemm_phase(ring, P); }
        xcd_barrier(bar);
#endif
#if (PHM >> 6) & 1
        frame_refresh(F);
        { ge::Dense<EpiWo> P{(const bf16*)(F.ws + X_MB), (const bf16*)(wl + WO_WO), 1024, 1024, {}, {(bf16*)(F.ws + X_PRE), (const bf16*)hb}}; P.S.init(T, 1024, F.G, bx);
          ge::gemm_phase(ring, P); }
        xcd_barrier(bar);
#endif
#if (PHM >> 7) & 1
        frame_refresh(F);
        ln_rows<false, false>(F, (const bf16*)(F.ws + X_PRE), (const float*)F.in[17] + L * D, (const float*)F.in[18] + L * D, nullptr, nullptr, nullptr);
        xcd_barrier(bar);
#endif
#if (PHM >> 8) & 1
        frame_refresh(F);
        { ge::Dense<EpiCat> P{hb, (const bf16*)(wl + WO_WCAT), 1024, 1024, {}, {(float*)(F.ws + X_LOGITS), (bf16*)(F.ws + X_SHHID), (bf16*)(F.ws + X_SG)}}; P.S.init(T, 1792, F.G, bx);
          ge::gemm_phase(ring, P); }
        { const int nwg = (T / 256) * (1792 / 256), maxu = (nwg + F.G - 1) / F.G, nfull = nwg - (maxu - 1) * F.G;
          int tid_ = cur_tid(); asm volatile("" : "+v"(tid_)); F.tid = tid_;
          if (nfull >= F.G) conv_p(F, L, bx, F.G); else if (bx >= nfull) conv_p(F, L, bx - nfull, F.G - nfull); }
        xcd_barrier(bar);
#endif
#if (PHM >> 9) & 1
        frame_refresh(F);
        topk_rows(F, L);
        { ge::Dense<EpiPle> P{(const bf16*)(F.ws + X_PB), (const bf16*)(wl + WO_WPLE), 256, 256, {}, {(bf16*)(F.ws + X_BASE), (const bf16*)hb, (const bf16*)(F.ws + X_SG)}}; P.S.init(T, 1024, F.G, bx);
          ge::gemm_phase(ring, P); }
        { ge::Dense<EpiAddF32> P{(const bf16*)(F.ws + X_SHHID), (const bf16*)(wl + WO_WSD), 256, 256, {}, {(bf16*)(F.ws + X_BASE)}}; P.S.init(T, 1024, F.G, bx);
          ge::gemm_phase(ring, P); }
        xcd_barrier(bar);
#endif
#if (PHM >> 10) & 1
        frame_refresh(F);
        build_toff(F, L, toff);
        scatter_slots(F, L, toff);
        xcd_barrier(bar);
#endif
#if (PHM >> 11) & 1
        frame_refresh(F);
        { MoeGU P{hb, (const bf16*)(F.ws + WS_WGU + (size_t)L * WGU_LAYER), (const int*)(F.ws + X_STOK), (bf16*)(F.ws + X_HID), toff, F.G, F.vcu, 1024};
          ge::gemm_phase(ring, P); }
        xcd_barrier(bar);
#endif
#if (PHM >> 12) & 1
        frame_refresh(F);
        { MoeDown P{(const bf16*)(F.ws + X_HID), (const bf16*)(F.ws + WS_WD + (size_t)L * WD_LAYER), (const float*)(F.ws + X_SW), (unsigned char*)(F.ws + X_Y), toff, F.G, F.vcu, 256};
          ge::gemm_phase(ring, P); }
        xcd_barrier(bar);
#endif
#if (PHM >> 13) & 1
        frame_refresh(F);
        ln_rows<true, L == DEPTH - 1>(F, (const bf16*)(F.ws + X_BASE), (const float*)F.in[29] + L * D, (const float*)F.in[30] + L * D, (const int*)(F.ws + X_RRANK), (const unsigned char*)(F.ws + X_Y), (const float*)(F.ws + X_RW));
        xcd_barrier(bar);
#endif
}
struct Args { const void* in[31]; float* out; unsigned char* ws; };
__global__ void __launch_bounds__(NWAVES * 64, 2) fwd(Args args) {
    Frame F;
    F.lds = (LAS unsigned char*)lds_raw;
    F.tid = threadIdx.x; F.lane = F.tid & 63; F.wave = __builtin_amdgcn_readfirstlane(F.tid >> 6);
    F.G = gridDim.x; { const int bx = blockIdx.x; F.vcu = (F.G % 8 == 0) ? (bx % 8) * (F.G / 8) + bx / 8 : bx; }
    F.ws = args.ws; F.out = args.out; F.in = args.in; F.ctl = (gu32*)(args.ws + WS_CTL);
    for (int u = F.tid; u < (LDS_BYTES - LDSCTL_OFF) / 4; u += NWAVES * 64) ((LAS unsigned*)(F.lds + LDSCTL_OFF))[u] = 0u;
    __syncthreads();
    if (F.lane == 0) *(volatile LAS int*)(F.lds + LDSCTL_OFF + 64 + 4 * hw_wave_slot()) = F.wave;
    __syncthreads();
    frame_refresh(F);
    XcdBarrier bar = xcd_barrier_post((unsigned*)(F.ctl + CW_BAR), (volatile LAS unsigned*)(F.lds + LDSCTL_OFF));
    LAS unsigned char* ring = F.lds + RING_OFF;
    LAS int* toff = (LAS int*)(F.lds + SIDE_OFF + 8192);
    bf16* hb = (bf16*)(F.ws + WS_HB);
    const int bx = (int)blockIdx.x;

#if (PHM >> 0) & 1
        frame_refresh(F);
    p0_small_weights(F); p0_misc(F);
    xcd_barrier(bar);

#endif
    layer_body<0>(F, bar, ring, toff, hb, bx);
    layer_body<1>(F, bar, ring, toff, hb, bx);
}

extern "C" void kernel_launch(void* const* d_in, const int* in_sizes, int n_in, void* d_out, int out_size, void* d_ws, size_t ws_size, hipStream_t stream) {
    static int grid = 0;
    if (grid == 0) {
        if (n_in != 31 || out_size != T * D || ws_size < WS_END) { fprintf(stderr, "kernel_launch: unexpected shapes (n_in %d out %d ws %zu)\n", n_in, out_size, ws_size); grid = -1; return; }
        int dev = 0, cus = 0, per_cu = 0;
        if (hipGetDevice(&dev) != hipSuccess || hipDeviceGetAttribute(&cus, hipDeviceAttributeMultiprocessorCount, dev) != hipSuccess) { grid = -1; return; }
        if (hipFuncSetAttribute((const void*)fwd, hipFuncAttributeMaxDynamicSharedMemorySize, LDS_BYTES) != hipSuccess) { fprintf(stderr, "kernel_launch: hipFuncSetAttribute failed\n"); grid = -1; return; }
        if (hipOccupancyMaxActiveBlocksPerMultiprocessor(&per_cu, (const void*)fwd, NWAVES * 64, LDS_BYTES) != hipSuccess || per_cu < 1) { fprintf(stderr, "kernel_launch: occupancy query says %d\n", per_cu); }
        (void)hipGetLastError();
        grid = cus;
    }
    if (grid < 0) return;
    (void)hipMemsetAsync((char*)d_ws + WS_CTL, 0, CTL_ZERO_BYTES, stream);
    Args a{};
    for (int i = 0; i < 31; ++i) a.in[i] = d_in[i];
    a.out = (float*)d_out; a.ws = (unsigned char*)d_ws;
    hipLaunchKernelGGL(fwd, dim3(grid), dim3(NWAVES * 64), LDS_BYTES, stream, a);
}
```

```cpp
#include <hip/hip_runtime.h>
#include <cstdio>
#include <cstdint>

#define LAS __attribute__((address_space(3)))
#define GAS __attribute__((address_space(1)))
typedef unsigned short bf16;
typedef short bf16x8 __attribute__((ext_vector_type(8)));
typedef short s16x4 __attribute__((ext_vector_type(4)));
typedef float f32x2 __attribute__((ext_vector_type(2)));
typedef float f32x4 __attribute__((ext_vector_type(4)));
typedef float f32x16 __attribute__((ext_vector_type(16)));
typedef unsigned u32x2 __attribute__((ext_vector_type(2)));
typedef unsigned u32x4 __attribute__((ext_vector_type(4)));
typedef GAS unsigned gu32;

constexpr int NB = 4, SEQ = 8192, T = NB * SEQ, D = 1024, DEPTH = 2;
constexpr int NCOLS = 5296, NPAD = 5376;
constexpr int CQ = 0, CKV = 384, CKPE = 640, CZ = 672, CXBC = 1696, CDT = 3232, CGA = 3248, CGB = 4272;
constexpr int NEXP = 256, TOPK = 8;
constexpr int SMAX = T * TOPK + NEXP * 255;
constexpr float ALPHA = 1.4142135623730951f;
constexpr float QSCALE = 0.10206207261596577f * 1.4426950408889634f;
constexpr int NWAVES = 8;
constexpr float YSCALE = 32.f;

constexpr size_t MiB = 1u << 20;
constexpr size_t WS_CTL = 0, CTL_ZERO_BYTES = 1 * MiB;
constexpr size_t WS_WSM = 1 * MiB, WSM_LAYER = 22 * MiB;
constexpr size_t WO_WIN = 0, WO_WQ = WO_WIN + (size_t)NPAD * 1024 * 2, WO_WKV = WO_WQ + 768 * 384 * 2, WO_WAB = WO_WKV + 1024 * 256 * 2,
                 WO_WSB = WO_WAB + 1024 * 512 * 2, WO_WO = WO_WSB + 1024 * 1024 * 2, WO_WCAT = WO_WO + 1024 * 1024 * 2,
                 WO_WSD = WO_WCAT + 1792 * 1024 * 2, WO_WPLE = WO_WSD + 1024 * 256 * 2, WO_END = WO_WPLE + 1024 * 256 * 2;
static_assert(WO_END <= WSM_LAYER, "small weights");
constexpr size_t WS_ROPE = 45 * MiB;
constexpr size_t WS_HB = 49 * MiB;
constexpr size_t WS_WGU = 113 * MiB, WGU_LAYER = 256 * MiB;
constexpr size_t WS_WD = 625 * MiB, WD_LAYER = 128 * MiB;
constexpr size_t WS_X = 881 * MiB;
constexpr size_t X_PROJ = WS_X, X_DTRAW = X_PROJ + 336 * MiB, X_QN = X_DTRAW + 2 * MiB, X_CKVN = X_QN + 24 * MiB, X_KPE = X_CKVN + 16 * MiB,
                 X_QB = X_KPE + 2 * MiB, X_KVB = X_QB + 48 * MiB, X_OB = X_KVB + 64 * MiB, X_YPART = X_OB + 32 * MiB, X_CC = X_YPART + 128 * MiB,
                 X_EACUM = X_CC + 16 * MiB, X_CDEC = X_EACUM + 2 * MiB, X_STATES = X_CDEC + 1 * MiB, X_PREV = X_STATES + 128 * MiB,
                 X_YNORM = X_PREV + 64 * MiB, X_MB = X_YNORM + 64 * MiB, X_PRE = X_MB + 64 * MiB, X_MIX_END = X_PRE + 128 * MiB;
constexpr size_t X_LOGITS = WS_X, X_RIDX = X_LOGITS + 32 * MiB, X_RW = X_RIDX + 1 * MiB, X_RRANK = X_RW + 1 * MiB, X_STOK = X_RRANK + 1 * MiB,
                 X_SW = X_STOK + 2 * MiB, X_PB = X_SW + 2 * MiB, X_SHHID = X_PB + 16 * MiB, X_SG = X_SHHID + 16 * MiB, X_BASE = X_SG + 64 * MiB,
                 X_HID = X_BASE + 128 * MiB, X_Y = X_HID + 160 * MiB, X_MOE_END = X_Y + 640 * MiB;
constexpr size_t WS_END = 2048 * MiB;
static_assert(X_MIX_END <= WS_END && X_MOE_END <= WS_END && X_PB + 16 * MiB <= X_PRE, "d_ws map");
static_assert((size_t)SMAX * 256 * 2 <= 160 * MiB && (size_t)SMAX * 1024 * 2 <= 640 * MiB && (size_t)SMAX * 4 <= 2 * MiB, "slot buffers");
constexpr int CW_TMO = 0, CW_BAR = 4096, CW_CNT = 16384, CW_SEM = 32768;
constexpr unsigned CONV_LIMIT = 96;

constexpr int RING_OFF = 0, RING_BYTES = 131072, SIDE_OFF = 131072, SIDE_BYTES = 16384, LDSCTL_OFF = SIDE_OFF + SIDE_BYTES, LDS_BYTES = LDSCTL_OFF + 512;


extern __shared__ __attribute__((aligned(16))) unsigned char lds_raw[];
__device__ __forceinline__ int lane_id() { return (int)__builtin_amdgcn_mbcnt_hi(~0u, __builtin_amdgcn_mbcnt_lo(~0u, 0u)); }
__device__ __forceinline__ unsigned hw_wave_slot() { return (unsigned)__builtin_amdgcn_s_getreg(((6 - 1) << 11) | 4) & 63u; }
__device__ __forceinline__ int wave_index() { return __builtin_amdgcn_readfirstlane(*(volatile LAS int*)((LAS unsigned char*)lds_raw + LDSCTL_OFF + 64 + 4 * hw_wave_slot())); }
__device__ __forceinline__ int cur_tid() { return wave_index() * 64 + lane_id(); }
__device__ __forceinline__ float bf2f(unsigned short b) { return __uint_as_float(((unsigned)b) << 16); }
__device__ __forceinline__ float bflo(unsigned w) { return __uint_as_float(w << 16); }
__device__ __forceinline__ float bfhi(unsigned w) { return __uint_as_float(w & 0xffff0000u); }
typedef __bf16 bf16x2_t __attribute__((ext_vector_type(2)));
__device__ __forceinline__ unsigned pk2(float lo, float hi) { const f32x2 v = {lo, hi}; const bf16x2_t b = __builtin_convertvector(v, bf16x2_t); return __builtin_bit_cast(unsigned, b); }
__device__ __forceinline__ unsigned short f2bf(float f) { return (unsigned short)(pk2(f, 0.f) & 0xffffu); }
__device__ __forceinline__ float sigmoidf_(float x) { return __builtin_amdgcn_rcpf(1.f + __expf(-x)); }
__device__ __forceinline__ float siluf_(float x) { return x * sigmoidf_(x); }
__device__ __forceinline__ float wave_sum(float v) {
#pragma unroll
    for (int o = 1; o < 64; o <<= 1) v += __shfl_xor(v, o);
    return v;
}
template <class Tp> __device__ __forceinline__ Tp* uni_ptr(Tp* p) {
    const unsigned long long v = (unsigned long long)p; unsigned lo = __builtin_amdgcn_readfirstlane((unsigned)v), hi = __builtin_amdgcn_readfirstlane((unsigned)(v >> 32));
    asm volatile("" : "+s"(lo), "+s"(hi)); return (Tp*)(GAS Tp*)(((unsigned long long)hi << 32) | lo); }
__device__ __forceinline__ int uni_int(int x) { x = __builtin_amdgcn_readfirstlane(x); asm volatile("" : "+s"(x)); return x; }
#define LDS_WAIT() asm volatile("s_waitcnt lgkmcnt(0)" ::: "memory")
#define VM_WAIT() asm volatile("s_waitcnt vmcnt(0)" ::: "memory")
#define LDS_BAR() do { asm volatile("s_waitcnt lgkmcnt(0)" ::: "memory"); __builtin_amdgcn_s_barrier(); asm volatile("" ::: "memory"); } while (0)
#define WG_BAR() do { asm volatile("s_waitcnt vmcnt(0) lgkmcnt(0)" ::: "memory"); __builtin_amdgcn_s_barrier(); asm volatile("" ::: "memory"); } while (0)

__device__ __forceinline__ unsigned off_b(unsigned row, unsigned ch) { return 256u * row + 16u * (ch ^ (((row & 3) << 2) | ((row >> 2) & 3))); }
__device__ __forceinline__ unsigned row_read_addr(unsigned rowbase, unsigned lane, unsigned s) { return off_b(rowbase + (lane & 31), 2 * s + (lane >> 5)); }
__device__ __forceinline__ unsigned tr_read_addr(unsigned lane, unsigned c, unsigned ks, unsigned t) {
    const unsigned h = lane >> 5, blk = (lane >> 4) & 1, q = (lane & 15) >> 2, p = lane & 3;
    return off_b(16 * ks + 8 * h + 4 * t + q, 4 * c + 2 * blk + (p >> 1)) + 8 * (p & 1);
}
typedef short v4i16_t __attribute__((ext_vector_type(4)));
__device__ __forceinline__ s16x4 ldstr(LAS const unsigned char* p) { return __builtin_bit_cast(s16x4, __builtin_amdgcn_ds_read_tr16_b64_v4i16((LAS v4i16_t*)p)); }
__device__ __forceinline__ bf16x8 tr_frag(LAS const unsigned char* tile, unsigned lane, unsigned c, unsigned ks) {
    const s16x4 a = ldstr(tile + tr_read_addr(lane, c, ks, 0)), b = ldstr(tile + tr_read_addr(lane, c, ks, 1));
    return (bf16x8){a[0], a[1], a[2], a[3], b[0], b[1], b[2], b[3]};
}
__device__ __forceinline__ int crow(int r, int hi) { return (r & 3) + 8 * (r >> 2) + 4 * hi; }

#define XB_TMO      128
#define XB_XCNT(j)  (256  + 64 * (j))
#define XB_XSUB(j)  (1280 + 64 * (j))
#define XB_XGEN(j)  (2304 + 64 * (j))
#define XB_TOP      3328
#define XB_TOPGEN   3392
#define XCD_BAR_WORDS 3456
#define XB_SPIN_CAP (1u << 22)
__device__ __forceinline__ unsigned xb_ld(unsigned* p)              { return __hip_atomic_load(p, __ATOMIC_RELAXED, __HIP_MEMORY_SCOPE_AGENT); }
__device__ __forceinline__ unsigned xb_add(unsigned* p, unsigned v) { return __hip_atomic_fetch_add(p, v, __ATOMIC_RELAXED, __HIP_MEMORY_SCOPE_AGENT); }
__device__ __forceinline__ unsigned xb_xcc_id() { return (unsigned)__builtin_amdgcn_s_getreg((3 << 11) | 20) & 0xFu; }
#define XB_SPIN(cond, bar) do { unsigned _sp = 0; while (cond) { __builtin_amdgcn_s_sleep(1); \
    if ((++_sp & 255u) == 0u) { if (xb_ld(&(bar)[XB_TMO])) break; if (_sp > XB_SPIN_CAP) { atomicAdd(&(bar)[XB_TMO], 1u); break; } } } } while (0)
struct XcdBarrier { unsigned* bar; unsigned x; volatile LAS unsigned* st; };
__device__ __forceinline__ XcdBarrier xcd_barrier_post(unsigned* bar, volatile LAS unsigned* st) {
    XcdBarrier b; b.bar = bar; b.x = xb_xcc_id(); b.st = st;
    if (cur_tid() == 0) (void)xb_add(&bar[XB_XCNT(b.x)], 1u);
    return b;
}
__device__ __forceinline__ void xcd_barrier_complete(unsigned* bar, unsigned x, unsigned& nloc, unsigned& nx) {
    const unsigned G = gridDim.x * gridDim.y * gridDim.z;
    unsigned sum, cnt, mine, sp = 0u;
    for (;;) {
        sum = 0u; cnt = 0u; mine = 0u;
#pragma unroll 1
        for (unsigned j = 0; j < 16; ++j) { const unsigned c = xb_ld(&bar[XB_XCNT(j)]); sum += c; cnt += (c > 0u) ? 1u : 0u; mine = (j == x) ? c : mine; }
        if (sum == G) break;
        __builtin_amdgcn_s_sleep(1);
        if ((++sp & 255u) == 0u) { if (xb_ld(&bar[XB_TMO])) break; if (sp > XB_SPIN_CAP) { atomicAdd(&bar[XB_TMO], 1u); break; } }
    }
    nloc = mine > 0u ? mine : 1u; nx = cnt > 0u ? cnt : 1u;
}
__device__ __attribute__((noinline)) void xcd_barrier(const XcdBarrier b) {
    asm volatile("s_waitcnt vmcnt(0)" ::: "memory");
    __syncthreads();
    if (cur_tid() == 0) {
        unsigned* bar = uni_ptr(b.bar);
        __builtin_amdgcn_s_waitcnt(0);
        unsigned nloc = b.st[0], nx = b.st[1];
        if (nloc == 0u) { xcd_barrier_complete(bar, b.x, nloc, nx); b.st[0] = nloc; b.st[1] = nx; }
        const unsigned old = xb_add(&bar[XB_XSUB(b.x)], 1u);
        const unsigned gen = old / nloc;
        if (old + 1u == (gen + 1u) * nloc) {
            __builtin_amdgcn_fence(__ATOMIC_RELEASE, "agent");
            asm volatile("s_waitcnt vmcnt(0)" ::: "memory");
            const unsigned og = xb_add(&bar[XB_TOP], 1u);
            const unsigned tg = og / nx;
            if (og + 1u == (tg + 1u) * nx) xb_add(&bar[XB_TOPGEN], 1u);
            else XB_SPIN(xb_ld(&bar[XB_TOPGEN]) == tg, bar);
            __builtin_amdgcn_fence(__ATOMIC_ACQUIRE, "agent");
            xb_add(&bar[XB_XGEN(b.x)], 1u);
            asm volatile("s_waitcnt vmcnt(0)" ::: "memory");
        } else {
            XB_SPIN(xb_ld(&bar[XB_XGEN(b.x)]) == gen, bar);
            __builtin_amdgcn_fence(__ATOMIC_ACQUIRE, "agent");
            asm volatile("s_waitcnt vmcnt(0)" ::: "memory");
        }
    }
    __syncthreads();
}

namespace ge {
constexpr int BM = 256, BK = 64, HALF = 128, HTB = HALF * BK * 2, STAGE_BYTES = 8 * HTB, NXCD = 8, WGM = 8;
__device__ __forceinline__ int lds_byte(int r, int c) { const int st = (r >> 4) * 2 + (c >> 5), rr = r & 15, cc = c & 31, ob = rr * 64 + cc * 2; return st * 1024 + (ob ^ (((ob >> 9) & 1) << 5)); }
__device__ __forceinline__ void stage_rc(int b, int& R, int& C) { const int st = b / 1024, sb = b % 1024, swz = sb ^ (((sb >> 9) & 1) << 5); R = (st >> 1) * 16 + swz / 64; C = (st & 1) * 32 + (swz % 64) / 2; }
__device__ __forceinline__ int perm32(int rho) { const int n = rho >> 4, i = rho & 15; return 8 * (i >> 2) + 4 * n + (i & 3); }
struct GU { const char* A; const char* B; int pm, pn, x0; };
typedef f32x4 Acc[2][2][4][2];
struct StaticOrder {
    int nM, nN, nwg, G, c;
    __device__ __forceinline__ void init(int M, int N, int G_, int c_) { nM = M / BM; nN = N / BM; nwg = nM * nN; G = G_; c = c_; }
    __device__ __forceinline__ bool next(int i, int& pm, int& pn) const {
        const long L = (long)i * G + c; if (L >= nwg) return false;
        int wgid = (int)L; { const int q = nwg / NXCD, r = nwg % NXCD, xcd = wgid % NXCD, off = wgid / NXCD; wgid = (xcd < r ? xcd * (q + 1) : r * (q + 1) + (xcd - r) * q) + off; }
        const int nig = WGM * nN, gid = wgid / nig, fm = gid * WGM, gsz = (nM - fm) < WGM ? (nM - fm) : WGM;
        pm = fm + ((wgid % nig) % gsz); pn = (wgid % nig) / gsz; return true;
    }
};

template <class P>
__device__ __forceinline__ void gemm_phase(LAS unsigned char* lds, const P& p) {
    int tid_ = cur_tid(); asm volatile("" : "+v"(tid_));
    const int tid = tid_, wid = __builtin_amdgcn_readfirstlane(tid >> 6), lane = tid & 63, wr = wid >> 2, wc = wid & 3, fr = lane & 15, fq = lane >> 4;
    const int K = p.K, nt = K / BK;
    int Rp[2], Cp[2]; unsigned voffB[2];
#pragma unroll
    for (int i = 0; i < 2; ++i) { int R, C; stage_rc(tid * 16 + i * 8192, R, C); Rp[i] = R; Cp[i] = C; const int Rb = (R & ~31) + perm32(R & 31); voffB[i] = (unsigned)(Rb * K + C) * 2u; }
    const size_t kstep = (size_t)(BK * 2);
    const size_t hstepB = (size_t)HALF * K * 2;
    const unsigned ldsw = (unsigned)wid * 1024u;
    const int aoff = lds_byte(wr * 64 + fr, fq * 8), boff = lds_byte(wc * 32 + fr, fq * 8);
#define PG8_SA(b, h) (((b) * 2 + (h)) * HTB)
#define PG8_SB(b, h) ((4 + (b) * 2 + (h)) * HTB)
#define PG8_STAGE(bufoff, gbase, voff) do { _Pragma("unroll") for (int _i = 0; _i < 2; ++_i) \
        __builtin_amdgcn_global_load_lds((const unsigned*)((const char*)(gbase) + (voff)[_i]), (LAS unsigned*)(lds + (bufoff) + ldsw + _i * 8192), 16, 0, 0); } while (0)
#define PG8_LDA(dst, b, h) do { _Pragma("unroll") for (int m = 0; m < 4; ++m) _Pragma("unroll") for (int k = 0; k < 2; ++k) dst[m][k] = *(const LAS bf16x8*)(lds + PG8_SA(b, h) + aoff + m * 2048 + k * 1024); } while (0)
#define PG8_LDB(dst, b, h) do { _Pragma("unroll") for (int n = 0; n < 2; ++n) _Pragma("unroll") for (int k = 0; k < 2; ++k) dst[n][k] = *(const LAS bf16x8*)(lds + PG8_SB(b, h) + boff + n * 2048 + k * 1024); } while (0)
#define PG8_MMA(ai, bj, At, Bt) do { __builtin_amdgcn_s_setprio(1); _Pragma("unroll") for (int m = 0; m < 4; ++m) _Pragma("unroll") for (int n = 0; n < 2; ++n) _Pragma("unroll") for (int k = 0; k < 2; ++k) \
        acc[ai][bj][m][n] = __builtin_amdgcn_mfma_f32_16x16x32_bf16(Bt[n][k], At[m][k], acc[ai][bj][m][n], 0, 0, 0); __builtin_amdgcn_s_setprio(0); } while (0)
#define PG8_WAIT_V(n) asm volatile("s_waitcnt vmcnt(" #n ")" ::: "memory")
#define PG8_WAIT_L(n) asm volatile("s_waitcnt lgkmcnt(" #n ")" ::: "memory")
#define PG8_BAR __builtin_amdgcn_s_barrier()
#define PG8_SCHED __builtin_amdgcn_sched_barrier(0)
    GU cur, nxt; int ui = 0;
    if (!p.next(0, cur)) return;
    Acc acc;
#pragma unroll
    for (int a = 0; a < 2; ++a)
#pragma unroll
        for (int b = 0; b < 2; ++b)
#pragma unroll
            for (int m = 0; m < 4; ++m)
#pragma unroll
                for (int n = 0; n < 2; ++n) acc[a][b][m][n] = (f32x4){0.f, 0.f, 0.f, 0.f};
    bf16x8 At[4][2], B0[2][2], B1[2][2];
    unsigned vA[2][2], vN[2][2];
    p.rowoff(cur, Rp, Cp, vA);
    const char* cA = cur.A; const char* cB = cur.B;
    PG8_STAGE(PG8_SB(0, 0), cB, voffB); PG8_STAGE(PG8_SB(0, 1), cB + hstepB, voffB); PG8_STAGE(PG8_SA(0, 0), cA, vA[0]); PG8_STAGE(PG8_SA(0, 1), cA, vA[1]);
    if (wr == 1) PG8_BAR;
    PG8_WAIT_V(2); PG8_BAR;
    PG8_STAGE(PG8_SB(1, 0), cB + kstep, voffB); PG8_STAGE(PG8_SA(1, 0), cA + kstep, vA[0]); PG8_STAGE(PG8_SB(1, 1), cB + hstepB + kstep, voffB);
    PG8_WAIT_V(6); PG8_BAR;
    for (;;) {
        const bool has_next = p.next(ui + 1, nxt);
        if (has_next) p.rowoff(nxt, Rp, Cp, vN);
        else {
#pragma unroll
            for (int h = 0; h < 2; ++h)
#pragma unroll
                for (int i = 0; i < 2; ++i) vN[h][i] = vA[h][i]; }
        const char* nA = has_next ? nxt.A : cA; const char* nB = has_next ? nxt.B : cB;
        for (int t = 0; t < nt; t += 2) {
            const bool last = (t == nt - 2);
            const char* a1 = cA + (size_t)(t + 1) * kstep;
            const char* a2 = last ? nA : cA + (size_t)(t + 2) * kstep; const char* b2 = last ? nB : cB + (size_t)(t + 2) * kstep;
            const char* a3 = a2 + kstep; const char* b3 = b2 + kstep;
            unsigned v2[2][2];
#pragma unroll
            for (int h = 0; h < 2; ++h)
#pragma unroll
                for (int i = 0; i < 2; ++i) v2[h][i] = last ? vN[h][i] : vA[h][i];
            PG8_LDB(B0, 0, 0); PG8_LDB(B1, 0, 1); PG8_SCHED; PG8_LDA(At, 0, 0); PG8_STAGE(PG8_SA(1, 1), a1, vA[1]);
            PG8_WAIT_V(8); PG8_WAIT_L(0); PG8_BAR; PG8_MMA(0, 0, At, B0); PG8_MMA(0, 1, At, B1); PG8_BAR; PG8_SCHED;
            PG8_LDA(At, 0, 1); PG8_STAGE(PG8_SB(0, 0), b2, voffB); PG8_STAGE(PG8_SB(0, 1), b2 + hstepB, voffB); PG8_STAGE(PG8_SA(0, 0), a2, v2[0]);
            PG8_WAIT_V(8); PG8_WAIT_L(0); PG8_BAR; PG8_MMA(1, 0, At, B0); PG8_MMA(1, 1, At, B1); PG8_BAR; PG8_SCHED;
            PG8_LDB(B0, 1, 0); PG8_LDB(B1, 1, 1); PG8_SCHED; PG8_LDA(At, 1, 0); PG8_STAGE(PG8_SA(0, 1), a2, v2[1]);
            PG8_WAIT_V(8); PG8_WAIT_L(0); PG8_BAR; PG8_MMA(0, 0, At, B0); PG8_MMA(0, 1, At, B1); PG8_BAR; PG8_SCHED;
            PG8_LDA(At, 1, 1); PG8_STAGE(PG8_SB(1, 0), b3, voffB); PG8_STAGE(PG8_SB(1, 1), b3 + hstepB, voffB); PG8_STAGE(PG8_SA(1, 0), a3, v2[0]);
            PG8_WAIT_V(8); PG8_WAIT_L(0); PG8_BAR; PG8_MMA(1, 0, At, B0); PG8_MMA(1, 1, At, B1); PG8_BAR; PG8_SCHED;
        }
        if (wr == 0) PG8_BAR;
        p.epi(acc, cur, wr, wc, fr, fq);
        if (!has_next) break;
#pragma unroll
        for (int a = 0; a < 2; ++a)
#pragma unroll
            for (int b = 0; b < 2; ++b)
#pragma unroll
                for (int m = 0; m < 4; ++m)
#pragma unroll
                    for (int n = 0; n < 2; ++n) acc[a][b][m][n] = (f32x4){0.f, 0.f, 0.f, 0.f};
        cur = nxt; cA = nA; cB = nB; ++ui;
#pragma unroll
        for (int h = 0; h < 2; ++h)
#pragma unroll
            for (int i = 0; i < 2; ++i) vA[h][i] = vN[h][i];
        if (wr == 1) PG8_BAR;
    }
    PG8_WAIT_V(0);
    PG8_BAR;
#undef PG8_SA
#undef PG8_SB
#undef PG8_STAGE
#undef PG8_LDA
#undef PG8_LDB
#undef PG8_MMA
#undef PG8_WAIT_V
#undef PG8_WAIT_L
#undef PG8_BAR
#undef PG8_SCHED
}

template <class Epi> struct Dense {
    const bf16* A; const bf16* Bt; int lda, K; StaticOrder S; Epi E;
    __device__ __forceinline__ bool next(int i, GU& u) const {
        int pm, pn; if (!S.next(i, pm, pn)) return false;
        u.pm = pm; u.pn = pn; u.x0 = 0; u.A = (const char*)A + (size_t)pm * BM * lda * 2; u.B = (const char*)Bt + (size_t)pn * BM * K * 2; return true;
    }
    __device__ __forceinline__ void rowoff(const GU&, const int (&R)[2], const int (&C)[2], unsigned (&v)[2][2]) const {
#pragma unroll
        for (int h = 0; h < 2; ++h)
#pragma unroll
            for (int i = 0; i < 2; ++i) v[h][i] = (unsigned)((h * HALF + R[i]) * lda + C[i]) * 2u;
    }
    __device__ __forceinline__ void epi(const Acc& acc, const GU& u, int wr, int wc, int fr, int fq) const {
        const int row0 = u.pm * BM + wr * 64 + fr, col0 = u.pn * BM + wc * 32 + 8 * fq;
        E.unit(acc, u, row0, col0);
    }
};
}

struct Frame {
    LAS unsigned char* lds;
    gu32* ctl;
    int tid, lane, wave, G, vcu;
    unsigned char* ws;
    float* out;
    const void* const* in;
};

__device__ __forceinline__ void frame_refresh(Frame& F) {
    int t = cur_tid(); asm volatile("" : "+v"(t)); F.tid = t; F.lane = t & 63; F.wave = __builtin_amdgcn_readfirstlane(t >> 6);
    F.ws = uni_ptr(F.ws); F.ctl = (gu32*)(F.ws + WS_CTL); F.G = uni_int(F.G); F.vcu = uni_int(F.vcu); F.out = uni_ptr(F.out);
}
template <class F> __device__ __forceinline__ void epi_rows(const ge::Acc& acc, int row0, int col0, F f) {
#pragma unroll
    for (int ai = 0; ai < 2; ++ai)
#pragma unroll
        for (int m = 0; m < 4; ++m)
        {
#pragma unroll
            for (int bj = 0; bj < 2; ++bj) f(row0 + ai * 128 + m * 16, col0 + bj * 128, acc[ai][bj][m][0], acc[ai][bj][m][1]);
            asm volatile("" ::: "memory"); }
}
template <class LD, class US> __device__ __forceinline__ void epi_rows_pf(const ge::Acc& acc, int row0, int col0, LD ld, US us) {
#pragma unroll
    for (int ai = 0; ai < 2; ++ai) {
        decltype(ld(0, 0)) pre[4][2];
#pragma unroll
        for (int m = 0; m < 4; ++m)
#pragma unroll
            for (int bj = 0; bj < 2; ++bj) pre[m][bj] = ld(row0 + ai * 128 + m * 16, col0 + bj * 128);
#pragma unroll
        for (int m = 0; m < 4; ++m)
#pragma unroll
            for (int bj = 0; bj < 2; ++bj) us(row0 + ai * 128 + m * 16, col0 + bj * 128, acc[ai][bj][m][0], acc[ai][bj][m][1], pre[m][bj]);
        asm volatile("" ::: "memory"); }
}
struct Pre2 { u32x4 a, b; };
__device__ __forceinline__ u32x4 pack8(f32x4 a, f32x4 b) { u32x4 w; w.x = pk2(a[0], a[1]); w.y = pk2(a[2], a[3]); w.z = pk2(b[0], b[1]); w.w = pk2(b[2], b[3]); return w; }
__device__ __forceinline__ void unpack8(u32x4 w, f32x4& a, f32x4& b) { a = (f32x4){bflo(w.x), bfhi(w.x), bflo(w.y), bfhi(w.y)}; b = (f32x4){bflo(w.z), bfhi(w.z), bflo(w.w), bfhi(w.w)}; }

struct EpiProj {
    bf16* proj; float* dtraw;
    __device__ __forceinline__ void unit(const ge::Acc& acc, const ge::GU& u, int row0, int col0) const {
        epi_rows(acc, row0, col0, [&](int row, int col, f32x4 a, f32x4 b) {
            *(u32x4*)(proj + (size_t)row * NPAD + col) = pack8(a, b);
            if (col >= CDT && col < CDT + 16) { float* d = dtraw + (size_t)row * 16 + (col - CDT); *(f32x4*)d = a; *(f32x4*)(d + 4) = b; }
        });
    }
};
struct EpiQ {
    bf16* Q; const float* rc; const float* rs;
    __device__ __forceinline__ void unit(const ge::Acc& acc, const ge::GU& u, int row0, int col0) const {
        const int fq = lane_id() >> 4;
        epi_rows(acc, row0, col0, [&](int row, int col, f32x4 a, f32x4 b) {
            const int cg = col & ~31;
            if ((cg % 96) == 64) {
                const int i0 = 8 * (fq & 1);
#pragma unroll
                for (int hf = 0; hf < 2; ++hf) {
                    f32x4& x = hf ? b : a;
                    const f32x4 c = *(const f32x4*)(rc + (size_t)row * 16 + i0 + 4 * hf), sn = *(const f32x4*)(rs + (size_t)row * 16 + i0 + 4 * hf);
                    f32x4 y;
#pragma unroll
                    for (int e = 0; e < 4; ++e) y[e] = __shfl_xor(x[e], 32);
                    x = (fq < 2) ? (x * c - y * sn) : (y * sn + x * c);
                }
            }
            *(u32x4*)(Q + (size_t)row * 768 + col) = pack8(a * QSCALE, b * QSCALE);
        });
    }
};
struct EpiStoreBf16 {
    bf16* O; int ld;
    __device__ __forceinline__ void unit(const ge::Acc& acc, const ge::GU& u, int row0, int col0) const {
        epi_rows(acc, row0, col0, [&](int row, int col, f32x4 a, f32x4 b) { *(u32x4*)(O + (size_t)row * ld + col) = pack8(a, b); });
    }
};
struct EpiGate {
    bf16* mb; const bf16* proj; int gcol0; int add;
    __device__ __forceinline__ void unit(const ge::Acc& acc, const ge::GU& u, int row0, int col0) const {
        epi_rows_pf(acc, row0, col0,
            [&](int row, int col) { Pre2 r; r.a = *(const u32x4*)(proj + (size_t)row * NPAD + gcol0 + col); r.b = r.a; if (add) r.b = *(const u32x4*)(mb + (size_t)row * D + col); return r; },
            [&](int row, int col, f32x4 a, f32x4 b, const Pre2& pr) {
            f32x4 g0, g1; unpack8(pr.a, g0, g1);
#pragma unroll
            for (int e = 0; e < 4; ++e) { a[e] *= sigmoidf_(g0[e]); b[e] *= sigmoidf_(g1[e]); }
            bf16* o = mb + (size_t)row * D + col;
            if (add) { f32x4 p0, p1; unpack8(pr.b, p0, p1); a += p0; b += p1; }
            *(u32x4*)o = pack8(a, b);
        });
    }
};
struct EpiWo {
    bf16* pre; const bf16* h;
    __device__ __forceinline__ void unit(const ge::Acc& acc, const ge::GU& u, int row0, int col0) const {
        epi_rows_pf(acc, row0, col0, [&](int row, int col) { return *(const u32x4*)(h + (size_t)row * D + col); },
            [&](int row, int col, f32x4 a, f32x4 b, const u32x4& hw) {
            f32x4 h0, h1; unpack8(hw, h0, h1);
            *(u32x4*)(pre + (size_t)row * D + col) = pack8(h0 * ALPHA + a, h1 * ALPHA + b);
        });
    }
};
struct EpiCat {
    float* logits; bf16* shhid; bf16* sg;
    __device__ __forceinline__ void unit(const ge::Acc& acc, const ge::GU& u, int row0, int col0) const {
        if (u.pn == 0) {
            epi_rows(acc, row0, col0, [&](int row, int col, f32x4 a, f32x4 b) { float* o = logits + (size_t)row * 256 + col; *(f32x4*)o = a; *(f32x4*)(o + 4) = b; });
        } else if (u.pn <= 2) {
            const int hc = (u.pn - 1) * 128 + (col0 & 127);
#pragma unroll
            for (int ai = 0; ai < 2; ++ai)
#pragma unroll
                for (int m = 0; m < 4; ++m) {
                    f32x4 g0 = acc[ai][0][m][0], g1 = acc[ai][0][m][1], u0 = acc[ai][1][m][0], u1 = acc[ai][1][m][1];
#pragma unroll
                    for (int e = 0; e < 4; ++e) { g0[e] = siluf_(g0[e]) * u0[e]; g1[e] = siluf_(g1[e]) * u1[e]; }
                    *(u32x4*)(shhid + (size_t)(row0 + ai * 128 + m * 16) * 256 + hc) = pack8(g0, g1);
                }
        } else {
            epi_rows(acc, row0, col0, [&](int row, int col, f32x4 a, f32x4 b) {
#pragma unroll
                for (int e = 0; e < 4; ++e) { a[e] = sigmoidf_(a[e]); b[e] = sigmoidf_(b[e]); }
                *(u32x4*)(sg + (size_t)row * D + (col - 768)) = pack8(a, b);
            });
        }
    }
};
struct EpiPle {
    bf16* base; const bf16* h; const bf16* sg;
    __device__ __forceinline__ void unit(const ge::Acc& acc, const ge::GU& u, int row0, int col0) const {
        epi_rows_pf(acc, row0, col0, [&](int row, int col) { Pre2 r; r.a = *(const u32x4*)(sg + (size_t)row * D + col); r.b = *(const u32x4*)(h + (size_t)row * D + col); return r; },
            [&](int row, int col, f32x4 a, f32x4 b, const Pre2& pr) {
            f32x4 g0, g1; unpack8(pr.a, g0, g1);
            f32x4 h0, h1; unpack8(pr.b, h0, h1);
            *(u32x4*)(base + (size_t)row * D + col) = pack8(h0 * ALPHA + a * g0, h1 * ALPHA + b * g1);
        });
    }
};
struct EpiAddF32 {
    bf16* base;
    __device__ __forceinline__ void unit(const ge::Acc& acc, const ge::GU& u, int row0, int col0) const {
        epi_rows_pf(acc, row0, col0, [&](int row, int col) { return *(const u32x4*)(base + (size_t)row * D + col); },
            [&](int row, int col, f32x4 a, f32x4 b, const u32x4& pw) {
            bf16* o = base + (size_t)row * D + col; f32x4 p0, p1; unpack8(pw, p0, p1);
            *(u32x4*)o = pack8(p0 + a, p1 + b);
        });
    }
};

__device__ __forceinline__ int find_expert(const LAS int* toff, int j) {
    int lo = 0, hi = NEXP;
    while (hi - lo > 1) { const int mid = (lo + hi) >> 1; if (toff[mid] <= j) lo = mid; else hi = mid; }
    return lo;
}
struct MoeGU {
    const bf16* hb; const bf16* wgu; const int* stok; bf16* hid; const LAS int* toff; int G, c, K;
    __device__ __forceinline__ bool next(int i, ge::GU& u) const {
        const int L = i * G + c, ntile = toff[NEXP]; if (L >= ntile * 2) return false;
        const int j = L >> 1, pn = L & 1, e = find_expert(toff, j);
        u.pm = j; u.pn = pn; u.x0 = e; u.A = (const char*)hb; u.B = (const char*)wgu + ((size_t)e * 512 + pn * 256) * 1024 * 2; return true;
    }
    __device__ __forceinline__ void rowoff(const ge::GU& u, const int (&R)[2], const int (&C)[2], unsigned (&v)[2][2]) const {
#pragma unroll
        for (int h = 0; h < 2; ++h)
#pragma unroll
            for (int i = 0; i < 2; ++i) v[h][i] = (unsigned)(stok[u.pm * 256 + h * 128 + R[i]] * D + C[i]) * 2u;
    }
    __device__ __forceinline__ void epi(const ge::Acc& acc, const ge::GU& u, int wr, int wc, int fr, int fq) const {
        const int slot0 = u.pm * 256 + wr * 64 + fr, hc = u.pn * 128 + wc * 32 + 8 * fq;
#pragma unroll
        for (int ai = 0; ai < 2; ++ai)
#pragma unroll
            for (int m = 0; m < 4; ++m) {
                f32x4 g0 = acc[ai][0][m][0], g1 = acc[ai][0][m][1], u0 = acc[ai][1][m][0], u1 = acc[ai][1][m][1];
#pragma unroll
                for (int e = 0; e < 4; ++e) { g0[e] = siluf_(g0[e]) * u0[e]; g1[e] = siluf_(g1[e]) * u1[e]; }
                *(u32x4*)(hid + (size_t)(slot0 + ai * 128 + m * 16) * 256 + hc) = pack8(g0, g1);
            }
    }
};
struct MoeDown {
    const bf16* hid; const bf16* wd; const float* sw; unsigned char* Y; const LAS int* toff; int G, c, K;
    __device__ __forceinline__ bool next(int i, ge::GU& u) const {
        const int L = i * G + c, ntile = toff[NEXP]; if (L >= ntile * 4) return false;
        const int j = L >> 2, pn = L & 3, e = find_expert(toff, j);
        u.pm = j; u.pn = pn; u.x0 = e; u.A = (const char*)hid + (size_t)j * 256 * 256 * 2; u.B = (const char*)wd + ((size_t)e * 1024 + pn * 256) * 256 * 2; return true;
    }
    __device__ __forceinline__ void rowoff(const ge::GU&, const int (&R)[2], const int (&C)[2], unsigned (&v)[2][2]) const {
#pragma unroll
        for (int h = 0; h < 2; ++h)
#pragma unroll
            for (int i = 0; i < 2; ++i) v[h][i] = (unsigned)((h * 128 + R[i]) * 256 + C[i]) * 2u;
    }
    __device__ __forceinline__ void epi(const ge::Acc& acc, const ge::GU& u, int wr, int wc, int fr, int fq) const {
        const int slot0 = u.pm * 256 + wr * 64 + fr, col0 = u.pn * 256 + wc * 32 + 8 * fq;
#pragma unroll
        for (int ai = 0; ai < 2; ++ai)
#pragma unroll
            for (int m = 0; m < 4; ++m) { const int slot = slot0 + ai * 128 + m * 16;
#pragma unroll
                for (int bj = 0; bj < 2; ++bj) { const f32x4 a = acc[ai][bj][m][0] * YSCALE, bq = acc[ai][bj][m][1] * YSCALE;
                    int w0 = __builtin_amdgcn_cvt_pk_fp8_f32(a[0], a[1], 0, false); w0 = __builtin_amdgcn_cvt_pk_fp8_f32(a[2], a[3], w0, true);
                    int w1 = __builtin_amdgcn_cvt_pk_fp8_f32(bq[0], bq[1], 0, false); w1 = __builtin_amdgcn_cvt_pk_fp8_f32(bq[2], bq[3], w1, true);
                    *(u32x2*)(Y + (size_t)slot * D + col0 + bj * 128) = (u32x2){(unsigned)w0, (unsigned)w1}; } }
    }
};

__device__ __forceinline__ void transpose_item(const float* W, int ld, int K, int nvalid, int col0, bf16* WT, int dst_row, int kb, LAS float* scr, int lane) {
    const int k0 = 64 * kb, n4 = lane & 7, kq = lane >> 3, cc = col0 + 4 * n4; const bool ok = cc < nvalid;
    const float* src = W + (size_t)(k0 + kq) * ld + cc;
    f32x4 v[8];
#pragma unroll
    for (int i = 0; i < 8; ++i) v[i] = ok ? *(const f32x4*)(src + (size_t)(8 * i) * ld) : (f32x4){0.f, 0.f, 0.f, 0.f};
#pragma unroll
    for (int i = 0; i < 8; ++i) { LAS float* d = scr + (8 * i + kq) * 33 + 4 * n4; d[0] = v[i][0]; d[1] = v[i][1]; d[2] = v[i][2]; d[3] = v[i][3]; }
    LDS_WAIT(); asm volatile("" ::: "memory");
    const int c = lane & 7;
#pragma unroll
    for (int j = 0; j < 4; ++j) { const int n = (lane >> 3) + 8 * j; const LAS float* s_ = scr + (8 * c) * 33 + n;
        u32x4 o; o.x = pk2(s_[0 * 33], s_[1 * 33]); o.y = pk2(s_[2 * 33], s_[3 * 33]); o.z = pk2(s_[4 * 33], s_[5 * 33]); o.w = pk2(s_[6 * 33], s_[7 * 33]);
        *(u32x4*)(WT + (size_t)(dst_row + n) * K + k0 + 8 * c) = o; }
    LDS_WAIT(); asm volatile("" ::: "memory");
}
#define TJOB(src_, ld_, K_, nvalid_, nrows_, dst_) { const int ni_ = ((K_) / 64) * ((nrows_) / 32); if (r < ni_) { const int nbk_ = (nrows_) / 32; \
        transpose_item((src_), (ld_), (K_), (nvalid_), 32 * (r % nbk_), (dst_), 32 * (r % nbk_), r / nbk_, scr, F.lane); continue; } r -= ni_; }
constexpr int ITEMS_SMALL = 16 * 168 + 6 * 24 + 4 * 32 + 8 * 32 + 16 * 32 + 16 * 32 + 16 * (8 + 4 * 4 + 32) + 4 * 32 + 4 * 32;
constexpr int ITEMS_EXP = NEXP * 384;
__device__ __forceinline__ void p0_small_weights(Frame& F) {
    LAS float* scr = (LAS float*)(F.lds + RING_OFF + F.wave * 16384);
    const int gw = F.vcu * NWAVES + F.wave, NGW = F.G * NWAVES;
    for (int it = gw; it < DEPTH * ITEMS_SMALL; it += NGW) {
        const int L = it / ITEMS_SMALL; int r = it % ITEMS_SMALL;
        unsigned char* wl = F.ws + WS_WSM + (size_t)L * WSM_LAYER;
        const float* w_in = (const float*)F.in[3] + (size_t)L * 1024 * NCOLS;
        TJOB(w_in, NCOLS, 1024, NCOLS, NPAD, (bf16*)(wl + WO_WIN));
        TJOB((const float*)F.in[5] + (size_t)L * 384 * 768, 768, 384, 768, 768, (bf16*)(wl + WO_WQ));
        TJOB((const float*)F.in[7] + (size_t)L * 256 * 1024, 1024, 256, 1024, 1024, (bf16*)(wl + WO_WKV));
        TJOB((const float*)F.in[14] + (size_t)L * 512 * 1024, 1024, 512, 1024, 1024, (bf16*)(wl + WO_WAB));
        TJOB((const float*)F.in[15] + (size_t)L * 1024 * 1024, 1024, 1024, 1024, 1024, (bf16*)(wl + WO_WSB));
        TJOB((const float*)F.in[16] + (size_t)L * 1024 * 1024, 1024, 1024, 1024, 1024, (bf16*)(wl + WO_WO));
        bf16* wcat = (bf16*)(wl + WO_WCAT);
        const float* shg = (const float*)F.in[24] + (size_t)L * 1024 * 256; const float* shu = (const float*)F.in[25] + (size_t)L * 1024 * 256;
        TJOB((const float*)F.in[19] + (size_t)L * 1024 * 256, 256, 1024, 256, 256, wcat);
        TJOB(shg, 256, 1024, 128, 128, wcat + (size_t)256 * 1024);
        TJOB(shu, 256, 1024, 128, 128, wcat + (size_t)384 * 1024);
        TJOB(shg + 128, 256, 1024, 128, 128, wcat + (size_t)512 * 1024);
        TJOB(shu + 128, 256, 1024, 128, 128, wcat + (size_t)640 * 1024);
        TJOB((const float*)F.in[28] + (size_t)L * 1024 * 1024, 1024, 1024, 1024, 1024, wcat + (size_t)768 * 1024);
        TJOB((const float*)F.in[26] + (size_t)L * 256 * 1024, 1024, 256, 1024, 1024, (bf16*)(wl + WO_WSD));
        TJOB((const float*)F.in[27] + (size_t)L * 256 * 1024, 1024, 256, 1024, 1024, (bf16*)(wl + WO_WPLE));
    }
}
__device__ __forceinline__ void p0_expert_weights(Frame& F, int L) {
    LAS float* scr = (LAS float*)(F.lds + RING_OFF + F.wave * 16384);
    int lane_ = F.lane; asm volatile("" : "+v"(lane_));
    const int gw = F.vcu * NWAVES + F.wave, NGW = F.G * NWAVES, lane = lane_, n4 = lane & 7, kq = lane >> 3;
    const float* wg = (const float*)F.in[21] + (size_t)L * NEXP * 1024 * 256; const float* wu = (const float*)F.in[22] + (size_t)L * NEXP * 1024 * 256;
    const float* wd = (const float*)F.in[23] + (size_t)L * NEXP * 256 * 1024;
    bf16* wgu_t = (bf16*)(F.ws + WS_WGU + (size_t)L * WGU_LAYER); bf16* wd_t = (bf16*)(F.ws + WS_WD + (size_t)L * WD_LAYER);
#define TP_DECODE(it_, SRC, LD, DST, KK) do { const int e_ = (it_) / 384, r_ = (it_) % 384, which_ = r_ >> 7, rr_ = r_ & 127; \
        if (which_ < 2) { const int kb_ = rr_ >> 3, nb_ = rr_ & 7; LD = 256; KK = 1024; \
            SRC = (which_ ? wu : wg) + (size_t)e_ * 1024 * 256 + (size_t)(64 * kb_ + kq) * 256 + 32 * nb_ + 4 * n4; \
            DST = wgu_t + (size_t)e_ * 512 * 1024 + (size_t)((nb_ >> 2) * 256 + which_ * 128 + 32 * (nb_ & 3)) * 1024 + 64 * kb_; } \
        else { const int kb_ = rr_ >> 5, nb_ = rr_ & 31; LD = 1024; KK = 256; \
            SRC = wd + (size_t)e_ * 256 * 1024 + (size_t)(64 * kb_ + kq) * 1024 + 32 * nb_ + 4 * n4; \
            DST = wd_t + (size_t)e_ * 1024 * 256 + (size_t)(32 * nb_) * 256 + 64 * kb_; } } while (0)
#define TP_LOAD(BUF, DSTV, KV, item) do { const float* s__; int ld__; TP_DECODE((item), s__, ld__, DSTV, KV); \
        _Pragma("unroll") for (int i = 0; i < 8; ++i) asm volatile("global_load_dwordx4 %0, %1, off nt" : "=v"(BUF[i]) : "v"(s__ + (size_t)(8 * i) * ld__) : "memory"); } while (0)
#define TP_WAIT7(BUF) asm volatile("s_waitcnt vmcnt(7)" ::: "memory")
#define TP_PROC(BUF, DSTV, KV) do { \
        _Pragma("unroll") for (int i = 0; i < 8; ++i) { LAS float* d = scr + (8 * i + kq) * 33 + 4 * n4; d[0] = BUF[i][0]; d[1] = BUF[i][1]; d[2] = BUF[i][2]; d[3] = BUF[i][3]; } \
        LDS_WAIT(); asm volatile("" ::: "memory"); \
        _Pragma("unroll") for (int j = 0; j < 4; ++j) { const int n = (lane >> 3) + 8 * j; const LAS float* s_ = scr + (8 * (lane & 7)) * 33 + n; \
            u32x4 o; o.x = pk2(s_[0 * 33], s_[1 * 33]); o.y = pk2(s_[2 * 33], s_[3 * 33]); o.z = pk2(s_[4 * 33], s_[5 * 33]); o.w = pk2(s_[6 * 33], s_[7 * 33]); \
            __builtin_nontemporal_store(o, (u32x4*)(DSTV + (size_t)n * KV + 8 * (lane & 7))); } \
        LDS_WAIT(); asm volatile("" ::: "memory"); } while (0)
#define TP_WAIT0(BUF) asm volatile("s_waitcnt vmcnt(0)" ::: "memory")
    for (int it = gw; it < ITEMS_EXP; it += 2 * NGW) {
        f32x4 b0[8], b1[8]; bf16 *d0, *d1 = wgu_t; int K0, K1 = 0;
        const bool two = it + NGW < ITEMS_EXP;
        TP_LOAD(b0, d0, K0, it);
        if (two) { TP_LOAD(b1, d1, K1, it + NGW); TP_WAIT7(b0); } else TP_WAIT0(b0);
        TP_PROC(b0, d0, K0);
        if (two) { TP_WAIT0(b1); TP_PROC(b1, d1, K1); }
    }
#undef TP_WAIT0
#undef TP_WAIT7
#undef TP_PROC
#undef TP_LOAD
#undef TP_DECODE
}
__device__ __forceinline__ bool conv_acquire(Frame& F, int L, bool block) {
    volatile LAS int* flag = (volatile LAS int*)(F.lds + LDSCTL_OFF + 384);
    unsigned* sem = (unsigned*)(F.ctl + CW_SEM + 64 * L);
    if (cur_tid() == 0) {
        int ok = 0;
        for (;;) {
            const unsigned old = __hip_atomic_fetch_add(sem, 1u, __ATOMIC_RELAXED, __HIP_MEMORY_SCOPE_AGENT);
            if (old < CONV_LIMIT) { ok = 1; break; }
            __hip_atomic_fetch_sub(sem, 1u, __ATOMIC_RELAXED, __HIP_MEMORY_SCOPE_AGENT);
            if (!block) break;
            __builtin_amdgcn_s_sleep(64);
        }
        *flag = ok;
    }
    WG_BAR();
    const int ok = __builtin_amdgcn_readfirstlane(*flag);
    WG_BAR();
    return ok != 0;
}
__device__ __forceinline__ void conv_release(Frame& F, int L) {
    if (cur_tid() == 0) __hip_atomic_fetch_sub((unsigned*)(F.ctl + CW_SEM + 64 * L), 1u, __ATOMIC_RELAXED, __HIP_MEMORY_SCOPE_AGENT);
}
__device__ __forceinline__ void p0_misc(Frame& F) {
    const int gw = F.vcu * NWAVES + F.wave, NGW = F.G * NWAVES;
    const float* x = (const float*)F.in[0]; bf16* hb = (bf16*)(F.ws + WS_HB);
    for (int m0 = gw; m0 < T; m0 += 2 * NGW) {
        const bool two = m0 + NGW < T; const int m1 = two ? m0 + NGW : m0;
        f32x4 v[2][4];
#pragma unroll
        for (int r = 0; r < 2; ++r) { const f32x4* xr = (const f32x4*)(x + (size_t)(r ? m1 : m0) * D) + F.lane;
#pragma unroll
            for (int j = 0; j < 4; ++j) v[r][j] = xr[64 * j]; }
#pragma unroll
        for (int r = 0; r < 2; ++r) { if (r == 1 && !two) break; u32x2* hr = (u32x2*)(hb + (size_t)(r ? m1 : m0) * D) + F.lane;
#pragma unroll
            for (int j = 0; j < 4; ++j) hr[64 * j] = (u32x2){pk2(v[r][j][0], v[r][j][1]), pk2(v[r][j][2], v[r][j][3])}; }
    }
    const int* pos = (const int*)F.in[2]; float* rc = (float*)(F.ws + WS_ROPE); float* rs = rc + (size_t)T * 16;
    const double cfr[16] = {0.15915494309189535, 0.08949940160889101, 0.050329212104487035, 0.0283021958306234, 0.015915494309189534, 0.008949940160889102, 0.005032921210448704, 0.00283021958306234,
                            0.0015915494309189536, 0.0008949940160889102, 0.0005032921210448703, 0.00028302195830623395, 0.00015915494309189535, 8.949940160889102e-05, 5.0329212104487035e-05, 2.8302195830623396e-05};
    for (int idx = (F.vcu * NWAVES * 64) + F.tid; idx < T * 16; idx += F.G * NWAVES * 64) {
        const int t = idx >> 4, i = idx & 15; double rev = (double)pos[t] * cfr[i]; rev -= __builtin_floor(rev);
        rc[idx] = __builtin_amdgcn_cosf((float)rev); rs[idx] = __builtin_amdgcn_sinf((float)rev);
    }
}

__device__ __forceinline__ void prep_rows(Frame& F, int L) {
    const int gw = F.vcu * NWAVES + F.wave, NGW = F.G * NWAVES, lane = F.lane;
    const bf16* proj = (const bf16*)(F.ws + X_PROJ); bf16* qn = (bf16*)(F.ws + X_QN); bf16* ckvn = (bf16*)(F.ws + X_CKVN); bf16* kpe = (bf16*)(F.ws + X_KPE);
    const float* qg = (const float*)F.in[4] + L * 384; const float* kg = (const float*)F.in[6] + L * 256;
    const float* rc = (const float*)(F.ws + WS_ROPE); const float* rs = rc + (size_t)T * 16;
    float gq[6], gk[4];
#pragma unroll
    for (int j = 0; j < 6; ++j) gq[j] = qg[lane * 2 + (j & 1) + 128 * (j >> 1)];
#pragma unroll
    for (int j = 0; j < 4; ++j) gk[j] = kg[lane * 4 + j];
    for (int t0 = gw; t0 < T; t0 += 2 * NGW) {
        const bool two = t0 + NGW < T; const int t1 = two ? t0 + NGW : t0;
        unsigned qw[2][3]; u32x2 kw[2]; float xv[2], cc[2], ss[2];
#pragma unroll
        for (int r = 0; r < 2; ++r) { const int t = r ? t1 : t0; const bf16* pr = proj + (size_t)t * NPAD;
#pragma unroll
            for (int j = 0; j < 3; ++j) qw[r][j] = *(const unsigned*)(pr + CQ + 128 * j + 2 * lane);
            kw[r] = *(const u32x2*)(pr + CKV + 4 * lane);
            xv[r] = bf2f(pr[CKPE + (lane & 31)]); cc[r] = rc[(size_t)t * 16 + (lane & 15)]; ss[r] = rs[(size_t)t * 16 + (lane & 15)]; }
#pragma unroll
        for (int r = 0; r < 2; ++r) { if (r == 1 && !two) break; const int t = r ? t1 : t0;
            float q[6], k[4];
#pragma unroll
            for (int j = 0; j < 3; ++j) { q[2 * j] = bflo(qw[r][j]); q[2 * j + 1] = bfhi(qw[r][j]); }
            k[0] = bflo(kw[r].x); k[1] = bfhi(kw[r].x); k[2] = bflo(kw[r].y); k[3] = bfhi(kw[r].y);
            float sq = 0.f, sk = 0.f;
#pragma unroll
            for (int j = 0; j < 6; ++j) sq += q[j] * q[j];
#pragma unroll
            for (int j = 0; j < 4; ++j) sk += k[j] * k[j];
            sq = wave_sum(sq); sk = wave_sum(sk);
            const float rq = __builtin_amdgcn_rsqf(sq * (1.f / 384.f) + 1e-6f), rk = __builtin_amdgcn_rsqf(sk * (1.f / 256.f) + 1e-6f);
#pragma unroll
            for (int j = 0; j < 3; ++j) *(unsigned*)(qn + (size_t)t * 384 + 128 * j + 2 * lane) = pk2(q[2 * j] * rq * gq[2 * j], q[2 * j + 1] * rq * gq[2 * j + 1]);
            *(u32x2*)(ckvn + (size_t)t * 256 + 4 * lane) = (u32x2){pk2(k[0] * rk * gk[0], k[1] * rk * gk[1]), pk2(k[2] * rk * gk[2], k[3] * rk * gk[3])};
            const float yv = __shfl_xor(xv[r], 16);
            const float o = (lane & 16) ? (yv * ss[r] + xv[r] * cc[r]) : (xv[r] * cc[r] - yv * ss[r]);
            if (lane < 32) kpe[(size_t)t * 32 + lane] = f2bf(o); }
    }
}
template <bool COMBINE, bool OUT32> __device__ __forceinline__ void ln_rows(Frame& F, const bf16* src, const float* g, const float* b, const int* rpos, const unsigned char* Y8, const float* rwt) {
    const int gw = F.vcu * NWAVES + F.wave, NGW = F.G * NWAVES, lane = F.lane;
    bf16* hb = (bf16*)(F.ws + WS_HB);
    f32x4 gv[4], bv[4];
#pragma unroll
    for (int j = 0; j < 4; ++j) { gv[j] = *((const f32x4*)g + 4 * lane + j); bv[j] = *((const f32x4*)b + 4 * lane + j); }
    for (int t = gw; t < T; t += NGW) {
        f32x4 v[4];
#pragma unroll
        for (int i = 0; i < 2; ++i) { const u32x4 w = *((const u32x4*)(src + (size_t)t * D) + 2 * lane + i); unpack8(w, v[2 * i], v[2 * i + 1]); }
        if (COMBINE) {
            const int slot = rpos[t * TOPK + (lane & 7)]; const float wgt = rwt[t * TOPK + (lane & 7)] * (1.f / YSCALE);
            f32x4 ra[4] = {{0.f, 0.f, 0.f, 0.f}, {0.f, 0.f, 0.f, 0.f}, {0.f, 0.f, 0.f, 0.f}, {0.f, 0.f, 0.f, 0.f}};
#pragma unroll
            for (int k = 0; k < TOPK; ++k) { const int sl = __builtin_amdgcn_readlane(slot, k); const u32x4 w = *((const u32x4*)(Y8 + (size_t)sl * D) + lane);
                const unsigned ww[4] = {w.x, w.y, w.z, w.w};
                const float wk = __uint_as_float(__builtin_amdgcn_readlane(__float_as_uint(wgt), k));
#pragma unroll
                for (int j = 0; j < 4; ++j) { const f32x2 lo = __builtin_amdgcn_cvt_pk_f32_fp8((int)ww[j], false), hi = __builtin_amdgcn_cvt_pk_f32_fp8((int)ww[j], true); ra[j] += (f32x4){lo[0], lo[1], hi[0], hi[1]} * wk; } }
#pragma unroll
            for (int j = 0; j < 4; ++j) v[j] += ra[j];
        }
        float s = 0.f;
#pragma unroll
        for (int j = 0; j < 4; ++j) s += (v[j][0] + v[j][1]) + (v[j][2] + v[j][3]);
        const float mean = wave_sum(s) * (1.f / D); float s2 = 0.f;
#pragma unroll
        for (int j = 0; j < 4; ++j) { v[j] = v[j] - mean; s2 += (v[j][0] * v[j][0] + v[j][1] * v[j][1]) + (v[j][2] * v[j][2] + v[j][3] * v[j][3]); }
        const float rstd = __builtin_amdgcn_rsqf(wave_sum(s2) * (1.f / D) + 1e-5f);
        f32x4 o[4];
#pragma unroll
        for (int j = 0; j < 4; ++j) { o[j] = v[j] * rstd * gv[j] + bv[j]; if (OUT32) *((f32x4*)(F.out + (size_t)t * D) + 4 * lane + j) = o[j]; }
        if (!OUT32) {
#pragma unroll
        for (int i = 0; i < 2; ++i) *((u32x4*)(hb + (size_t)t * D) + 2 * lane + i) = pack8(o[2 * i], o[2 * i + 1]); }
    }
}
__device__ __forceinline__ void conv_p(Frame& F, int L, int rank, int nwgs) {
    const float* p = (const float*)F.in[1] + (size_t)L * T * 256; bf16* pb = (bf16*)(F.ws + X_PB);
    const size_t n = (size_t)T * 256 / 4, st = (size_t)nwgs * NWAVES * 64;
    for (size_t i = (size_t)(rank * NWAVES * 64 + F.tid); i < n; i += 4 * st) {
        f32x4 v[4];
#pragma unroll
        for (int k = 0; k < 4; ++k) if (i + k * st < n) v[k] = ((const f32x4*)p)[i + k * st];
#pragma unroll
        for (int k = 0; k < 4; ++k) if (i + k * st < n) ((u32x2*)pb)[i + k * st] = (u32x2){pk2(v[k][0], v[k][1]), pk2(v[k][2], v[k][3])}; }
}

template <int CTRL> __device__ __forceinline__ float dppf(float v) { return __int_as_float(__builtin_amdgcn_update_dpp(0, __float_as_int(v), CTRL, 0xF, 0xF, false)); }
__device__ __forceinline__ float rdlane(float v, int l) { return __uint_as_float(__builtin_amdgcn_readlane(__float_as_uint(v), l)); }
__device__ __forceinline__ float wave_max_uniform(float v) {
    v = fmaxf(v, dppf<0xB1>(v)); v = fmaxf(v, dppf<0x4E>(v)); v = fmaxf(v, dppf<0x141>(v)); v = fmaxf(v, dppf<0x140>(v));
    return fmaxf(fmaxf(rdlane(v, 0), rdlane(v, 16)), fmaxf(rdlane(v, 32), rdlane(v, 48)));
}
__device__ __forceinline__ void topk_rows(Frame& F, int L) {
    const int gw = F.vcu * NWAVES + F.wave, NGW = F.G * NWAVES, lane = F.lane;
    const float* logits = (const float*)(F.ws + X_LOGITS); int* ridx = (int*)(F.ws + X_RIDX); float* rw = (float*)(F.ws + X_RW); int* rrank = (int*)(F.ws + X_RRANK);
    unsigned* cnt = (unsigned*)(F.ctl + CW_CNT + L * NEXP);
    const f32x4 bias = *((const f32x4*)((const float*)F.in[20] + L * NEXP) + lane);
    const int g = lane >> 3;
    auto route = [&](const f32x4& lg, int& myidx, float& mysc, float& ssum) {
        float sc[4], sel[4];
#pragma unroll
        for (int j = 0; j < 4; ++j) { sc[j] = __builtin_amdgcn_rcpf(1.f + __expf(-lg[j])); sel[j] = sc[j] + bias[j]; }
        float m1 = fmaxf(sel[0], sel[1]), m2 = fminf(sel[0], sel[1]);
        { const float a = fmaxf(sel[2], sel[3]), bb = fminf(sel[2], sel[3]); const float n1 = fmaxf(m1, a), n2 = fmaxf(fminf(m1, a), fmaxf(m2, bb)); m1 = n1; m2 = n2; }
#define TK_MERGE(CTRL) do { const float a1 = dppf<CTRL>(m1), a2 = dppf<CTRL>(m2); const float n1 = fmaxf(m1, a1), n2 = fmaxf(fminf(m1, a1), fmaxf(m2, a2)); m1 = n1; m2 = n2; } while (0)
        TK_MERGE(0xB1); TK_MERGE(0x4E); TK_MERGE(0x141);
#undef TK_MERGE
        const float gs = m1 + m2; int rank = 0;
#pragma unroll
        for (int j = 0; j < 8; ++j) { const float o = rdlane(gs, 8 * j); rank += (o > gs || (o == gs && j < g)) ? 1 : 0; }
        if (rank >= 4) {
#pragma unroll
            for (int j = 0; j < 4; ++j) sel[j] = -INFINITY; }
        myidx = 0; mysc = 0.f; ssum = 0.f;
#pragma unroll
        for (int k = 0; k < TOPK; ++k) {
            float bv = sel[0]; int bi = 0;
#pragma unroll
            for (int j = 1; j < 4; ++j) if (sel[j] > bv) { bv = sel[j]; bi = j; }
            const float wmax = wave_max_uniform(bv);
            const unsigned long long mask = __ballot(bv == wmax);
            const int wl = (int)__builtin_ctzll(mask);
            const int wj = __builtin_amdgcn_readlane(bi, wl);
            const float cand = (wj == 0) ? sc[0] : (wj == 1) ? sc[1] : (wj == 2) ? sc[2] : sc[3];
            const float wsc = rdlane(cand, wl);
            if (lane == wl) {
#pragma unroll
                for (int j = 0; j < 4; ++j) if (wj == j) sel[j] = -INFINITY; }
            ssum += wsc;
            if (lane == k) { myidx = 4 * wl + wj; mysc = wsc; }
        }
    };
    for (int t0 = gw; t0 < T; t0 += 2 * NGW) {
        const bool two = t0 + NGW < T; const int t1 = two ? t0 + NGW : t0;
        const f32x4 lg0 = *((const f32x4*)(logits + (size_t)t0 * NEXP) + lane), lg1 = *((const f32x4*)(logits + (size_t)t1 * NEXP) + lane);
        int i0, i1; float s0, s1, q0, q1;
        route(lg0, i0, s0, q0); route(lg1, i1, s1, q1);
        if (lane < TOPK) {
            const float w0 = s0 * __builtin_amdgcn_rcpf(q0) * 2.5f, w1 = s1 * __builtin_amdgcn_rcpf(q1) * 2.5f;
            const unsigned r0 = __hip_atomic_fetch_add(cnt + i0, 1u, __ATOMIC_RELAXED, __HIP_MEMORY_SCOPE_AGENT);
            unsigned r1 = 0; if (two) r1 = __hip_atomic_fetch_add(cnt + i1, 1u, __ATOMIC_RELAXED, __HIP_MEMORY_SCOPE_AGENT);
            ridx[t0 * TOPK + lane] = i0; rw[t0 * TOPK + lane] = w0; rrank[t0 * TOPK + lane] = (int)r0;
            if (two) { ridx[t1 * TOPK + lane] = i1; rw[t1 * TOPK + lane] = w1; rrank[t1 * TOPK + lane] = (int)r1; }
        }
    }
}
__device__ __forceinline__ void build_toff(Frame& F, int L, LAS int* toff) {
    const unsigned* cnt = (const unsigned*)(F.ctl + CW_CNT + L * NEXP);
    if (F.wave == 0) {
        int run = 0;
#pragma unroll
        for (int j = 0; j < 4; ++j) {
            const int e = 64 * j + F.lane; const int nt = ((int)__hip_atomic_load(cnt + e, __ATOMIC_RELAXED, __HIP_MEMORY_SCOPE_AGENT) + 255) >> 8;
            int inc = nt;
#pragma unroll
            for (int o = 1; o < 64; o <<= 1) { const int v = __shfl_up(inc, o); if (F.lane >= o) inc += v; }
            toff[e] = run + inc - nt; run += __shfl(inc, 63);
        }
        if (F.lane == 0) toff[NEXP] = run;
    }
    WG_BAR();
}
__device__ __forceinline__ void scatter_slots(Frame& F, int L, const LAS int* toff) {
    const int* ridx = (const int*)(F.ws + X_RIDX); const float* rw = (const float*)(F.ws + X_RW); int* rrank = (int*)(F.ws + X_RRANK);
    int* stok = (int*)(F.ws + X_STOK); float* sw = (float*)(F.ws + X_SW);
    const unsigned* cnt = (const unsigned*)(F.ctl + CW_CNT + L * NEXP);
    for (int i = F.vcu * NWAVES * 64 + F.tid; i < T * TOPK; i += F.G * NWAVES * 64) {
        const int e = ridx[i], slot = 256 * toff[e] + rrank[i];
        stok[slot] = i >> 3; sw[slot] = rw[i]; rrank[i] = slot;
    }
    for (int e = F.vcu; e < NEXP; e += F.G) {
        const int n = (int)__hip_atomic_load(cnt + e, __ATOMIC_RELAXED, __HIP_MEMORY_SCOPE_AGENT), s0 = 256 * toff[e] + n, s1 = 256 * toff[e + 1];
        for (int s = s0 + F.tid; s < s1; s += NWAVES * 64) { stok[s] = 0; sw[s] = 0.f; }
    }
}

namespace at {
constexpr int KSLOT = 12288, VSLOT = 8192, LDS_K = 0, LDS_V = 4 * KSLOT, LDS_WS = LDS_V + 3 * VSLOT, LDS_END = LDS_WS + 8 * 256;
__device__ __forceinline__ void glds16(const void* gsrc, unsigned lds_dst) { unsigned keep;
    asm volatile("s_mov_b32 %0, m0\n\ts_mov_b32 m0, %2\n\ts_nop 0\n\tglobal_load_lds_dwordx4 %1, off\n\ts_mov_b32 m0, %0" : "=&s"(keep) : "v"(gsrc), "s"(lds_dst) : "memory"); }
#define AT_SBAR() __builtin_amdgcn_sched_barrier(0)
#define AT_PIN(x) asm volatile("" : "+v"(x))
#define AT_MF(a, b, c) __builtin_amdgcn_mfma_f32_32x32x16_bf16(a, b, c, 0, 0, 0)
#define AT_MX3(a, b, c) __builtin_fmaxf(__builtin_fmaxf((a), (b)), (c))
__device__ __forceinline__ float rowmax(const f32x16& p0, const f32x16& p1) {
    float a = AT_MX3(p0[0], p0[1], p1[0]), b = AT_MX3(p0[2], p0[3], p1[1]); a = AT_MX3(a, p1[2], p1[3]);
#pragma unroll
    for (int r = 4; r < 16; r += 4) { a = AT_MX3(a, p0[r], p0[r + 1]); b = AT_MX3(b, p0[r + 2], p0[r + 3]); a = AT_MX3(a, p1[r], p1[r + 1]); b = AT_MX3(b, p1[r + 2], p1[r + 3]); }
    const float m = __builtin_fmaxf(a, b); auto rr = __builtin_amdgcn_permlane32_swap(__float_as_uint(m), __float_as_uint(m), false, false);
    return __builtin_fmaxf(__uint_as_float(rr[0]), __uint_as_float(rr[1])); }
__device__ __forceinline__ void cmask(f32x16& p0, f32x16& p1, int jb, int qrel, int hi) {
    const int kb = 64 * jb + 4 * hi;
#pragma unroll
    for (int r = 0; r < 16; ++r) { const int kv = kb + (r & 3) + 8 * (r >> 2); if (kv > qrel) p0[r] = -INFINITY; if (kv + 32 > qrel) p1[r] = -INFINITY; } }
__device__ __forceinline__ void attn_unit(int b, int h, int qb, const bf16* Q, const bf16* KV, const bf16* KPE, bf16* O, LAS unsigned char* shm) {
    int tid_ = cur_tid(); asm volatile("" : "+v"(tid_));
    const int tid = tid_, lane = tid & 63, r32 = lane & 31, hi = lane >> 5; const int wid = __builtin_amdgcn_readfirstlane(tid >> 6);
    const size_t tb = (size_t)b * SEQ; const int q0 = qb * 256;
    const unsigned lds0 = (unsigned)(size_t)shm;
    LAS float* wsf = (LAS float*)(shm + LDS_WS) + wid * 64;
    const int NT = (q0 + 256) / 64;
    const bf16* ksrc0 = KV + (tb + lane) * 1024 + h * 128 + wid * 8;
    const bf16* ksrc1 = KPE + (tb + lane) * 32 + (wid & 3) * 8;
    const bf16* vsrc = KV + (tb + 16 * (wid & 3) + (lane >> 2)) * 1024 + h * 128 + 64 + (wid >> 2) * 32 + (lane & 3) * 8;
#define AT_DMAK(t, s) do { glds16(ksrc0 + (size_t)(t) * 64 * 1024, (unsigned)__builtin_amdgcn_readfirstlane(lds0 + LDS_K + (s) * KSLOT + wid * 1024)); \
        if (wid < 4) glds16(ksrc1 + (size_t)(t) * 64 * 32, (unsigned)__builtin_amdgcn_readfirstlane(lds0 + LDS_K + (s) * KSLOT + (8 + wid) * 1024)); } while (0)
#define AT_DMAV(t, s) glds16(vsrc + (size_t)(t) * 64 * 1024, (unsigned)__builtin_amdgcn_readfirstlane(lds0 + LDS_V + (s) * VSLOT + wid * 1024))
#define AT_WAITC() do { if (wid < 4) asm volatile("s_waitcnt vmcnt(3) lgkmcnt(0)\n\ts_barrier" ::: "memory"); else asm volatile("s_waitcnt vmcnt(2) lgkmcnt(0)\n\ts_barrier" ::: "memory"); } while (0)
#define AT_WAIT0() asm volatile("s_waitcnt vmcnt(0) lgkmcnt(0)\n\ts_barrier" ::: "memory")
    AT_DMAK(0, 0); AT_DMAV(0, 0); AT_DMAK(1, 1); AT_DMAK(2, 2);
    bf16x8 qr[6];
    { const bf16* qp = Q + (tb + q0 + wid * 32 + r32) * 768 + h * 96 + hi * 8;
#pragma unroll
      for (int d0 = 0; d0 < 6; ++d0) qr[d0] = *(const bf16x8*)(qp + d0 * 16); }
    constexpr float THR = 8.f;
    float mhat = 0.f, l_reg = 0.f; f32x2 mh2 = {0.f, 0.f}; f32x16 o0 = {}, o1 = {}; const f32x16 zero16 = {};
    const int qrel = wid * 32 + r32;
    bool resc = false;
    f32x16 pA0, pA1, pB0, pB1; bf16x8 kf[12]; s16x4 vlo[8], vhi[8]; u32x4 pw0, pw1, pw2, pw3;
    LAS const unsigned char* const kp0 = shm + LDS_K + hi * 1024 + r32 * 16;
    LAS const unsigned char* const vp0 = shm + LDS_V + ((lane >> 4) & 1) * 32 + (lane & 3) * 8 + (4 * hi + ((lane & 15) >> 2)) * 64;
    int sl_prev = 0, sl_cur = 0, sl_next = 1;
#define AT_ROT() do { sl_prev = sl_cur; sl_cur = sl_next; sl_next = (sl_next == 2) ? 0 : sl_next + 1; } while (0)
#define AT_KRDP(kp_, d0) do { kf[2 * (d0)] = *(LAS const bf16x8*)((kp_) + (d0) * 2048); kf[2 * (d0) + 1] = *(LAS const bf16x8*)((kp_) + (d0) * 2048 + 512); } while (0)
#define AT_KRD(d0) AT_KRDP(kp_, d0)
#define AT_VRD(i) do { vlo[i] = ldstr(vp_ + (((i) >> 2) * 4096 + ((i) & 3) * 1024)); vhi[i] = ldstr(vp_ + (((i) >> 2) * 4096 + ((i) & 3) * 1024 + 512)); } while (0)
#define AT_VFR(i) (bf16x8){vlo[i][0], vlo[i][1], vlo[i][2], vlo[i][3], vhi[i][0], vhi[i][1], vhi[i][2], vhi[i][3]}
#define AT_PAF(k) __builtin_bit_cast(bf16x8, pw##k)
#define AT_PK(P, i) pk2(P[i], P[i + 1])
#define AT_EX(X, i) X[i] = __builtin_amdgcn_exp2f(X[i])
#define AT_RESC() do { if (resc) { _Pragma("unroll") for (int r = 0; r < 16; ++r) { const float f = wsf[crow(r, hi)]; o0[r] *= f; o1[r] *= f; } } } while (0)
    asm volatile("s_waitcnt vmcnt(0) lgkmcnt(0)\n\ts_barrier" ::: "memory");
    { LAS const unsigned char* kp_ = kp0;
      _Pragma("unroll") for (int d0 = 0; d0 < 6; ++d0) AT_KRD(d0);
      pA0 = AT_MF(kf[0], qr[0], zero16); pA1 = AT_MF(kf[1], qr[0], zero16);
      _Pragma("unroll") for (int d0 = 1; d0 < 6; ++d0) { pA0 = AT_MF(kf[2 * d0], qr[d0], pA0); pA1 = AT_MF(kf[2 * d0 + 1], qr[d0], pA1); } }
    AT_DMAK(3, 3); AT_DMAV(1, 1);
    if (NT == 4) cmask(pA0, pA1, 0, qrel, hi);
    { mhat = rowmax(pA0, pA1); mh2 = (f32x2){-mhat, -mhat}; AT_PIN(mh2);
#pragma unroll
      for (int r = 0; r < 16; ++r) pA0[r] = __builtin_amdgcn_exp2f(pA0[r] - mhat); }
    AT_KRDP(kp0 + KSLOT, 0); AT_KRDP(kp0 + KSLOT, 1);
    sl_prev = 0; sl_cur = 1; sl_next = 2;
#define AT_GA(MFS, FILL) do { MFS; FILL; AT_SBAR(); } while (0)
#define AT_EX2(X, i) do { f32x2 x_ = {X[i], X[(i) + 1]}; x_ += mh2; X[i] = __builtin_amdgcn_exp2f(x_[0]); X[(i) + 1] = __builtin_amdgcn_exp2f(x_[1]); } while (0)
#define AT_SUM2(X, i) s2 += (f32x2){X[i], X[(i) + 1]}
#define AT_STEP(C0, C1, P0, P1, t, MASK, GK, GV, GL, CNT) do { \
    if (CNT) AT_WAITC(); else AT_WAIT0(); \
    if (GK) AT_DMAK((t) + 3, ((t) + 3) & 3); if (GV) AT_DMAV((t) + 1, sl_next); \
    LAS const unsigned char* const kp_ = kp0 + ((t) & 3) * KSLOT; LAS const unsigned char* const kpn_ = kp0 + (((t) + 1) & 3) * KSLOT; LAS const unsigned char* const vp_ = vp0 + sl_prev * VSLOT; \
    f32x2 s2 = {0.f, 0.f}; \
    AT_KRD(2); AT_SBAR(); \
    AT_GA(C0 = AT_MF(kf[0], qr[0], zero16), AT_EX2(P1, 0); pw0[0] = AT_PK(P0, 0); AT_SUM2(P0, 0); AT_PIN(P1); AT_PIN(pw0); AT_PIN(s2)); \
    AT_GA(C1 = AT_MF(kf[1], qr[0], zero16), AT_KRD(3); AT_EX2(P1, 2); pw0[1] = AT_PK(P0, 2); AT_SUM2(P0, 2); pw2[0] = AT_PK(P1, 0); AT_SUM2(P1, 0); AT_PIN(P1); AT_PIN(pw0); AT_PIN(pw2); AT_PIN(s2)); \
    AT_GA(C0 = AT_MF(kf[2], qr[1], C0), pw0[2] = AT_PK(P0, 4); AT_SUM2(P0, 4); pw2[1] = AT_PK(P1, 2); AT_SUM2(P1, 2); AT_PIN(pw0); AT_PIN(pw2); AT_PIN(s2)); \
    AT_GA(C1 = AT_MF(kf[3], qr[1], C1), AT_KRD(4); AT_EX2(P1, 4); pw0[3] = AT_PK(P0, 6); AT_SUM2(P0, 6); AT_PIN(P1); AT_PIN(pw0); AT_PIN(s2)); \
    AT_GA(C0 = AT_MF(kf[4], qr[2], C0), AT_EX2(P1, 6); pw1[0] = AT_PK(P0, 8); AT_SUM2(P0, 8); pw2[2] = AT_PK(P1, 4); AT_SUM2(P1, 4); AT_PIN(P1); AT_PIN(pw1); AT_PIN(pw2); AT_PIN(s2)); \
    AT_GA(C1 = AT_MF(kf[5], qr[2], C1), AT_KRD(5); pw1[1] = AT_PK(P0, 10); AT_SUM2(P0, 10); pw2[3] = AT_PK(P1, 6); AT_SUM2(P1, 6); AT_PIN(pw1); AT_PIN(pw2); AT_PIN(s2)); \
    AT_GA(C0 = AT_MF(kf[6], qr[3], C0), AT_EX2(P1, 8); pw1[2] = AT_PK(P0, 12); AT_SUM2(P0, 12); AT_PIN(P1); AT_PIN(pw1); AT_PIN(s2)); \
    AT_GA(C1 = AT_MF(kf[7], qr[3], C1), AT_EX2(P1, 10); pw1[3] = AT_PK(P0, 14); AT_SUM2(P0, 14); pw3[0] = AT_PK(P1, 8); AT_SUM2(P1, 8); AT_PIN(P1); AT_PIN(pw1); AT_PIN(pw3); AT_PIN(s2)); \
    AT_GA(C0 = AT_MF(kf[8], qr[4], C0), pw3[1] = AT_PK(P1, 10); AT_SUM2(P1, 10); AT_PIN(pw3); AT_PIN(s2)); \
    AT_GA(C1 = AT_MF(kf[9], qr[4], C1), AT_EX2(P1, 12); AT_PIN(P1)); \
    AT_GA(C0 = AT_MF(kf[10], qr[5], C0), AT_VRD(0); AT_EX2(P1, 14); pw3[2] = AT_PK(P1, 12); AT_SUM2(P1, 12); AT_PIN(P1); AT_PIN(pw3); AT_PIN(s2)); \
    AT_GA(C1 = AT_MF(kf[11], qr[5], C1), AT_VRD(4); pw3[3] = AT_PK(P1, 14); AT_SUM2(P1, 14); AT_PIN(pw3); AT_PIN(s2)); \
    l_reg += s2[0] + s2[1]; \
    if (MASK) cmask(C0, C1, (t) - (NT - 4), qrel, hi); \
    { const float rm = rowmax(C0, C1) - mhat; resc = false;                                                       \
      if (__builtin_expect(__any(rm > THR), 0)) { const float dl = __builtin_fmaxf(rm, 0.f); mhat += dl; mh2 = (f32x2){-mhat, -mhat}; AT_PIN(mh2);     \
          const float f = __builtin_amdgcn_exp2f(-dl); l_reg *= f; if (hi == 0) wsf[r32] = f; resc = true; } } \
    AT_PIN(l_reg); AT_SBAR(); \
    AT_GA(o0 = AT_MF(AT_PAF(0), AT_VFR(0), o0), AT_VRD(1); AT_EX2(C0, 0); AT_PIN(C0)); \
    AT_GA(o1 = AT_MF(AT_PAF(0), AT_VFR(4), o1), AT_VRD(5); AT_EX2(C0, 2); AT_PIN(C0)); \
    AT_GA(o0 = AT_MF(AT_PAF(1), AT_VFR(1), o0), AT_VRD(2); AT_EX2(C0, 4); AT_PIN(C0)); \
    AT_GA(o1 = AT_MF(AT_PAF(1), AT_VFR(5), o1), AT_VRD(6); AT_EX2(C0, 6); AT_PIN(C0)); \
    AT_GA(o0 = AT_MF(AT_PAF(2), AT_VFR(2), o0), AT_VRD(3); AT_EX2(C0, 8); AT_PIN(C0)); \
    AT_GA(o1 = AT_MF(AT_PAF(2), AT_VFR(6), o1), AT_VRD(7); AT_EX2(C0, 10); AT_PIN(C0)); \
    AT_GA(o0 = AT_MF(AT_PAF(3), AT_VFR(3), o0), if (GL) AT_KRDP(kpn_, 0); AT_EX2(C0, 12); AT_PIN(C0)); \
    AT_GA(o1 = AT_MF(AT_PAF(3), AT_VFR(7), o1), if (GL) AT_KRDP(kpn_, 1); AT_EX2(C0, 14); AT_PIN(C0)); \
    AT_RESC(); AT_ROT(); \
    } while (0)
    int t = 1;
    for (; t + 5 < NT; t += 2) {
        AT_STEP(pB0, pB1, pA0, pA1, t, false, true, true, true, true);
        AT_STEP(pA0, pA1, pB0, pB1, t + 1, false, true, true, true, true);
    }
    for (; t + 1 < NT; t += 2) {
        AT_STEP(pB0, pB1, pA0, pA1, t, true, (t + 3 < NT), (t + 1 < NT), (t + 1 < NT), false);
        AT_STEP(pA0, pA1, pB0, pB1, t + 1, true, (t + 4 < NT), (t + 2 < NT), (t + 2 < NT), false);
    }
    AT_STEP(pB0, pB1, pA0, pA1, NT - 1, true, false, false, false, false);
    { LAS const unsigned char* const vp_ = vp0 + sl_prev * VSLOT;
#pragma unroll
      for (int i = 0; i < 8; ++i) AT_VRD(i);
#pragma unroll
      for (int r = 0; r < 16; ++r) pB1[r] = __builtin_amdgcn_exp2f(pB1[r] - mhat);
      pw0 = (u32x4){AT_PK(pB0, 0), AT_PK(pB0, 2), AT_PK(pB0, 4), AT_PK(pB0, 6)}; pw1 = (u32x4){AT_PK(pB0, 8), AT_PK(pB0, 10), AT_PK(pB0, 12), AT_PK(pB0, 14)};
      pw2 = (u32x4){AT_PK(pB1, 0), AT_PK(pB1, 2), AT_PK(pB1, 4), AT_PK(pB1, 6)}; pw3 = (u32x4){AT_PK(pB1, 8), AT_PK(pB1, 10), AT_PK(pB1, 12), AT_PK(pB1, 14)};
      { float sa = 0.f;
#pragma unroll
        for (int r = 0; r < 16; ++r) sa += pB0[r] + pB1[r];
        l_reg += sa; }
      o0 = AT_MF(AT_PAF(0), AT_VFR(0), o0); o1 = AT_MF(AT_PAF(0), AT_VFR(4), o1);
      o0 = AT_MF(AT_PAF(1), AT_VFR(1), o0); o1 = AT_MF(AT_PAF(1), AT_VFR(5), o1);
      o0 = AT_MF(AT_PAF(2), AT_VFR(2), o0); o1 = AT_MF(AT_PAF(2), AT_VFR(6), o1);
      o0 = AT_MF(AT_PAF(3), AT_VFR(3), o0); o1 = AT_MF(AT_PAF(3), AT_VFR(7), o1); }
#undef AT_STEP
#undef AT_GA
#undef AT_EX2
#undef AT_SUM2
#undef AT_RESC
#undef AT_EX
#undef AT_PK
#undef AT_PAF
#undef AT_VFR
#undef AT_VRD
#undef AT_KRD
#undef AT_KRDP
#undef AT_ROT
#undef AT_WAIT0
#undef AT_WAITC
#undef AT_DMAV
#undef AT_DMAK
    { auto rr = __builtin_amdgcn_permlane32_swap(__float_as_uint(l_reg), __float_as_uint(l_reg), false, false); l_reg = __uint_as_float(rr[0]) + __uint_as_float(rr[1]); }
    if (hi == 0) wsf[32 + r32] = l_reg;
    bf16* Ow = O + (tb + q0 + wid * 32) * 512 + h * 64 + r32;
#pragma unroll
    for (int r = 0; r < 16; ++r) { const int q = crow(r, hi); const float f = __builtin_amdgcn_rcpf(wsf[32 + q]); Ow[(size_t)q * 512] = f2bf(o0[r] * f); Ow[(size_t)q * 512 + 32] = f2bf(o1[r] * f); }
    asm volatile("s_waitcnt lgkmcnt(0)\n\ts_barrier" ::: "memory");
}
}

namespace ssd {
constexpr int L_BM = 0, L_CG = 32768, L_X = 65536;
constexpr int S_ACUM = 0, S_DT = 2048;
template <class F> __device__ __forceinline__ void conv8(const bf16* proj, const float* cw, const float* cb, int ccol, size_t t0, int tr0, bool seq_start, F sink) {
    float w[4][8], bia[8];
#pragma unroll
    for (int k = 0; k < 4; ++k) { const f32x4 a = *(const f32x4*)(cw + k * 1536 + ccol), b = *(const f32x4*)(cw + k * 1536 + ccol + 4);
        w[k][0] = a[0]; w[k][1] = a[1]; w[k][2] = a[2]; w[k][3] = a[3]; w[k][4] = b[0]; w[k][5] = b[1]; w[k][6] = b[2]; w[k][7] = b[3]; }
    { const f32x4 a = *(const f32x4*)(cb + ccol), b = *(const f32x4*)(cb + ccol + 4); bia[0] = a[0]; bia[1] = a[1]; bia[2] = a[2]; bia[3] = a[3]; bia[4] = b[0]; bia[5] = b[1]; bia[6] = b[2]; bia[7] = b[3]; }
    float x0[8], x1[8], x2[8];
    auto ld = [&](int tr, float (&x)[8]) {
        if (seq_start && tr < 0) {
#pragma unroll
            for (int e = 0; e < 8; ++e) x[e] = 0.f;
        } else {
            const u32x4 v = *(const u32x4*)(proj + (t0 + tr) * NPAD + CXBC + ccol);
            x[0] = bflo(v.x); x[1] = bfhi(v.x); x[2] = bflo(v.y); x[3] = bfhi(v.y); x[4] = bflo(v.z); x[5] = bfhi(v.z); x[6] = bflo(v.w); x[7] = bfhi(v.w);
        } };
    ld(tr0 - 3, x0); ld(tr0 - 2, x1); ld(tr0 - 1, x2);
#pragma unroll
    for (int i = 0; i < 8; ++i) {
        float x3[8], y[8]; ld(tr0 + i, x3);
#pragma unroll
        for (int e = 0; e < 8; ++e) { const float v = bia[e] + w[0][e] * x0[e] + w[1][e] * x1[e] + w[2][e] * x2[e] + w[3][e] * x3[e]; y[e] = siluf_(v); x0[e] = x1[e]; x1[e] = x2[e]; x2[e] = x3[e]; }
        sink(tr0 + i, y);
    }
}
__device__ __forceinline__ void s1_unit(Frame& F, int L, int b, int c, int g) {
    LAS unsigned char* lds = F.lds; LAS float* side = (LAS float*)(F.lds + SIDE_OFF);
    int tid_ = cur_tid(); asm volatile("" : "+v"(tid_));
    const int tid = tid_, lane = tid & 63, wid = __builtin_amdgcn_readfirstlane(tid >> 6), r32 = lane & 31, hi = lane >> 5;
    const size_t t0 = (size_t)b * SEQ + (size_t)c * 128; const bool seq_start = (c == 0);
    const bf16* proj = (const bf16*)(F.ws + X_PROJ); const float* dtraw = (const float*)(F.ws + X_DTRAW);
    const float* cw = (const float*)F.in[8] + (size_t)L * 4 * 1536; const float* cb = (const float*)F.in[9] + L * 1536;
    const float* dtb = (const float*)F.in[10] + L * 16; const float* alog = (const float*)F.in[11] + L * 16; const float* dsk = (const float*)F.in[12] + L * 16;
    bf16* Cc = (bf16*)(F.ws + X_CC); float* eacum = (float*)(F.ws + X_EACUM); float* cdec = (float*)(F.ws + X_CDEC);
    bf16* ypart = (bf16*)(F.ws + X_YPART); bf16* states = (bf16*)(F.ws + X_STATES);
    { const int ch = tid & 31, tg = tid >> 5; const bool isC = ch >= 16; const int ccol = 1024 + (isC ? 256 : 0) + g * 128 + 8 * (ch & 15);
      conv8(proj, cw, cb, ccol, t0, 8 * tg, seq_start, [&](int tr, const float (&y)[8]) {
          const u32x4 w = {pk2(y[0], y[1]), pk2(y[2], y[3]), pk2(y[4], y[5]), pk2(y[6], y[7])};
          *(LAS u32x4*)(lds + (isC ? L_CG : L_BM) + off_b(tr, ch & 15)) = w;
          if (isC) *(u32x4*)(Cc + (t0 + tr) * 256 + g * 128 + 8 * (ch & 15)) = w; }); }
    LDS_BAR();
    { const int lb = wid >> 1; f32x16 gacc[2];
#pragma unroll
      for (int i = 0; i < 2; ++i) { const int sb = 2 * (wid & 1) + i; gacc[i] = (f32x16){};
          if (sb <= lb) {
#pragma unroll
              for (int ks = 0; ks < 8; ++ks) { const bf16x8 a = *(LAS const bf16x8*)(lds + L_CG + row_read_addr(32 * lb, lane, ks)), bb = *(LAS const bf16x8*)(lds + L_BM + row_read_addr(32 * sb, lane, ks));
                  gacc[i] = __builtin_amdgcn_mfma_f32_32x32x16_bf16(a, bb, gacc[i], 0, 0, 0); } } }
      LDS_BAR();
#pragma unroll
      for (int i = 0; i < 2; ++i) { const int sb = 2 * (wid & 1) + i;
          if (sb <= lb) {
#pragma unroll
              for (int r = 0; r < 16; ++r) { const int row = 32 * lb + crow(r, hi), col = 32 * sb + r32; *(LAS unsigned short*)(lds + L_CG + off_b(row, col >> 3) + (col & 7) * 2) = f2bf(gacc[i][r]); } } } }
#pragma unroll 1
    for (int rd = 0; rd < 2; ++rd) {
        if (wid < 4) {
            const int h = 8 * g + 4 * rd + wid; const float bia = dtb[h], a = -__expf(alog[h]);
            float d0 = dtraw[(t0 + lane) * 16 + h] + bia, d1 = dtraw[(t0 + 64 + lane) * 16 + h] + bia;
            d0 = fmaxf(d0, 0.f) + __logf(1.f + __expf(-fabsf(d0))); d1 = fmaxf(d1, 0.f) + __logf(1.f + __expf(-fabsf(d1)));
            d0 = fmaxf(d0, 1e-20f); d1 = fmaxf(d1, 1e-20f);
            float c0 = d0 * a, c1 = d1 * a;
#pragma unroll
            for (int o = 1; o < 64; o <<= 1) { const float v0 = __shfl_up(c0, o), v1 = __shfl_up(c1, o); if (lane >= o) { c0 += v0; c1 += v1; } }
            c1 += __shfl(c0, 63);
            side[S_ACUM / 4 + wid * 128 + lane] = c0; side[S_ACUM / 4 + wid * 128 + 64 + lane] = c1;
            side[S_DT / 4 + wid * 128 + lane] = d0; side[S_DT / 4 + wid * 128 + 64 + lane] = d1;
            eacum[(t0 + lane) * 16 + h] = __expf(c0); eacum[(t0 + 64 + lane) * 16 + h] = __expf(c1);
            if (lane == 63) cdec[((size_t)b * 64 + c) * 16 + h] = __expf(c1);
        }
        LDS_BAR();
        {
          const int ch = tid & 31, tg = tid >> 5, hd = ch >> 3, pch = ch & 7; const int ccol = (8 * g + 4 * rd + hd) * 64 + 8 * pch;
          conv8(proj, cw, cb, ccol, t0, 8 * tg, seq_start, [&](int tr, const float (&y)[8]) {
              const float d = side[S_DT / 4 + hd * 128 + tr];
              *(LAS u32x4*)(lds + L_X + (hd >> 1) * 32768 + off_b(tr, (hd & 1) * 8 + pch)) = (u32x4){pk2(y[0] * d, y[1] * d), pk2(y[2] * d, y[3] * d), pk2(y[4] * d, y[5] * d), pk2(y[6] * d, y[7] * d)}; }); }
        LDS_BAR();
        {
          const int hd = wid >> 1, sub = wid & 1, h = 8 * g + 4 * rd + hd;
          LAS const unsigned char* Xt = lds + L_X + (hd >> 1) * 32768; const int cb0 = (hd & 1) * 2;
          LAS const float* ac = side + S_ACUM / 4 + hd * 128; LAS const float* dts = side + S_DT / 4 + hd * 128;
          const float dskip = dsk[h];
#pragma unroll 1
          for (int rbi = 0; rbi < 2; ++rbi) {
              const int rb = sub ? (1 + rbi) : (3 * rbi); const int l = 32 * rb + r32; const float al = ac[l], dl = dskip * __builtin_amdgcn_rcpf(dts[l]);
              f32x16 y0 = {}, y1 = {};
              for (int ks = 0; ks <= 2 * rb + 1; ++ks) {
                  const u32x4 gw = *(LAS const u32x4*)(lds + L_CG + row_read_addr(32 * rb, lane, ks));
                  const f32x4 as0 = *(LAS const f32x4*)(ac + 16 * ks + 8 * hi), as1 = *(LAS const f32x4*)(ac + 16 * ks + 8 * hi + 4);
                  const float gv[8] = {bflo(gw.x), bfhi(gw.x), bflo(gw.y), bfhi(gw.y), bflo(gw.z), bfhi(gw.z), bflo(gw.w), bfhi(gw.w)};
                  const float asv[8] = {as0[0], as0[1], as0[2], as0[3], as1[0], as1[1], as1[2], as1[3]};
                  float mv[8];
#pragma unroll
                  for (int j = 0; j < 8; ++j) { const int s = 16 * ks + 8 * hi + j; float m = (s <= l) ? gv[j] * __expf(al - asv[j]) : 0.f; if (s == l) m += dl; mv[j] = m; }
                  const bf16x8 af = __builtin_bit_cast(bf16x8, (u32x4){pk2(mv[0], mv[1]), pk2(mv[2], mv[3]), pk2(mv[4], mv[5]), pk2(mv[6], mv[7])});
                  y0 = __builtin_amdgcn_mfma_f32_32x32x16_bf16(af, tr_frag(Xt, lane, cb0, ks), y0, 0, 0, 0);
                  y1 = __builtin_amdgcn_mfma_f32_32x32x16_bf16(af, tr_frag(Xt, lane, cb0 + 1, ks), y1, 0, 0, 0);
              }
#pragma unroll
              for (int i = 0; i < 2; ++i) { bf16* yp = ypart + (((size_t)b * 64 + c) * 16 + h) * 8192 + (size_t)(rb * 2) * 1024 + lane * 16 + 8 * i;
                  *(u32x4*)yp = (u32x4){pk2(y0[8 * i], y0[8 * i + 1]), pk2(y0[8 * i + 2], y0[8 * i + 3]), pk2(y0[8 * i + 4], y0[8 * i + 5]), pk2(y0[8 * i + 6], y0[8 * i + 7])};
                  *(u32x4*)(yp + 1024) = (u32x4){pk2(y1[8 * i], y1[8 * i + 1]), pk2(y1[8 * i + 2], y1[8 * i + 3]), pk2(y1[8 * i + 4], y1[8 * i + 5]), pk2(y1[8 * i + 6], y1[8 * i + 7])}; }
          }
          { f32x16 st[4] = {{}, {}, {}, {}}; const float aend = ac[127];
            for (int ks = 0; ks < 8; ++ks) {
                const bf16x8 xf = tr_frag(Xt, lane, cb0 + sub, ks); const u32x4 xw = __builtin_bit_cast(u32x4, xf);
                const f32x4 as0 = *(LAS const f32x4*)(ac + 16 * ks + 8 * hi), as1 = *(LAS const f32x4*)(ac + 16 * ks + 8 * hi + 4);
                const bf16x8 af = __builtin_bit_cast(bf16x8, (u32x4){pk2(bflo(xw.x) * __expf(aend - as0[0]), bfhi(xw.x) * __expf(aend - as0[1])), pk2(bflo(xw.y) * __expf(aend - as0[2]), bfhi(xw.y) * __expf(aend - as0[3])),
                                                                       pk2(bflo(xw.z) * __expf(aend - as1[0]), bfhi(xw.z) * __expf(aend - as1[1])), pk2(bflo(xw.w) * __expf(aend - as1[2]), bfhi(xw.w) * __expf(aend - as1[3]))});
#pragma unroll
                for (int nb = 0; nb < 4; ++nb) st[nb] = __builtin_amdgcn_mfma_f32_32x32x16_bf16(af, tr_frag(lds + L_BM, lane, nb, ks), st[nb], 0, 0, 0);
            }
            bf16* sp = states + (((size_t)b * 64 + c) * 16 + h) * 8192;
#pragma unroll
            for (int nb = 0; nb < 4; ++nb)
#pragma unroll
                for (int r = 0; r < 16; ++r) sp[(32 * sub + crow(r, hi)) * 128 + 32 * nb + r32] = f2bf(st[nb][r]); }
        }
        LDS_BAR();
    }
}
__device__ __forceinline__ void scan_phase(Frame& F) {
    const bf16* states = (const bf16*)(F.ws + X_STATES); const float* cdec = (const float*)(F.ws + X_CDEC); bf16* prev = (bf16*)(F.ws + X_PREV);
    for (int idx = F.vcu * NWAVES * 64 + F.tid; idx < NB * 16 * 64 * 32; idx += F.G * NWAVES * 64) {
        const int n4 = idx & 31, p = (idx >> 5) & 63, h = (idx >> 11) & 15, b = idx >> 15;
        f32x4 st = {0.f, 0.f, 0.f, 0.f};
#pragma unroll 1
        for (int c0 = 0; c0 < 64; c0 += 16) {
            const size_t o0 = ((((size_t)b * 64 + c0) * 16 + h) * 64 + p) * 128 + 4 * n4;
            u32x2 cw[16]; float d[16];
#pragma unroll
            for (int k = 0; k < 16; ++k) { cw[k] = *(const u32x2*)(states + o0 + (size_t)k * (16 * 64 * 128)); d[k] = cdec[((size_t)b * 64 + c0 + k) * 16 + h]; }
#pragma unroll
            for (int k = 0; k < 16; ++k) {
                *(u32x2*)(prev + o0 + (size_t)k * (16 * 64 * 128)) = (u32x2){pk2(st[0], st[1]), pk2(st[2], st[3])};
                const f32x4 cs = {bflo(cw[k].x), bfhi(cw[k].x), bflo(cw[k].y), bfhi(cw[k].y)};
                st = st * d[k] + cs; }
        }
    }
}
__device__ __forceinline__ void s3_unit(Frame& F, int L, int b, int c, int g) {
    LAS unsigned char* lds = F.lds; LAS float* side = (LAS float*)(F.lds + SIDE_OFF);
    int tid_ = cur_tid(); asm volatile("" : "+v"(tid_));
    const int tid = tid_, lane = tid & 63, wid = __builtin_amdgcn_readfirstlane(tid >> 6), r32 = lane & 31, hi = lane >> 5, h = 8 * g + wid;
    const size_t t0 = (size_t)b * SEQ + (size_t)c * 128;
    const bf16* proj = (const bf16*)(F.ws + X_PROJ); const bf16* Cc = (const bf16*)(F.ws + X_CC); const float* eacum = (const float*)(F.ws + X_EACUM);
    const bf16* ypf = (const bf16*)(F.ws + X_YPART) + (((size_t)b * 64 + c) * 16 + h) * 8192 + lane * 16; const bf16* prev = (const bf16*)(F.ws + X_PREV) + (((size_t)b * 64 + c) * 16 + h) * 8192;
    const float* nw = (const float*)F.in[13] + L * 1024; bf16* ynorm = (bf16*)(F.ws + X_YNORM);
    LAS unsigned char* zst = lds + 32768 + wid * 8192;
    LAS float* eac = side + 1280 + wid * 128;
#pragma unroll
    for (int i = 0; i < 4; ++i) { const int q = tid + 512 * i, row = q >> 4, ch = q & 15; *(LAS u32x4*)(lds + off_b(row, ch)) = *(const u32x4*)(Cc + (t0 + row) * 256 + g * 128 + 8 * ch); }
    eac[lane] = eacum[(t0 + lane) * 16 + h]; eac[64 + lane] = eacum[(t0 + 64 + lane) * 16 + h];
    bf16x8 pf[8][2];
#pragma unroll
    for (int ks = 0; ks < 8; ++ks)
#pragma unroll
        for (int pb = 0; pb < 2; ++pb) pf[ks][pb] = *(const bf16x8*)(prev + (32 * pb + r32) * 128 + 16 * ks + 8 * hi);
    LDS_BAR();
    const int srow = lane >> 1, shalf = lane & 1;
#define S3_LOAD(rb, Z, Y0, Y1) do { \
        _Pragma("unroll") for (int i = 0; i < 4; ++i) { const int q = lane + 64 * i, row = q >> 3, ch = q & 7; Z[i] = *(const u32x4*)(proj + (t0 + 32 * (rb) + row) * NPAD + CZ + h * 64 + 8 * ch); } \
        _Pragma("unroll") for (int i = 0; i < 2; ++i) { Y0[i] = *(const u32x4*)(ypf + ((rb) * 2 + 0) * 1024 + 8 * i); Y1[i] = *(const u32x4*)(ypf + ((rb) * 2 + 1) * 1024 + 8 * i); } } while (0)
    auto s3_body = [&](const int rb, const u32x4 (&zq)[4], const u32x4 (&yq0)[2], const u32x4 (&yq1)[2]) {
#pragma unroll
        for (int i = 0; i < 4; ++i) { const int q = lane + 64 * i, row = q >> 3, ch = q & 7; *(LAS u32x4*)(zst + row * 128 + ch * 16) = zq[i]; }
        f32x16 a0 = {}, a1 = {};
#pragma unroll
        for (int ks = 0; ks < 8; ++ks) { const bf16x8 cf = *(LAS const bf16x8*)(lds + row_read_addr(32 * rb, lane, ks));
            a0 = __builtin_amdgcn_mfma_f32_32x32x16_bf16(cf, pf[ks][0], a0, 0, 0, 0); a1 = __builtin_amdgcn_mfma_f32_32x32x16_bf16(cf, pf[ks][1], a1, 0, 0, 0); }
#pragma unroll
        for (int r = 0; r < 16; ++r) { const int lr = crow(r, hi); const float ea = eac[32 * rb + lr];
            const float z0 = bf2f(*(LAS const unsigned short*)(zst + lr * 128 + r32 * 2)), z1 = bf2f(*(LAS const unsigned short*)(zst + lr * 128 + 64 + r32 * 2));
            const unsigned w0_ = yq0[r >> 3][(r >> 1) & 3], w1_ = yq1[r >> 3][(r >> 1) & 3];
            const float y0 = (((r & 1) ? bfhi(w0_) : bflo(w0_)) + ea * a0[r]) * siluf_(z0), y1 = (((r & 1) ? bfhi(w1_) : bflo(w1_)) + ea * a1[r]) * siluf_(z1);
            *(LAS unsigned short*)(zst + 4096 + lr * 128 + r32 * 2) = f2bf(y0); *(LAS unsigned short*)(zst + 4096 + lr * 128 + 64 + r32 * 2) = f2bf(y1); }
        { float ss = 0.f; u32x4 w[4];
#pragma unroll
          for (int i = 0; i < 4; ++i) { w[i] = *(LAS const u32x4*)(zst + 4096 + srow * 128 + shalf * 64 + i * 16);
              const float e[8] = {bflo(w[i].x), bfhi(w[i].x), bflo(w[i].y), bfhi(w[i].y), bflo(w[i].z), bfhi(w[i].z), bflo(w[i].w), bfhi(w[i].w)};
#pragma unroll
              for (int k = 0; k < 8; ++k) ss += e[k] * e[k]; }
          ss += __shfl_xor(ss, 1);
          if (shalf == 0) side[wid * 128 + 32 * rb + srow] = ss;
          bf16* yo = ynorm + (t0 + 32 * rb + srow) * 1024 + h * 64 + shalf * 32;
#pragma unroll
          for (int i = 0; i < 4; ++i) *(u32x4*)(yo + 8 * i) = w[i]; }
    };
    { u32x4 zA[4], yA0[2], yA1[2], zB[4], yB0[2], yB1[2];
      S3_LOAD(0, zA, yA0, yA1);
      S3_LOAD(1, zB, yB0, yB1); s3_body(0, zA, yA0, yA1);
      S3_LOAD(2, zA, yA0, yA1); s3_body(1, zB, yB0, yB1);
      S3_LOAD(3, zB, yB0, yB1); s3_body(2, zA, yA0, yA1);
      s3_body(3, zB, yB0, yB1); }
#undef S3_LOAD
    WG_BAR();
    if (tid < 128) { float s = 0.f;
#pragma unroll
        for (int w = 0; w < 8; ++w) s += side[w * 128 + tid];
        side[1024 + tid] = __builtin_amdgcn_rsqf(s * (1.f / 512.f) + 1e-6f); }
    LDS_BAR();
    float wv[32];
#pragma unroll
    for (int i = 0; i < 8; ++i) { const f32x4 t4 = *(const f32x4*)(nw + h * 64 + shalf * 32 + 4 * i); wv[4 * i] = t4[0]; wv[4 * i + 1] = t4[1]; wv[4 * i + 2] = t4[2]; wv[4 * i + 3] = t4[3]; }
    u32x4 yw[4][4];
#pragma unroll
    for (int rb = 0; rb < 4; ++rb) { const bf16* yo = ynorm + (t0 + 32 * rb + srow) * 1024 + h * 64 + shalf * 32;
#pragma unroll
        for (int i = 0; i < 4; ++i) yw[rb][i] = *(const u32x4*)(yo + 8 * i); }
#pragma unroll
    for (int rb = 0; rb < 4; ++rb) { const float rs = side[1024 + 32 * rb + srow]; bf16* yo = ynorm + (t0 + 32 * rb + srow) * 1024 + h * 64 + shalf * 32;
#pragma unroll
        for (int i = 0; i < 4; ++i) { const u32x4 w = yw[rb][i]; u32x4 o;
            o.x = pk2(bflo(w.x) * rs * wv[8 * i], bfhi(w.x) * rs * wv[8 * i + 1]); o.y = pk2(bflo(w.y) * rs * wv[8 * i + 2], bfhi(w.y) * rs * wv[8 * i + 3]);
            o.z = pk2(bflo(w.z) * rs * wv[8 * i + 4], bfhi(w.z) * rs * wv[8 * i + 5]); o.w = pk2(bflo(w.w) * rs * wv[8 * i + 6], bfhi(w.w) * rs * wv[8 * i + 7]);
            *(u32x4*)(yo + 8 * i) = o; } }
    LDS_BAR();
}
}

#ifndef PHM
#define PHM 0x3fff
#endif
template <int L> __device__ __forceinline__ void layer_body(Frame& F, const XcdBarrier bar, LAS unsigned char* ring, LAS int* toff, bf16* hb, const int bx) {
        unsigned char* wl = F.ws + WS_WSM + (size_t)L * WSM_LAYER; (void)wl;
#if (PHM >> 1) & 1
        frame_refresh(F);
        { ge::Dense<EpiProj> P{hb, (const bf16*)(wl + WO_WIN), 1024, 1024, {}, {(bf16*)(F.ws + X_PROJ), (float*)(F.ws + X_DTRAW)}}; P.S.init(T, NPAD, F.G, bx);
          ge::gemm_phase(ring, P); }
        xcd_barrier(bar);
#endif
#if (PHM >> 2) & 1
        frame_refresh(F);
#ifndef NO_PREP
        prep_rows(F, L);
#endif
#ifndef NO_S1
        { const int nk_ = (NB * 64 * 2 + F.G - 1) / F.G, kmax_ = nk_ < 2 ? 2 : nk_;
#pragma unroll 1
          for (int k_ = 0; k_ < kmax_; ++k_) { const int u = F.vcu + k_ * F.G;
              if (u < NB * 64 * 2) ssd::s1_unit(F, L, u >> 7, (u >> 1) & 63, u & 1); } }
#endif
        xcd_barrier(bar);
#endif
#if (PHM >> 3) & 1
        frame_refresh(F);
        { ge::Dense<EpiQ> P{(const bf16*)(F.ws + X_QN), (const bf16*)(wl + WO_WQ), 384, 384, {}, {(bf16*)(F.ws + X_QB), (const float*)(F.ws + WS_ROPE), (const float*)(F.ws + WS_ROPE) + (size_t)T * 16}}; P.S.init(T, 768, F.G, bx);
          ge::gemm_phase(ring, P); }
        { ge::Dense<EpiStoreBf16> P{(const bf16*)(F.ws + X_CKVN), (const bf16*)(wl + WO_WKV), 256, 256, {}, {(bf16*)(F.ws + X_KVB), 1024}}; P.S.init(T, 1024, F.G, bx);
          ge::gemm_phase(ring, P); }
        ssd::scan_phase(F);
        xcd_barrier(bar);
#endif
#if (PHM >> 4) & 1
        frame_refresh(F);
#ifndef NO_ATTN
        { const int s = F.vcu & 7, bh = F.vcu >> 3; const bool bal = F.G == 256;
          const int nk_ = bal ? 4 : (1024 + F.G - 1) / F.G, kmax_ = nk_ < 4 ? 4 : nk_;
          bool conv_done = false;
#pragma unroll 1
          for (int i = 0; i < kmax_; ++i) {
              if (!conv_done && conv_acquire(F, L, false)) { p0_expert_weights(F, L); WG_BAR(); conv_release(F, L); conv_done = true; }
              const int qb = (i == 0) ? 31 - s : (i == 1) ? 16 + s : (i == 2) ? 15 - s : s;     const int u = F.vcu + i * F.G;
              if (bal || u < 1024)
                  at::attn_unit(bal ? (bh >> 3) : (u >> 8), bal ? (bh & 7) : ((u >> 5) & 7), bal ? qb : (u & 31), (const bf16*)(F.ws + X_QB), (const bf16*)(F.ws + X_KVB), (const bf16*)(F.ws + X_KPE), (bf16*)(F.ws + X_OB), ring); }
          if (!conv_done) { conv_acquire(F, L, true); p0_expert_weights(F, L); WG_BAR(); conv_release(F, L); } }
#endif
#ifndef NO_S3
        for (int u = F.vcu; u < NB * 64 * 2; u += F.G) ssd::s3_unit(F, L, u >> 7, (u >> 1) & 63, u & 1);
#endif
        xcd_barrier(bar);
#endif
#if (PHM >> 5) & 1
        frame_refresh(F);
        { ge::Dense<EpiGate> P{(const bf16*)(F.ws + X_OB), (const bf16*)(wl + WO_WAB), 512, 512, {}, {(bf16*)(F.ws + X_MB), (const bf16*)(F.ws + X_PROJ), CGA, 0}}; P.S.init(T, 1024, F.G, bx);
          ge::gemm_phase(ring, P); }
        { ge::Dense<EpiGate> P{(const bf16*)(F.ws + X_YNORM), (const bf16*)(wl + WO_WSB), 1024, 1024, {}, {(bf16*)(F.ws + X_MB), (const bf16*)(F.ws + X_PROJ), CGB, 1}}; P.S.init(T, 1024, F.G, bx);
          ge::gemm_phase(ring, P); }
        xcd_barrier(bar);
#endif
#if (PHM >> 6) & 1
        frame_refresh(F);
        { ge::Dense<EpiWo> P{(const bf16*)(F.ws + X_MB), (const bf16*)(wl + WO_WO), 1024, 1024, {}, {(bf16*)(F.ws + X_PRE), (const bf16*)hb}}; P.S.init(T, 1024, F.G, bx);
          ge::gemm_phase(ring, P); }
        xcd_barrier(bar);
#endif
#if (PHM >> 7) & 1
        frame_refresh(F);
        ln_rows<false, false>(F, (const bf16*)(F.ws + X_PRE), (const float*)F.in[17] + L * D, (const float*)F.in[18] + L * D, nullptr, nullptr, nullptr);
        xcd_barrier(bar);
#endif
#if (PHM >> 8) & 1
        frame_refresh(F);
        { ge::Dense<EpiCat> P{hb, (const bf16*)(wl + WO_WCAT), 1024, 1024, {}, {(float*)(F.ws + X_LOGITS), (bf16*)(F.ws + X_SHHID), (bf16*)(F.ws + X_SG)}}; P.S.init(T, 1792, F.G, bx);
          ge::gemm_phase(ring, P); }
        { const int nwg = (T / 256) * (1792 / 256), maxu = (nwg + F.G - 1) / F.G, nfull = nwg - (maxu - 1) * F.G;
          int tid_ = cur_tid(); asm volatile("" : "+v"(tid_)); F.tid = tid_;
          if (nfull >= F.G) conv_p(F, L, bx, F.G); else if (bx >= nfull) conv_p(F, L, bx - nfull, F.G - nfull); }
        xcd_barrier(bar);
#endif
#if (PHM >> 9) & 1
        frame_refresh(F);
        topk_rows(F, L);
        { ge::Dense<EpiPle> P{(const bf16*)(F.ws + X_PB), (const bf16*)(wl + WO_WPLE), 256, 256, {}, {(bf16*)(F.ws + X_BASE), (const bf16*)hb, (const bf16*)(F.ws + X_SG)}}; P.S.init(T, 1024, F.G, bx);
          ge::gemm_phase(ring, P); }
        { ge::Dense<EpiAddF32> P{(const bf16*)(F.ws + X_SHHID), (const bf16*)(wl + WO_WSD), 256, 256, {}, {(bf16*)(F.ws + X_BASE)}}; P.S.init(T, 1024, F.G, bx);
          ge::gemm_phase(ring, P); }
        xcd_barrier(bar);
#endif
#if (PHM >> 10) & 1
        frame_refresh(F);
        build_toff(F, L, toff);
        scatter_slots(F, L, toff);
        xcd_barrier(bar);
#endif
#if (PHM >> 11) & 1
        frame_refresh(F);
        { MoeGU P{hb, (const bf16*)(F.ws + WS_WGU + (size_t)L * WGU_LAYER), (const int*)(F.ws + X_STOK), (bf16*)(F.ws + X_HID), toff, F.G, F.vcu, 1024};
          ge::gemm_phase(ring, P); }
        xcd_barrier(bar);
#endif
#if (PHM >> 12) & 1
        frame_refresh(F);
        { MoeDown P{(const bf16*)(F.ws + X_HID), (const bf16*)(F.ws + WS_WD + (size_t)L * WD_LAYER), (const float*)(F.ws + X_SW), (unsigned char*)(F.ws + X_Y), toff, F.G, F.vcu, 256};
          ge::gemm_phase(ring, P); }
        xcd_barrier(bar);
#endif
#if (PHM >> 13) & 1
        frame_refresh(F);
        ln_rows<true, L == DEPTH - 1>(F, (const bf16*)(F.ws + X_BASE), (const float*)F.in[29] + L * D, (const float*)F.in[30] + L * D, (const int*)(F.ws + X_RRANK), (const unsigned char*)(F.ws + X_Y), (const float*)(F.ws + X_RW));
        xcd_barrier(bar);
#endif
}
struct Args { const void* in[31]; float* out; unsigned char* ws; };
__global__ void __launch_bounds__(NWAVES * 64, 2) fwd(Args args) {
    Frame F;
    F.lds = (LAS unsigned char*)lds_raw;
    F.tid = threadIdx.x; F.lane = F.tid & 63; F.wave = __builtin_amdgcn_readfirstlane(F.tid >> 6);
    F.G = gridDim.x; { const int bx = blockIdx.x; F.vcu = (F.G % 8 == 0) ? (bx % 8) * (F.G / 8) + bx / 8 : bx; }
    F.ws = args.ws; F.out = args.out; F.in = args.in; F.ctl = (gu32*)(args.ws + WS_CTL);
    for (int u = F.tid; u < (LDS_BYTES - LDSCTL_OFF) / 4; u += NWAVES * 64) ((LAS unsigned*)(F.lds + LDSCTL_OFF))[u] = 0u;
    __syncthreads();
    if (F.lane == 0) *(volatile LAS int*)(F.lds + LDSCTL_OFF + 64 + 4 * hw_wave_slot()) = F.wave;
    __syncthreads();
    frame_refresh(F);
    XcdBarrier bar = xcd_barrier_post((unsigned*)(F.ctl + CW_BAR), (volatile LAS unsigned*)(F.lds + LDSCTL_OFF));
    LAS unsigned char* ring = F.lds + RING_OFF;
    LAS int* toff = (LAS int*)(F.lds + SIDE_OFF + 8192);
    bf16* hb = (bf16*)(F.ws + WS_HB);
    const int bx = (int)blockIdx.x;

#if (PHM >> 0) & 1
        frame_refresh(F);
    p0_small_weights(F); p0_misc(F);
    xcd_barrier(bar);

#endif
    layer_body<0>(F, bar, ring, toff, hb, bx);
    layer_body<1>(F, bar, ring, toff, hb, bx);
}

extern "C" void kernel_launch(void* const* d_in, const int* in_sizes, int n_in, void* d_out, int out_size, void* d_ws, size_t ws_size, hipStream_t stream) {
    static int grid = 0;
    if (grid == 0) {
        if (n_in != 31 || out_size != T * D || ws_size < WS_END) { fprintf(stderr, "kernel_launch: unexpected shapes (n_in %d out %d ws %zu)\n", n_in, out_size, ws_size); grid = -1; return; }
        int dev = 0, cus = 0, per_cu = 0;
        if (hipGetDevice(&dev) != hipSuccess || hipDeviceGetAttribute(&cus, hipDeviceAttributeMultiprocessorCount, dev) != hipSuccess) { grid = -1; return; }
        if (hipFuncSetAttribute((const void*)fwd, hipFuncAttributeMaxDynamicSharedMemorySize, LDS_BYTES) != hipSuccess) { fprintf(stderr, "kernel_launch: hipFuncSetAttribute failed\n"); grid = -1; return; }
        if (hipOccupancyMaxActiveBlocksPerMultiprocessor(&per_cu, (const void*)fwd, NWAVES * 64, LDS_BYTES) != hipSuccess || per_cu < 1) { fprintf(stderr, "kernel_launch: occupancy query says %d\n", per_cu); }
        (void)hipGetLastError();
        grid = cus;
    }
    if (grid < 0) return;
    (void)hipMemsetAsync((char*)d_ws + WS_CTL, 0, CTL_ZERO_BYTES, stream);
    Args a{};
    for (int i = 0; i < 31; ++i) a.in[i] = d_in[i];
    a.out = (float*)d_out; a.ws = (unsigned char*)d_ws;
    hipLaunchKernelGGL(fwd, dim3(grid), dim3(NWAVES * 64), LDS_BYTES, stream, a);
}
```
